# Optimizing an MI355X kernel written in HIP

```python
import jax, jax.numpy as jnp
from jax import lax
import numpy as np

D_MODEL = 2048
BATCH = 2
SEQ = 8192
DEPTH = 1

MIX_WIDTH = D_MODEL
HEAD_DIM = 128
POOL_WINDOWS = (2, 4, 8, 16)
N_POOL_GROUPS = len(POOL_WINDOWS)
POOL_WIDTH = MIX_WIDTH // 4
POOL_GROUP_DIM = POOL_WIDTH // N_POOL_GROUPS
ATTN_WIDTH = MIX_WIDTH - POOL_WIDTH
N_ATTN_HEADS = ATTN_WIDTH // HEAD_DIM
DILATION_PAIRS = ((128, 1), (512, 4), (2048, 16))
N_DIL_GROUPS = len(DILATION_PAIRS)
HEADS_PER_GROUP = N_ATTN_HEADS // N_DIL_GROUPS
BLOCK = 128
D_FF = ((8 * D_MODEL // 3 + 255) // 256) * 256
D_PLE = 256
NUM_BUCKETS = 32
MAX_EXACT = NUM_BUCKETS // 2
MAX_DISTANCE = 2048
EPS = 1e-6
NEG_INF = -1e30
IN_PROJ_WIDTH = POOL_WIDTH + 3 * ATTN_WIDTH

kernel_name = "hymba_pool_dilated_attn_swiglu_ple"


def rms_norm(x, g):
    xf = x.astype(jnp.float32)
    y = xf * lax.rsqrt(jnp.mean(xf * xf, axis=-1, keepdims=True) + EPS)
    return (y * g.astype(jnp.float32)).astype(x.dtype)


def t5_causal_bucket(distance):
    n = jnp.maximum(distance, 0)
    nf = jnp.maximum(n, 1).astype(jnp.float32)
    large = MAX_EXACT + (jnp.log(nf / MAX_EXACT) / np.float32(np.log(MAX_DISTANCE / MAX_EXACT))
                         * (NUM_BUCKETS - MAX_EXACT)).astype(jnp.int32)
    large = jnp.minimum(large, NUM_BUCKETS - 1)
    return jnp.where(n < MAX_EXACT, n, large)


def pool_mixer(u, pool_w, pool_scale):
    B, S, _ = u.shape
    uf = u.astype(jnp.float32)
    cs = jnp.pad(jnp.cumsum(uf, axis=1), ((0, 0), (1, 0), (0, 0)))
    pos = jnp.arange(1, S + 1, dtype=jnp.int32)
    outs = []
    for gi, w in enumerate(POOL_WINDOWS):
        sl = slice(gi * POOL_GROUP_DIM, (gi + 1) * POOL_GROUP_DIM)
        c = cs[..., sl]
        prev = jnp.pad(c, ((0, 0), (w, 0), (0, 0)))[:, 1:S + 1]
        cnt = jnp.minimum(pos, w).astype(jnp.float32)[None, :, None]
        outs.append((c[:, 1:] - prev) / cnt - uf[..., sl])
    pooled = jnp.stack(outs, axis=2)
    mixed = jnp.einsum('bsgc,gcd->bsgd', pooled, pool_w.astype(jnp.float32))
    return (mixed.reshape(B, S, POOL_WIDTH) * pool_scale.astype(jnp.float32)).astype(u.dtype)


def dilated_window_attention(q, k, v, bias_table, window, dilation):
    B, S, H, Dh = q.shape
    d = dilation
    steps = window // d
    L = S // d
    nb = -(-L // BLOCK)
    Lp = nb * BLOCK

    def to_sub(t):
        t = t.reshape(B, L, d, H, Dh).astype(jnp.float32)
        return jnp.pad(t, ((0, 0), (0, Lp - L), (0, 0), (0, 0), (0, 0)))

    def band_keys(t):
        tp = jnp.pad(to_sub(t), ((0, 0), (BLOCK, 0), (0, 0), (0, 0), (0, 0)))
        prev = tp[:, :Lp].reshape(B, nb, BLOCK, d, H, Dh)
        cur = tp[:, BLOCK:].reshape(B, nb, BLOCK, d, H, Dh)
        return jnp.concatenate([prev, cur], axis=2)

    qs = to_sub(q).reshape(B, nb, BLOCK, d, H, Dh)
    kb = band_keys(k)
    vb = band_keys(v)
    scores = jnp.einsum('bnqrhe,bnkrhe->bnrhqk', qs, kb) * np.float32(Dh ** -0.5)

    qi = jnp.arange(BLOCK, dtype=jnp.int32)[:, None]
    ki = jnp.arange(2 * BLOCK, dtype=jnp.int32)[None, :]
    offset = qi + BLOCK - ki
    valid_off = (offset >= 0) & (offset <= steps)
    key_ok = (jnp.arange(nb)[:, None] > 0) | (ki >= BLOCK)
    mask = valid_off[None] & key_ok[:, None, :]
    bias = jnp.transpose(bias_table.astype(jnp.float32)[t5_causal_bucket(offset * d)], (2, 0, 1))

    logits = jnp.where(mask[None, :, None, None], scores + bias[None, None, None], NEG_INF)
    m = jnp.max(logits, axis=-1, keepdims=True)
    pexp = jnp.exp(logits - m)
    den = jnp.sum(pexp, axis=-1, keepdims=True)
    out = jnp.einsum('bnrhqk,bnkrhe->bnrhqe', pexp, vb) / den
    lse = (m + jnp.log(den))[..., 0]

    out = jnp.transpose(out, (0, 1, 4, 2, 3, 5)).reshape(B, Lp, d, H, Dh)[:, :L]
    lse = jnp.transpose(lse, (0, 1, 4, 2, 3)).reshape(B, Lp, d, H)[:, :L]
    return out.reshape(B, S, H, Dh), lse.reshape(B, S, H)


def dilated_mixture_attention(q, k, v, rel_bias):
    B, S, _ = q.shape
    q = q.reshape(B, S, N_ATTN_HEADS, HEAD_DIM)
    k = k.reshape(B, S, N_ATTN_HEADS, HEAD_DIM)
    v = v.reshape(B, S, N_ATTN_HEADS, HEAD_DIM)
    outs, lses = [], []
    for gi, (window, dil) in enumerate(DILATION_PAIRS):
        hs = slice(gi * HEADS_PER_GROUP, (gi + 1) * HEADS_PER_GROUP)
        o, l = dilated_window_attention(q[:, :, hs], k[:, :, hs], v[:, :, hs], rel_bias[:, hs], window, dil)
        outs.append(o)
        lses.append(l)
    outs = jnp.stack(outs, axis=2)
    alpha = jax.nn.softmax(jnp.stack(lses, axis=2), axis=2)
    return (outs * alpha[..., None]).reshape(B, S, ATTN_WIDTH).astype(q.dtype)


def setup_inputs(seed: int = 0) -> dict:
    key = jax.random.key(seed)
    ks = jax.random.split(key, 16)
    f32 = jnp.float32
    nrm = lambda k, shape, fan_in: jax.random.normal(k, shape, f32) * (fan_in ** -0.5)
    gain = lambda k, shape: 1.0 + 0.05 * jax.random.normal(k, shape, f32)
    return {
        "x": jax.random.normal(ks[0], (BATCH, SEQ, D_MODEL), f32),
        "p": jax.random.normal(ks[1], (DEPTH, BATCH, SEQ, D_PLE), f32),
        "rel_bias": 0.5 * jax.random.normal(ks[2], (NUM_BUCKETS, N_ATTN_HEADS), f32),
        "norm_mix_g": gain(ks[3], (DEPTH, D_MODEL)),
        "w_in": nrm(ks[4], (DEPTH, D_MODEL, IN_PROJ_WIDTH), D_MODEL),
        "pool_w": nrm(ks[5], (DEPTH, N_POOL_GROUPS, POOL_GROUP_DIM, POOL_GROUP_DIM), POOL_GROUP_DIM),
        "pool_scale": gain(ks[6], (DEPTH, POOL_WIDTH)),
        "w_out": nrm(ks[7], (DEPTH, MIX_WIDTH, D_MODEL), MIX_WIDTH),
        "norm_ffn_g": gain(ks[8], (DEPTH, D_MODEL)),
        "w_gate": nrm(ks[9], (DEPTH, D_MODEL, D_FF), D_MODEL),
        "w_up": nrm(ks[10], (DEPTH, D_MODEL, D_FF), D_MODEL),
        "w_down": nrm(ks[11], (DEPTH, D_FF, D_MODEL), D_FF),
        "norm_ple_g": gain(ks[12], (DEPTH, D_MODEL)),
        "w_ple_gate": nrm(ks[13], (DEPTH, D_MODEL, D_MODEL), D_MODEL),
        "w_ple_proj": nrm(ks[14], (DEPTH, D_PLE, D_MODEL), D_PLE),
        "final_norm_g": gain(ks[15], (D_MODEL,)),
    }


def reference(x, p, rel_bias, norm_mix_g, w_in, pool_w, pool_scale, w_out,
              norm_ffn_g, w_gate, w_up, w_down, norm_ple_g, w_ple_gate, w_ple_proj,
              final_norm_g):
    h = x
    for i in range(DEPTH):
        xn = rms_norm(h, norm_mix_g[i])
        proj = xn @ w_in[i]
        u_pool = proj[..., :POOL_WIDTH]
        q = proj[..., POOL_WIDTH:POOL_WIDTH + ATTN_WIDTH]
        k = proj[..., POOL_WIDTH + ATTN_WIDTH:POOL_WIDTH + 2 * ATTN_WIDTH]
        v = proj[..., POOL_WIDTH + 2 * ATTN_WIDTH:]
        y_pool = pool_mixer(u_pool, pool_w[i], pool_scale[i])
        y_attn = dilated_mixture_attention(q, k, v, rel_bias)
        h = h + jnp.concatenate([y_pool, y_attn], axis=-1) @ w_out[i]
        hn = rms_norm(h, norm_ffn_g[i])
        h = h + (jax.nn.silu(hn @ w_gate[i]) * (hn @ w_up[i])) @ w_down[i]
        gate = jax.nn.sigmoid(rms_norm(h, norm_ple_g[i]) @ w_ple_gate[i])
        h = h + gate * (p[i] @ w_ple_proj[i])
    return rms_norm(h, final_norm_g)
```

```cpp
#include <hip/hip_runtime.h>
#include <hip/hip_cooperative_groups.h>
#include <cstdio>
#include <cstdint>
namespace cg = cooperative_groups;

constexpr int BATCH = 2, SEQ = 8192, DM = 2048, MROWS = BATCH * SEQ, NIN = 5120, DFF = 5632, DPLE = 256, NHEADS = 12, HD = 128;
constexpr float RMS_EPS = 1e-6f;
constexpr float QSCALE = 0.08838834764831845f * 1.4426950408889634f;
constexpr float LOG2E = 1.4426950408889634f, LN2 = 0.6931471805599453f;
namespace pg8 {
#define PG8_LAS __attribute__((address_space(3)))
typedef unsigned short bf16_t;
typedef short bf16x8 __attribute__((ext_vector_type(8)));
typedef float f32x4 __attribute__((ext_vector_type(4)));
typedef unsigned u32x4 __attribute__((ext_vector_type(4)));
constexpr int BM = 256, BK = 64, HALF = 128, HTB = HALF * BK * 2  , STAGE_BYTES = 8 * HTB, NXCD = 8, WGM = 8;

__host__ __device__ __forceinline__ int lds_byte(int r, int c) { const int st = (r >> 4) * 2 + (c >> 5), rr = r & 15, cc = c & 31, ob = rr * 64 + cc * 2; return st * 1024 + (ob ^ (((ob >> 9) & 1) << 5)); }
__host__ __device__ __forceinline__ void stage_rc(int b, int& R, int& C) { const int st = b / 1024, sb = b % 1024, swz = sb ^ (((sb >> 9) & 1) << 5); R = (st >> 1) * 16 + swz / 64; C = (st & 1) * 32 + (swz % 64) / 2; }
__host__ __device__ __forceinline__ int perm32(int rho) { const int n = rho >> 4, i = rho & 15; return 8 * (i >> 2) + 4 * n + (i & 3); }

struct Unit { int pm, pn; };
struct Gemm { const bf16_t* A; const bf16_t* Bt; int M, N, K; };

struct StaticOrder {
    int nM, nN, nwg, G, c;
    __host__ __device__ void init(int M, int N, int G_, int c_) { nM = M / BM; nN = N / BM; nwg = nM * nN; G = G_; c = c_; }
    __host__ __device__ bool next(int i, Unit& u) const {
        const long L = (long)i * G + c; if (L >= nwg) return false;
        int wgid = (int)L; { const int q = nwg / NXCD, r = nwg % NXCD, xcd = wgid % NXCD, off = wgid / NXCD; wgid = (xcd < r ? xcd * (q + 1) : r * (q + 1) + (xcd - r) * q) + off; }
        const int nig = WGM * nN, gid = wgid / nig, fm = gid * WGM, gsz = (nM - fm) < WGM ? (nM - fm) : WGM;
        u.pm = fm + ((wgid % nig) % gsz); u.pn = (wgid % nig) / gsz; return true;
    }
    __device__ __forceinline__ void a_ready(const Unit&) const {}
    __device__ __forceinline__ void done(const Unit&) const {}
};

__device__ __forceinline__ unsigned cvt_pk_bf16(float lo, float hi) { unsigned r; asm volatile("v_cvt_pk_bf16_f32 %0, %1, %2" : "=v"(r) : "v"(lo), "v"(hi)); return r; }
__device__ __forceinline__ u32x4 pack8(const f32x4 v0, const f32x4 v1) { u32x4 w; w.x = cvt_pk_bf16(v0[0], v0[1]); w.y = cvt_pk_bf16(v0[2], v0[3]); w.z = cvt_pk_bf16(v1[0], v1[1]); w.w = cvt_pk_bf16(v1[2], v1[3]); return w; }
__device__ __forceinline__ float bf_lo(unsigned w) { return __uint_as_float(w << 16); }
__device__ __forceinline__ float bf_hi(unsigned w) { return __uint_as_float(w & 0xffff0000u); }
__device__ __forceinline__ float dot4(const f32x4 v) { return (v[0] * v[0] + v[1] * v[1]) + (v[2] * v[2] + v[3] * v[3]); }

struct EpiProj {
    static constexpr bool PERM = true, AFTER_DRAIN = false;
    bf16_t* O; int ldc; const float* rstd; int q_lo, q_hi; float qscale;
    __device__ __forceinline__ void operator()(const f32x4 (&acc)[2][2][4][2], const Unit& u, int wr, int wc, int fr, int fq) const {
        const int row0 = u.pm * BM + wr * 64 + fr, col0 = u.pn * BM + wc * 32 + 8 * fq;
        const float qs = (u.pn >= q_lo && u.pn < q_hi) ? qscale : 1.0f;
#pragma unroll
        for (int ai = 0; ai < 2; ++ai)
#pragma unroll
            for (int m = 0; m < 4; ++m) { const int row = row0 + ai * HALF + m * 16; const float s = rstd[row] * qs; bf16_t* rowp = O + (size_t)row * ldc + col0;
#pragma unroll
                for (int bj = 0; bj < 2; ++bj) *(u32x4*)(rowp + bj * HALF) = pack8(acc[ai][bj][m][0] * s, acc[ai][bj][m][1] * s); }
    }
};
struct EpiPlain {
    static constexpr bool PERM = true, AFTER_DRAIN = false;
    bf16_t* O; int ldc;
    __device__ __forceinline__ void operator()(const f32x4 (&acc)[2][2][4][2], const Unit& u, int wr, int wc, int fr, int fq) const {
        const int row0 = u.pm * BM + wr * 64 + fr, col0 = u.pn * BM + wc * 32 + 8 * fq;
#pragma unroll
        for (int ai = 0; ai < 2; ++ai)
#pragma unroll
            for (int m = 0; m < 4; ++m) { bf16_t* rowp = O + (size_t)(row0 + ai * HALF + m * 16) * ldc + col0;
#pragma unroll
                for (int bj = 0; bj < 2; ++bj) *(u32x4*)(rowp + bj * HALF) = pack8(acc[ai][bj][m][0], acc[ai][bj][m][1]); }
    }
};
struct EpiRes {
    static constexpr bool PERM = true, AFTER_DRAIN = false;
    const float* base; float* out; bf16_t* ob; float* ssq; int ldc;
    __device__ __forceinline__ void operator()(const f32x4 (&acc)[2][2][4][2], const Unit& u, int wr, int wc, int fr, int fq) const {
        const int row0 = u.pm * BM + wr * 64 + fr, col0 = u.pn * BM + wc * 32 + 8 * fq;
#pragma unroll
        for (int ai = 0; ai < 2; ++ai)
#pragma unroll
            for (int m = 0; m < 4; ++m) { const int row = row0 + ai * HALF + m * 16; const size_t off = (size_t)row * ldc + col0; float s = 0.f;
#pragma unroll
                for (int bj = 0; bj < 2; ++bj) {
                    const f32x4 v0 = *(const f32x4*)(base + off + bj * HALF) + acc[ai][bj][m][0], v1 = *(const f32x4*)(base + off + bj * HALF + 4) + acc[ai][bj][m][1];
                    *(f32x4*)(out + off + bj * HALF) = v0; *(f32x4*)(out + off + bj * HALF + 4) = v1;
                    *(u32x4*)(ob + off + bj * HALF) = pack8(v0, v1);
                    s += dot4(v0) + dot4(v1); }
                s += __shfl_xor(s, 16); s += __shfl_xor(s, 32);
                if (fq == 0) atomicAdd(ssq + row, s);
                if (m & 1) asm volatile("" ::: "memory"); }
    }
};
struct EpiSwiGLU {
    static constexpr bool PERM = true, AFTER_DRAIN = false;
    bf16_t* O; int ldc; const float* ssq; float inv_d, eps;
    __device__ __forceinline__ void operator()(const f32x4 (&acc)[2][2][4][2], const Unit& u, int wr, int wc, int fr, int fq) const {
        const int row0 = u.pm * BM + wr * 64 + fr, col0 = u.pn * HALF + wc * 32 + 8 * fq;
#pragma unroll
        for (int ai = 0; ai < 2; ++ai)
#pragma unroll
            for (int m = 0; m < 4; ++m) { const int row = row0 + ai * HALF + m * 16; const float r = __builtin_amdgcn_rsqf(ssq[row] * inv_d + eps);
                f32x4 o[2];
#pragma unroll
                for (int n = 0; n < 2; ++n)
#pragma unroll
                    for (int j = 0; j < 4; ++j) { const float g = acc[ai][0][m][n][j] * r, up = acc[ai][1][m][n][j] * r;
                        o[n][j] = g * up * __builtin_amdgcn_rcpf(1.0f + __builtin_amdgcn_exp2f(-1.4426950408889634f * g)); }
                *(u32x4*)(O + (size_t)row * ldc + col0) = pack8(o[0], o[1]); }
    }
};
struct EpiPle {
    static constexpr bool PERM = true, AFTER_DRAIN = false;
    float* h; const bf16_t* pp; const float* ssq2; float* ssq3; int ldc; float inv_d, eps;
    __device__ __forceinline__ void operator()(const f32x4 (&acc)[2][2][4][2], const Unit& u, int wr, int wc, int fr, int fq) const {
        const int row0 = u.pm * BM + wr * 64 + fr, col0 = u.pn * BM + wc * 32 + 8 * fq;
#pragma unroll
        for (int ai = 0; ai < 2; ++ai)
#pragma unroll
            for (int m = 0; m < 4; ++m) { const int row = row0 + ai * HALF + m * 16; const size_t off = (size_t)row * ldc + col0; float s = 0.f;
                const float r = __builtin_amdgcn_rsqf(ssq2[row] * inv_d + eps);
#pragma unroll
                for (int bj = 0; bj < 2; ++bj) {
                    const u32x4 pw = *(const u32x4*)(pp + off + bj * HALF);
                    f32x4 v0 = *(const f32x4*)(h + off + bj * HALF), v1 = *(const f32x4*)(h + off + bj * HALF + 4);
                    const f32x4 p0 = {bf_lo(pw.x), bf_hi(pw.x), bf_lo(pw.y), bf_hi(pw.y)}, p1 = {bf_lo(pw.z), bf_hi(pw.z), bf_lo(pw.w), bf_hi(pw.w)};
#pragma unroll
                    for (int j = 0; j < 4; ++j) {
                        v0[j] += p0[j] * __builtin_amdgcn_rcpf(1.0f + __builtin_amdgcn_exp2f(-1.4426950408889634f * r * acc[ai][bj][m][0][j]));
                        v1[j] += p1[j] * __builtin_amdgcn_rcpf(1.0f + __builtin_amdgcn_exp2f(-1.4426950408889634f * r * acc[ai][bj][m][1][j])); }
                    *(f32x4*)(h + off + bj * HALF) = v0; *(f32x4*)(h + off + bj * HALF + 4) = v1;
                    s += dot4(v0) + dot4(v1); }
                s += __shfl_xor(s, 16); s += __shfl_xor(s, 32);
                if (fq == 0) atomicAdd(ssq3 + row, s);
                if (m & 1) asm volatile("" ::: "memory"); }
    }
};

template <class Epi, class Sched, bool ALIGN_EPI = false, bool SP2 = false>
__device__ __forceinline__ void gemm_phase(PG8_LAS unsigned char* lds, const Gemm g, const Sched& S, const Epi& E) {
    const int tid = threadIdx.x, wid = __builtin_amdgcn_readfirstlane(tid >> 6), lane = tid & 63, wr = wid >> 2, wc = wid & 3, fr = lane & 15, fq = lane >> 4;
    const int K = g.K, nt = K / BK;
    unsigned voffA[2], voffB[2];
#pragma unroll
    for (int i = 0; i < 2; ++i) { int R, C; stage_rc(tid * 16 + i * 8192, R, C); const int Rb = Epi::PERM ? ((R & ~31) + perm32(R & 31)) : R;
        voffA[i] = (unsigned)(R * K + C) * 2u; voffB[i] = (unsigned)(Rb * K + C) * 2u; }
    const size_t kstep = (size_t)(BK * 2);
    const size_t hstep = (size_t)HALF * K * 2;
    const size_t tstep = 2 * hstep;
    const unsigned ldsw = (unsigned)wid * 1024u;
    const int aoff = lds_byte(wr * 64 + fr, fq * 8), boff = lds_byte(wc * 32 + fr, fq * 8);
#define PG8_SA(b, h) (((b) * 2 + (h)) * HTB)
#define PG8_SB(b, h) ((4 + (b) * 2 + (h)) * HTB)
#define PG8_STAGE(bufoff, gbase, voff) do { _Pragma("unroll") for (int _i = 0; _i < 2; ++_i) \
        __builtin_amdgcn_global_load_lds((const unsigned*)((const char*)(gbase) + (voff)[_i]), (PG8_LAS unsigned*)(lds + (bufoff) + ldsw + _i * 8192), 16, 0, 0); } while (0)
#define PG8_LDA(dst, b, h) do { _Pragma("unroll") for (int m = 0; m < 4; ++m) _Pragma("unroll") for (int k = 0; k < 2; ++k) dst[m][k] = *(const PG8_LAS bf16x8*)(lds + PG8_SA(b, h) + aoff + m * 2048 + k * 1024); } while (0)
#define PG8_LDB(dst, b, h) do { _Pragma("unroll") for (int n = 0; n < 2; ++n) _Pragma("unroll") for (int k = 0; k < 2; ++k) dst[n][k] = *(const PG8_LAS bf16x8*)(lds + PG8_SB(b, h) + boff + n * 2048 + k * 1024); } while (0)
#define PG8_MMA(ai, bj, At, Bt) do { __builtin_amdgcn_s_setprio(1); _Pragma("unroll") for (int m = 0; m < 4; ++m) _Pragma("unroll") for (int n = 0; n < 2; ++n) _Pragma("unroll") for (int k = 0; k < 2; ++k) \
        acc[ai][bj][m][n] = __builtin_amdgcn_mfma_f32_16x16x32_bf16(Bt[n][k], At[m][k], acc[ai][bj][m][n], 0, 0, 0); __builtin_amdgcn_s_setprio(0); } while (0)
#define PG8_WAIT_V(n) asm volatile("s_waitcnt vmcnt(" #n ")" ::: "memory")
#define PG8_WAIT_L(n) asm volatile("s_waitcnt lgkmcnt(" #n ")" ::: "memory")
#define PG8_BAR __builtin_amdgcn_s_barrier()
#define PG8_SCHED __builtin_amdgcn_sched_barrier(0)
    Unit cur, nxt; int ui = 0;
    if (!S.next(0, cur)) return;
    f32x4 acc[2][2][4][2];
#pragma unroll
    for (int a = 0; a < 2; ++a)
#pragma unroll
        for (int b = 0; b < 2; ++b)
#pragma unroll
            for (int m = 0; m < 4; ++m)
#pragma unroll
                for (int n = 0; n < 2; ++n) acc[a][b][m][n] = (f32x4){0.f, 0.f, 0.f, 0.f};
    bf16x8 At[4][2], B0[2][2], B1[2][2];
    const char* cA = (const char*)g.A + (size_t)cur.pm * tstep; const char* cB = (const char*)g.Bt + (size_t)cur.pn * tstep;
    S.a_ready(cur);
    if constexpr (SP2) {
        PG8_STAGE(PG8_SB(0, 0), cB, voffB); PG8_STAGE(PG8_SB(0, 1), cB + hstep, voffB); PG8_STAGE(PG8_SA(0, 0), cA, voffA); PG8_STAGE(PG8_SA(0, 1), cA + hstep, voffA);
        if (wr == 1) PG8_BAR;
        PG8_WAIT_V(2); PG8_BAR;
        PG8_STAGE(PG8_SB(1, 0), cB + kstep, voffB); PG8_STAGE(PG8_SA(1, 0), cA + kstep, voffA); PG8_STAGE(PG8_SB(1, 1), cB + hstep + kstep, voffB);
        PG8_WAIT_V(6); PG8_BAR;
    } else {
        PG8_STAGE(PG8_SB(0, 0), cB, voffB); PG8_STAGE(PG8_SA(0, 0), cA, voffA); PG8_STAGE(PG8_SB(0, 1), cB + hstep, voffB); PG8_STAGE(PG8_SA(0, 1), cA + hstep, voffA);
        if (wr == 1) PG8_BAR;
        PG8_WAIT_V(4); PG8_BAR;
        PG8_STAGE(PG8_SB(1, 0), cB + kstep, voffB); PG8_STAGE(PG8_SA(1, 0), cA + kstep, voffA); PG8_STAGE(PG8_SB(1, 1), cB + hstep + kstep, voffB);
        PG8_WAIT_V(6); PG8_BAR;
    }
    for (;;) {
        const bool has_next = S.next(ui + 1, nxt);
        const char* nA = has_next ? (const char*)g.A + (size_t)nxt.pm * tstep : cA; const char* nB = has_next ? (const char*)g.Bt + (size_t)nxt.pn * tstep : cB;
        for (int t = 0; t < nt; t += 2) {
            const bool last = (t == nt - 2);
            const char* a1 = cA + (size_t)(t + 1) * kstep;
            const char* a2 = last ? nA : cA + (size_t)(t + 2) * kstep; const char* b2 = last ? nB : cB + (size_t)(t + 2) * kstep;
            const char* a3 = a2 + kstep; const char* b3 = b2 + kstep;
            if (last && has_next) S.a_ready(nxt);
            if constexpr (SP2) {
            PG8_LDB(B0, 0, 0); PG8_LDB(B1, 0, 1); PG8_SCHED; PG8_LDA(At, 0, 0); PG8_STAGE(PG8_SA(1, 1), a1 + hstep, voffA);
            PG8_WAIT_V(8); PG8_WAIT_L(0); PG8_BAR; PG8_MMA(0, 0, At, B0); PG8_MMA(0, 1, At, B1); PG8_BAR; PG8_SCHED;
            PG8_LDA(At, 0, 1); PG8_STAGE(PG8_SB(0, 0), b2, voffB); PG8_STAGE(PG8_SB(0, 1), b2 + hstep, voffB); PG8_STAGE(PG8_SA(0, 0), a2, voffA);
            PG8_WAIT_V(8); PG8_WAIT_L(0); PG8_BAR; PG8_MMA(1, 0, At, B0); PG8_MMA(1, 1, At, B1); PG8_BAR; PG8_SCHED;
            PG8_LDB(B0, 1, 0); PG8_LDB(B1, 1, 1); PG8_SCHED; PG8_LDA(At, 1, 0); PG8_STAGE(PG8_SA(0, 1), a2 + hstep, voffA);
            PG8_WAIT_V(8); PG8_WAIT_L(0); PG8_BAR; PG8_MMA(0, 0, At, B0); PG8_MMA(0, 1, At, B1); PG8_BAR; PG8_SCHED;
            PG8_LDA(At, 1, 1); PG8_STAGE(PG8_SB(1, 0), b3, voffB); PG8_STAGE(PG8_SB(1, 1), b3 + hstep, voffB); PG8_STAGE(PG8_SA(1, 0), a3, voffA);
            PG8_WAIT_V(8); PG8_WAIT_L(0); PG8_BAR; PG8_MMA(1, 0, At, B0); PG8_MMA(1, 1, At, B1); PG8_BAR; PG8_SCHED;
            } else {
            PG8_LDB(B0, 0, 0); PG8_SCHED; PG8_LDA(At, 0, 0); PG8_STAGE(PG8_SA(1, 1), a1 + hstep, voffA);
            PG8_WAIT_L(8); PG8_BAR; PG8_WAIT_L(0); PG8_MMA(0, 0, At, B0); PG8_BAR; PG8_SCHED;
            PG8_LDB(B1, 0, 1); PG8_STAGE(PG8_SB(0, 0), b2, voffB);
            PG8_BAR; PG8_WAIT_L(0); PG8_MMA(0, 1, At, B1); PG8_BAR;
            PG8_LDA(At, 0, 1); PG8_STAGE(PG8_SA(0, 0), a2, voffA);
            PG8_BAR; PG8_WAIT_L(0); PG8_MMA(1, 0, At, B0); PG8_BAR; PG8_SCHED;
            PG8_STAGE(PG8_SB(0, 1), b2 + hstep, voffB);
            PG8_WAIT_V(6); PG8_BAR; PG8_MMA(1, 1, At, B1); PG8_BAR;
            PG8_LDB(B0, 1, 0); PG8_SCHED; PG8_LDA(At, 1, 0); PG8_STAGE(PG8_SA(0, 1), a2 + hstep, voffA);
            PG8_WAIT_L(8); PG8_BAR; PG8_WAIT_L(0); PG8_MMA(0, 0, At, B0); PG8_BAR; PG8_SCHED;
            PG8_LDB(B1, 1, 1); PG8_STAGE(PG8_SB(1, 0), b3, voffB);
            PG8_BAR; PG8_WAIT_L(0); PG8_MMA(0, 1, At, B1); PG8_BAR;
            PG8_LDA(At, 1, 1); PG8_STAGE(PG8_SA(1, 0), a3, voffA);
            PG8_BAR; PG8_WAIT_L(0); PG8_MMA(1, 0, At, B0); PG8_BAR; PG8_SCHED;
            PG8_STAGE(PG8_SB(1, 1), b3 + hstep, voffB);
            PG8_WAIT_V(6); PG8_BAR; PG8_MMA(1, 1, At, B1); PG8_BAR;
            }
        }
        if constexpr (ALIGN_EPI) { if (wr == 0) PG8_BAR; }
        if constexpr (!Epi::AFTER_DRAIN) { E(acc, cur, wr, wc, fr, fq); S.done(cur); }
        if (!has_next) break;
#pragma unroll
        for (int a = 0; a < 2; ++a)
#pragma unroll
            for (int b = 0; b < 2; ++b)
#pragma unroll
                for (int m = 0; m < 4; ++m)
#pragma unroll
                    for (int n = 0; n < 2; ++n) acc[a][b][m][n] = (f32x4){0.f, 0.f, 0.f, 0.f};
        cur = nxt; cA = nA; cB = nB; ++ui;
        if constexpr (ALIGN_EPI) { if (wr == 1) PG8_BAR; }
    }
    PG8_WAIT_V(0);
    if constexpr (!ALIGN_EPI) { if (wr == 0) PG8_BAR; }
    PG8_BAR;
    if constexpr (Epi::AFTER_DRAIN) { E.fused(acc, cur, wr, wc, fr, fq, lds, wid, lane); S.done(cur); }
#undef PG8_SA
#undef PG8_SB
#undef PG8_STAGE
#undef PG8_LDA
#undef PG8_LDB
#undef PG8_MMA
#undef PG8_WAIT_V
#undef PG8_WAIT_L
#undef PG8_BAR
#undef PG8_SCHED
}
}

#define LAS __attribute__((address_space(3)))
typedef unsigned short bf16_t;
typedef short bf16x8 __attribute__((ext_vector_type(8)));
typedef short s16x4 __attribute__((ext_vector_type(4)));
typedef float f32x4 __attribute__((ext_vector_type(4)));
typedef unsigned u32x4 __attribute__((ext_vector_type(4)));
typedef unsigned u32x2 __attribute__((ext_vector_type(2)));

__device__ __forceinline__ float wave_sum(float v) {
#pragma unroll
    for (int o = 1; o < 64; o <<= 1) v += __shfl_xor(v, o);
    return v;
}
__device__ __forceinline__ unsigned pk2(float lo, float hi) { return pg8::cvt_pk_bf16(lo, hi); }
__device__ __forceinline__ float bflo(unsigned w) { return __uint_as_float(w << 16); }
__device__ __forceinline__ float bfhi(unsigned w) { return __uint_as_float(w & 0xffff0000u); }

constexpr size_t MiB = 1u << 20;
constexpr size_t WS_SSQ1 = 64 * 1024, WS_SSQ2 = 128 * 1024, WS_SSQ3 = 192 * 1024, WS_RSTDX = 256 * 1024;
constexpr size_t WS_LSE = 1 * MiB;
constexpr size_t WS_BT1 = 2 * MiB;
constexpr size_t WS_BT2 = 22 * MiB;
constexpr size_t WS_BT3 = 30 * MiB;
constexpr size_t WS_BT4 = 74 * MiB;
constexpr size_t WS_BT5 = 96 * MiB;
constexpr size_t WS_BT6 = 104 * MiB;
constexpr size_t WS_PB = 105 * MiB;
constexpr size_t WS_XB = 114 * MiB;
constexpr size_t WS_YMIX = 178 * MiB;
constexpr size_t WS_PROJ = 242 * MiB;
constexpr size_t WS_END = 418 * MiB;

constexpr int RING_BYTES = 131072;
constexpr int LUT_OFF = RING_BYTES;
constexpr int LDS_BYTES = 147456;

__device__ __forceinline__ void transpose_item(const float* W, int N, const float* gain, bf16_t* WT, int ldk, int drow0, int k0, int n0, LAS float* scr, int lane) {
#pragma unroll 8
    for (int i = 0; i < 32; ++i) { const int kk = 2 * i + (lane >> 5); float v = W[(size_t)(k0 + kk) * N + n0 + (lane & 31)]; if (gain) v *= gain[k0 + kk]; scr[kk * 33 + (lane & 31)] = v; }
    asm volatile("s_waitcnt lgkmcnt(0)" ::: "memory");
    const int c = lane & 7;
#pragma unroll
    for (int j = 0; j < 4; ++j) { const int n = (lane >> 3) + 8 * j; const LAS float* s = scr + (8 * c) * 33 + n;
        u32x4 o; o.x = pk2(s[0 * 33], s[1 * 33]); o.y = pk2(s[2 * 33], s[3 * 33]); o.z = pk2(s[4 * 33], s[5 * 33]); o.w = pk2(s[6 * 33], s[7 * 33]);
        *(u32x4*)(WT + (size_t)(drow0 + n) * ldk + k0 + 8 * c) = o; }
    asm volatile("s_waitcnt lgkmcnt(0)" ::: "memory");
}

struct Ptrs {
    const float *x, *p, *rel_bias, *g_mix, *w_in, *pool_w, *pool_scale, *w_out, *g_ffn, *w_gate, *w_up, *w_down, *g_ple, *w_pg, *w_pp, *g_final;
    float* out; unsigned char* ws;
};

__device__ __forceinline__ void prologue(const Ptrs& P, LAS unsigned char* lds, int gw, int NGW, int wid, int lane) {
    unsigned char* ws = P.ws;
    LAS float* scr = (LAS float*)(lds + wid * 16384);
    bf16_t* BT1 = (bf16_t*)(ws + WS_BT1); bf16_t* BT2 = (bf16_t*)(ws + WS_BT2); bf16_t* BT3 = (bf16_t*)(ws + WS_BT3);
    bf16_t* BT4 = (bf16_t*)(ws + WS_BT4); bf16_t* BT5 = (bf16_t*)(ws + WS_BT5); bf16_t* BT6 = (bf16_t*)(ws + WS_BT6);
    constexpr int I_IN = (DM / 64) * (NIN / 32);
    constexpr int I_OUT = ((DM - 512) / 64) * (DM / 32);
    constexpr int I_G = (DM / 64) * (DFF / 32);
    constexpr int I_DN = (DFF / 64) * (DM / 32);
    constexpr int I_PG = (DM / 64) * (DM / 32);
    constexpr int I_PP = (DPLE / 64) * (DM / 32);
    constexpr int NITEMS = I_IN + I_OUT + 2 * I_G + I_DN + I_PG + I_PP;
    for (int it = gw; it < NITEMS; it += NGW) {
        int r = it;
        if (r < I_IN) { const int nb = NIN / 32, kb = r / nb, n0 = 32 * (r % nb); transpose_item(P.w_in, NIN, P.g_mix, BT1, DM, n0, 64 * kb, n0, scr, lane); continue; } r -= I_IN;
        if (r < I_OUT) { const int nb = DM / 32, kb = r / nb, n0 = 32 * (r % nb); transpose_item(P.w_out, DM, nullptr, BT2, DM, n0, 512 + 64 * kb, n0, scr, lane); continue; } r -= I_OUT;
        if (r < I_G) { const int nb = DFF / 32, kb = r / nb, n0 = 32 * (r % nb); transpose_item(P.w_gate, DFF, P.g_ffn, BT3, DM, (n0 >> 7) * 256 + (n0 & 127), 64 * kb, n0, scr, lane); continue; } r -= I_G;
        if (r < I_G) { const int nb = DFF / 32, kb = r / nb, n0 = 32 * (r % nb); transpose_item(P.w_up, DFF, P.g_ffn, BT3, DM, (n0 >> 7) * 256 + 128 + (n0 & 127), 64 * kb, n0, scr, lane); continue; } r -= I_G;
        if (r < I_DN) { const int nb = DM / 32, kb = r / nb, n0 = 32 * (r % nb); transpose_item(P.w_down, DM, nullptr, BT4, DFF, n0, 64 * kb, n0, scr, lane); continue; } r -= I_DN;
        if (r < I_PG) { const int nb = DM / 32, kb = r / nb, n0 = 32 * (r % nb); transpose_item(P.w_pg, DM, P.g_ple, BT5, DM, n0, 64 * kb, n0, scr, lane); continue; } r -= I_PG;
        { const int nb = DM / 32, kb = r / nb, n0 = 32 * (r % nb); transpose_item(P.w_pp, DM, nullptr, BT6, DPLE, n0, 64 * kb, n0, scr, lane); }
    }
    for (int it = gw; it < 1024; it += NGW) {
        const int kq = it >> 3, nc = it & 7, k4 = kq * 4, g = k4 >> 7, n = nc * 256 + lane * 4;
        f32x4 acc[4] = {{0.f, 0.f, 0.f, 0.f}, {0.f, 0.f, 0.f, 0.f}, {0.f, 0.f, 0.f, 0.f}, {0.f, 0.f, 0.f, 0.f}};
        const float* pw = P.pool_w + (size_t)k4 * 128;
        const float* ps = P.pool_scale + g * 128;
        const float* wo = P.w_out + (size_t)(g * 128) * DM + n;
#pragma unroll 4
        for (int d = 0; d < 128; ++d) {
            const f32x4 wv = *(const f32x4*)(wo + (size_t)d * DM); const float sc = ps[d];
#pragma unroll
            for (int cc = 0; cc < 4; ++cc) acc[cc] += (pw[cc * 128 + d] * sc) * wv;
        }
#pragma unroll
        for (int j = 0; j < 4; ++j) { u32x2 o; o.x = pk2(acc[0][j], acc[1][j]); o.y = pk2(acc[2][j], acc[3][j]); *(u32x2*)(BT2 + (size_t)(n + j) * DM + k4) = o; }
    }
    bf16_t* XB = (bf16_t*)(ws + WS_XB); float* rstdx = (float*)(ws + WS_RSTDX);
    for (int row = gw; row < MROWS; row += NGW) {
        const float* xr = P.x + (size_t)row * DM + lane * 8; f32x4 v[4][2]; float s = 0.f;
#pragma unroll
        for (int j = 0; j < 4; ++j) { v[j][0] = *(const f32x4*)(xr + 512 * j); v[j][1] = *(const f32x4*)(xr + 512 * j + 4); s += pg8::dot4(v[j][0]) + pg8::dot4(v[j][1]); }
        s = wave_sum(s);
        if (lane == 0) rstdx[row] = 1.0f / sqrtf(s * (1.0f / DM) + RMS_EPS);
        bf16_t* o = XB + (size_t)row * DM + lane * 8;
#pragma unroll
        for (int j = 0; j < 4; ++j) *(u32x4*)(o + 512 * j) = pg8::pack8(v[j][0], v[j][1]);
    }
    bf16_t* PB = (bf16_t*)(ws + WS_PB);
    for (int c = gw * 64 + lane; c < MROWS * DPLE / 8; c += NGW * 64) {
        const f32x4 a = *(const f32x4*)(P.p + (size_t)c * 8), b = *(const f32x4*)(P.p + (size_t)c * 8 + 4);
        *(u32x4*)(PB + (size_t)c * 8) = pg8::pack8(a, b);
    }
    float* z = (float*)(ws + WS_SSQ1);
    for (int c = gw * 64 + lane; c < 3 * MROWS; c += NGW * 64) z[c] = 0.f;
}

__device__ __forceinline__ void ld8(const bf16_t* p, float (&f)[8]) { const u32x4 w = *(const u32x4*)p; f[0] = bflo(w.x); f[1] = bfhi(w.x); f[2] = bflo(w.y); f[3] = bfhi(w.y); f[4] = bflo(w.z); f[5] = bfhi(w.z); f[6] = bflo(w.w); f[7] = bfhi(w.w); }
__device__ __forceinline__ void pool_item(const bf16_t* proj, bf16_t* ymix, int item, int lane) {
    const int gi = item & 3, tg = item >> 2, w = 2 << gi, rq = lane >> 4, oct = lane & 15;
    const int t0 = tg * 16 + rq * 4, pos0 = t0 & (SEQ - 1), col = gi * 128 + oct * 8;
    const bf16_t* u = proj + (size_t)t0 * NIN + col;
    float acc[8] = {0.f, 0.f, 0.f, 0.f, 0.f, 0.f, 0.f, 0.f}, f[8];
#pragma unroll
    for (int k = 1; k < 16; ++k) if (k < w && pos0 - k >= 0) { ld8(u - (size_t)k * NIN, f);
#pragma unroll
        for (int e = 0; e < 8; ++e) acc[e] += f[e]; }
#pragma unroll
    for (int i = 0; i < 4; ++i) {
        float cur[8]; ld8(u + (size_t)i * NIN, cur);
#pragma unroll
        for (int e = 0; e < 8; ++e) acc[e] += cur[e];
        if (i > 0 && pos0 + i - w >= 0) { ld8(u + (size_t)(i - w) * NIN, f);
#pragma unroll
            for (int e = 0; e < 8; ++e) acc[e] -= f[e]; }
        const int cnt = (pos0 + i + 1 < w) ? (pos0 + i + 1) : w; const float ic = 1.0f / (float)cnt;
        u32x4 o; o.x = pk2(acc[0] * ic - cur[0], acc[1] * ic - cur[1]); o.y = pk2(acc[2] * ic - cur[2], acc[3] * ic - cur[3]);
        o.z = pk2(acc[4] * ic - cur[4], acc[5] * ic - cur[5]); o.w = pk2(acc[6] * ic - cur[6], acc[7] * ic - cur[7]);
        *(u32x4*)(ymix + (size_t)(t0 + i) * DM + col) = o;
    }
}

__device__ const unsigned char T5_BUCKET[3][129] = {
{0,1,2,3,4,5,6,7,8,9,10,11,12,13,14,15,16,16,16,16,16,16,17,17,17,17,17,17,17,17,18,18,18,18,18,18,18,18,18,18,19,19,19,19,19,19,19,19,19,19,19,19,19,19,20,20,20,20,20,20,20,20,20,20,20,20,20,20,20,20,20,20,20,21,21,21,21,21,21,21,21,21,21,21,21,21,21,21,21,21,21,21,21,21,21,21,21,21,21,22,22,22,22,22,22,22,22,22,22,22,22,22,22,22,22,22,22,22,22,22,22,22,22,22,22,22,22,22,22},
{0,4,8,12,16,16,17,17,18,18,19,19,19,19,20,20,20,20,20,21,21,21,21,21,21,22,22,22,22,22,22,22,22,22,23,23,23,23,23,23,23,23,23,23,23,23,24,24,24,24,24,24,24,24,24,24,24,24,24,24,24,24,25,25,25,25,25,25,25,25,25,25,25,25,25,25,25,25,25,25,25,25,25,26,26,26,26,26,26,26,26,26,26,26,26,26,26,26,26,26,26,26,26,26,26,26,26,26,26,26,26,26,26,27,27,27,27,27,27,27,27,27,27,27,27,27,27,27,27},
{0,16,18,19,20,21,21,22,22,23,23,23,24,24,24,24,25,25,25,25,25,26,26,26,26,26,26,26,26,27,27,27,27,27,27,27,27,27,27,28,28,28,28,28,28,28,28,28,28,28,28,28,29,29,29,29,29,29,29,29,29,29,29,29,29,29,29,29,29,29,30,30,30,30,30,30,30,30,30,30,30,30,30,30,30,30,30,30,30,30,30,30,30,30,30,31,31,31,31,31,31,31,31,31,31,31,31,31,31,31,31,31,31,31,31,31,31,31,31,31,31,31,31,31,31,31,31,31,31}};

__device__ __forceinline__ s16x4 vtr(LAS const unsigned char* p) { typedef short v4i16_t __attribute__((ext_vector_type(4))); return __builtin_bit_cast(s16x4, __builtin_amdgcn_ds_read_tr16_b64_v4i16((LAS v4i16_t*)p)); }

__device__ __forceinline__ void attn_item(LAS unsigned char* lds, const bf16_t* proj, bf16_t* ymix, float* lse, const float* rel_bias, int item) {
    const int tid = threadIdx.x, lane = tid & 63, wid = __builtin_amdgcn_readfirstlane(tid >> 6), fr = lane & 15, fq = lane >> 4;
    const int g = item >> 9, idx = item & 511, dsh = 2 * g, d = 1 << dsh, nbsh = 6 - dsh;
    const int seq = idx >> nbsh, n = idx & ((1 << nbsh) - 1), r = seq & (d - 1), bh = seq >> dsh, hl = bh & 3, b = bh >> 2, head = g * 4 + hl;
    const size_t rowbase = (size_t)b * SEQ;
    const bf16_t* kbase = proj + 2048 + head * HD; const bf16_t* vbase = proj + 3584 + head * HD;
#pragma unroll
    for (int j = 0; j < 8; ++j) {
        const int piece = wid * 8 + j, key = piece * 4 + (lane >> 4), cp = lane & 15;
        int l = 128 * (n - 1) + key; if (l < 0) l += 128;
        const size_t grow = rowbase + ((size_t)l << dsh) + r;
        const int kc = cp ^ (key & 15), vc = (((cp >> 1) ^ (key & 7)) << 1) | (cp & 1);
        __builtin_amdgcn_global_load_lds((const unsigned*)(kbase + grow * NIN + kc * 8), (LAS unsigned*)(lds + piece * 1024), 16, 0, 0);
        __builtin_amdgcn_global_load_lds((const unsigned*)(vbase + grow * NIN + vc * 8), (LAS unsigned*)(lds + 65536 + piece * 1024), 16, 0, 0);
    }
    if (tid < 129) ((LAS float*)(lds + LUT_OFF))[tid] = rel_bias[(int)T5_BUCKET[g][tid] * NHEADS + head] * LOG2E;
    const int q0 = wid * 16;
    const size_t qrow = rowbase + ((size_t)(128 * n + q0 + fr) << dsh) + r;
    bf16x8 qf[4];
#pragma unroll
    for (int s = 0; s < 4; ++s) qf[s] = *(const bf16x8*)(proj + qrow * NIN + 512 + head * HD + 32 * s + 8 * fq);
    asm volatile("s_waitcnt vmcnt(0) lgkmcnt(0)" ::: "memory");
    __syncthreads();
    f32x4 sc[9];
#pragma unroll
    for (int jt = 0; jt < 9; ++jt) {
        f32x4 a = {0.f, 0.f, 0.f, 0.f};
        LAS const unsigned char* kp = lds + (q0 + 16 * jt + fr) * 256;
#pragma unroll
        for (int s = 0; s < 4; ++s) { const bf16x8 kf = *(LAS const bf16x8*)(kp + (((4 * s + fq) ^ fr) << 4)); a = __builtin_amdgcn_mfma_f32_16x16x32_bf16(kf, qf[s], a, 0, 0, 0); }
        sc[jt] = a;
    }
    LAS const float* lut = (LAS const float*)(lds + LUT_OFF);
    float mx = -3.0e38f;
#pragma unroll
    for (int jt = 0; jt < 9; ++jt)
#pragma unroll
        for (int e = 0; e < 4; ++e) {
            const int off = 128 + fr - 16 * jt - 4 * fq - e, ki = q0 + 16 * jt + 4 * fq + e;
            const bool ok = (off >= 0) && (off <= 128) && (n > 0 || ki >= 128);
            const int oc = off < 0 ? 0 : (off > 128 ? 128 : off);
            const float v = ok ? sc[jt][e] + lut[oc] : -1.0e30f;
            sc[jt][e] = v; mx = fmaxf(mx, v);
        }
    mx = fmaxf(mx, __shfl_xor(mx, 16)); mx = fmaxf(mx, __shfl_xor(mx, 32));
    float den = 0.f;
#pragma unroll
    for (int jt = 0; jt < 9; ++jt)
#pragma unroll
        for (int e = 0; e < 4; ++e) { const float pv = __builtin_amdgcn_exp2f(sc[jt][e] - mx); sc[jt][e] = pv; den += pv; }
    den += __shfl_xor(den, 16); den += __shfl_xor(den, 32);
    bf16x8 pb[5];
#pragma unroll
    for (int ks = 0; ks < 5; ++ks) {
        u32x4 w; w.x = pk2(sc[2 * ks][0], sc[2 * ks][1]); w.y = pk2(sc[2 * ks][2], sc[2 * ks][3]);
        if (ks < 4) { w.z = pk2(sc[2 * ks + 1][0], sc[2 * ks + 1][1]); w.w = pk2(sc[2 * ks + 1][2], sc[2 * ks + 1][3]); } else { w.z = 0u; w.w = 0u; }
        pb[ks] = __builtin_bit_cast(bf16x8, w);
    }
    f32x4 o[8];
#pragma unroll
    for (int db = 0; db < 8; ++db) o[db] = (f32x4){0.f, 0.f, 0.f, 0.f};
#pragma unroll
    for (int ks = 0; ks < 5; ++ks) {
        const int rowA = q0 + 32 * ks + 4 * fq + (fr >> 2), rowB = (ks < 4) ? rowA + 16 : rowA;
        LAS const unsigned char* va = lds + 65536 + rowA * 256 + 8 * (fr & 3);
        LAS const unsigned char* vb = lds + 65536 + rowB * 256 + 8 * (fr & 3);
#pragma unroll
        for (int db = 0; db < 8; ++db) {
            const s16x4 lo = vtr(va + ((db ^ (rowA & 7)) << 5)), hi = vtr(vb + ((db ^ (rowB & 7)) << 5));
            const bf16x8 vf = {lo[0], lo[1], lo[2], lo[3], hi[0], hi[1], hi[2], hi[3]};
            o[db] = __builtin_amdgcn_mfma_f32_16x16x32_bf16(vf, pb[ks], o[db], 0, 0, 0);
        }
    }
    const float inv = 1.0f / den;
    bf16_t* orow = ymix + qrow * DM + 512 + head * HD + 4 * fq;
#pragma unroll
    for (int db = 0; db < 8; ++db) { u32x2 w; w.x = pk2(o[db][0] * inv, o[db][1] * inv); w.y = pk2(o[db][2] * inv, o[db][3] * inv); *(u32x2*)(orow + 16 * db) = w; }
    if (fq == 0) lse[qrow * NHEADS + head] = (mx + __builtin_amdgcn_logf(den)) * LN2;
    asm volatile("s_waitcnt lgkmcnt(0)" ::: "memory");
    __syncthreads();
}

__device__ __forceinline__ void mix_row(bf16_t* ymix, const float* lse, int row, int lane) {
    const int hs = lane >> 4; const float* l = lse + (size_t)row * NHEADS + hs;
    const float l0 = l[0], l1 = l[4], l2 = l[8], m = fmaxf(l0, fmaxf(l1, l2));
    const float e0 = __expf(l0 - m), e1 = __expf(l1 - m), e2 = __expf(l2 - m), inv = 1.0f / (e0 + e1 + e2);
    const float al[3] = {e0 * inv, e1 * inv, e2 * inv};
    bf16_t* y = ymix + (size_t)row * DM + 512 + lane * 8;
#pragma unroll
    for (int j = 0; j < 3; ++j) { const u32x4 w = *(const u32x4*)(y + 512 * j); const float a = al[j]; u32x4 o;
        o.x = pk2(bflo(w.x) * a, bfhi(w.x) * a); o.y = pk2(bflo(w.y) * a, bfhi(w.y) * a); o.z = pk2(bflo(w.z) * a, bfhi(w.z) * a); o.w = pk2(bflo(w.w) * a, bfhi(w.w) * a);
        *(u32x4*)(y + 512 * j) = o; }
}
__device__ __forceinline__ void final_row(float* out, const float* ssq, const float* gfin, int row, int lane) {
    const float r = 1.0f / sqrtf(ssq[row] * (1.0f / DM) + RMS_EPS);
    float* o = out + (size_t)row * DM + lane * 4;
#pragma unroll
    for (int j = 0; j < 8; ++j) { const f32x4 v = *(const f32x4*)(o + 256 * j), gg = *(const f32x4*)(gfin + lane * 4 + 256 * j); *(f32x4*)(o + 256 * j) = v * r * gg; }
}

struct Args { const float* in[16]; float* out; unsigned char* ws; };

#define PG8_ALIGN true
#define PG8_SP2 true

__global__ void __launch_bounds__(512, 2) hymba_fwd(Args args) {
    extern __shared__ __attribute__((aligned(16))) unsigned char lds_raw[];
    LAS unsigned char* lds = (LAS unsigned char*)lds_raw;
    cg::grid_group grid = cg::this_grid();
    const int tid = threadIdx.x, lane = tid & 63, wid = __builtin_amdgcn_readfirstlane(tid >> 6);
    const int G = gridDim.x, bx = blockIdx.x;
    const int vcu = (G % 8 == 0) ? (bx % 8) * (G / 8) + bx / 8 : bx;
    const int gw = vcu * 8 + wid, NGW = G * 8;
    Ptrs P;
    P.x = args.in[0]; P.p = args.in[1]; P.rel_bias = args.in[2]; P.g_mix = args.in[3]; P.w_in = args.in[4]; P.pool_w = args.in[5]; P.pool_scale = args.in[6]; P.w_out = args.in[7];
    P.g_ffn = args.in[8]; P.w_gate = args.in[9]; P.w_up = args.in[10]; P.w_down = args.in[11]; P.g_ple = args.in[12]; P.w_pg = args.in[13]; P.w_pp = args.in[14]; P.g_final = args.in[15];
    P.out = args.out; P.ws = args.ws;
    unsigned char* ws = args.ws;
    bf16_t* BT1 = (bf16_t*)(ws + WS_BT1); bf16_t* BT2 = (bf16_t*)(ws + WS_BT2); bf16_t* BT3 = (bf16_t*)(ws + WS_BT3);
    bf16_t* BT4 = (bf16_t*)(ws + WS_BT4); bf16_t* BT5 = (bf16_t*)(ws + WS_BT5); bf16_t* BT6 = (bf16_t*)(ws + WS_BT6);
    bf16_t* PB = (bf16_t*)(ws + WS_PB); bf16_t* XB = (bf16_t*)(ws + WS_XB); bf16_t* YMIX = (bf16_t*)(ws + WS_YMIX); bf16_t* PROJ = (bf16_t*)(ws + WS_PROJ);
    float* SSQ1 = (float*)(ws + WS_SSQ1); float* SSQ2 = (float*)(ws + WS_SSQ2); float* SSQ3 = (float*)(ws + WS_SSQ3); float* RSTDX = (float*)(ws + WS_RSTDX); float* LSE = (float*)(ws + WS_LSE);

    prologue(P, lds, gw, NGW, wid, lane);
    grid.sync();

    { pg8::Gemm g{XB, BT1, MROWS, NIN, DM}; pg8::StaticOrder S; S.init(MROWS, NIN, G, bx);
      pg8::EpiProj E{PROJ, NIN, RSTDX, 2, 8, QSCALE};
      pg8::gemm_phase<pg8::EpiProj, pg8::StaticOrder, PG8_ALIGN, PG8_SP2>(lds, g, S, E); }
    grid.sync();

    { const int per = (1536 + G - 1) / G;
      for (int i = 0; i < per; ++i) { const int item = vcu * per + i; if (item >= 1536) break; attn_item(lds, PROJ, YMIX, LSE, P.rel_bias, item); }
      for (int it = gw; it < 4096; it += NGW) pool_item(PROJ, YMIX, it, lane); }
    grid.sync();

    for (int row = gw; row < MROWS; row += NGW) mix_row(YMIX, LSE, row, lane);
    grid.sync();

    { pg8::Gemm g{YMIX, BT2, MROWS, DM, DM}; pg8::StaticOrder S; S.init(MROWS, DM, G, bx);
      pg8::EpiRes E{P.x, P.out, XB, SSQ1, DM};
      pg8::gemm_phase<pg8::EpiRes, pg8::StaticOrder, PG8_ALIGN, PG8_SP2>(lds, g, S, E); }
    grid.sync();

    { pg8::Gemm g{XB, BT3, MROWS, 2 * DFF, DM}; pg8::StaticOrder S; S.init(MROWS, 2 * DFF, G, bx);
      pg8::EpiSwiGLU E{PROJ, DFF, SSQ1, 1.0f / DM, RMS_EPS};
      pg8::gemm_phase<pg8::EpiSwiGLU, pg8::StaticOrder, PG8_ALIGN, PG8_SP2>(lds, g, S, E); }
    { int kpp = DPLE; asm volatile("" : "+s"(kpp));
      pg8::Gemm g{PB, BT6, MROWS, DM, kpp}; pg8::StaticOrder S; S.init(MROWS, DM, G, bx);
      pg8::EpiPlain E{YMIX, DM};
      pg8::gemm_phase<pg8::EpiPlain, pg8::StaticOrder, PG8_ALIGN, PG8_SP2>(lds, g, S, E); }
    grid.sync();

    { pg8::Gemm g{PROJ, BT4, MROWS, DM, DFF}; pg8::StaticOrder S; S.init(MROWS, DM, G, bx);
      pg8::EpiRes E{P.out, P.out, XB, SSQ2, DM};
      pg8::gemm_phase<pg8::EpiRes, pg8::StaticOrder, PG8_ALIGN, PG8_SP2>(lds, g, S, E); }
    grid.sync();

    { pg8::Gemm g{XB, BT5, MROWS, DM, DM}; pg8::StaticOrder S; S.init(MROWS, DM, G, bx);
      pg8::EpiPle E{P.out, YMIX, SSQ2, SSQ3, DM, 1.0f / DM, RMS_EPS};
      pg8::gemm_phase<pg8::EpiPle, pg8::StaticOrder, PG8_ALIGN, PG8_SP2>(lds, g, S, E); }
    grid.sync();

    for (int row = gw; row < MROWS; row += NGW) final_row(P.out, SSQ3, P.g_final, row, lane);
}

extern "C" void kernel_launch(void* const* d_in, const int* in_sizes, int n_in, void* d_out, int out_size, void* d_ws, size_t ws_size, hipStream_t stream) {
    static int grid = 0;
    if (grid == 0) {
        if (n_in != 16 || in_sizes[0] != MROWS * DM || out_size != MROWS * DM || ws_size < WS_END) {
            fprintf(stderr, "kernel_launch: unexpected shapes (n_in %d, in0 %d, out %d, ws %zu); nothing launched\n", n_in, n_in > 0 ? in_sizes[0] : -1, out_size, ws_size); grid = -1; return; }
        int dev = 0, cus = 0, per_cu = 0;
        if (hipGetDevice(&dev) != hipSuccess || hipDeviceGetAttribute(&cus, hipDeviceAttributeMultiprocessorCount, dev) != hipSuccess) { fprintf(stderr, "kernel_launch: device query failed\n"); grid = -1; return; }
        if (hipFuncSetAttribute((const void*)hymba_fwd, hipFuncAttributeMaxDynamicSharedMemorySize, LDS_BYTES) != hipSuccess) { fprintf(stderr, "kernel_launch: hipFuncSetAttribute failed\n"); grid = -1; return; }
        if (hipOccupancyMaxActiveBlocksPerMultiprocessor(&per_cu, (const void*)hymba_fwd, 512, LDS_BYTES) != hipSuccess || per_cu < 1) { fprintf(stderr, "kernel_launch: occupancy query says %d blocks per CU\n", per_cu); (void)hipGetLastError(); per_cu = 1; }
        if (per_cu > 1) per_cu = 1;
        grid = cus * per_cu;
    }
    if (grid < 0) return;
    Args a{};
    for (int i = 0; i < 16; ++i) a.in[i] = (const float*)d_in[i];
    a.out = (float*)d_out; a.ws = (unsigned char*)d_ws;
    void* kargs[] = {&a};
    hipError_t e = hipLaunchCooperativeKernel((const void*)hymba_fwd, dim3(grid), dim3(512), kargs, LDS_BYTES, stream);
    if (e != hipSuccess) fprintf(stderr, "kernel_launch: cooperative launch failed: %s (grid %d)\n", hipGetErrorString(e), grid);
}
```

```cpp
#include <hip/hip_runtime.h>
#include <hip/hip_cooperative_groups.h>
#include <cstdio>
#include <cstdint>
namespace cg = cooperative_groups;

constexpr int BATCH = 2, SEQ = 8192, DM = 2048, MROWS = BATCH * SEQ, NIN = 5120, DFF = 5632, DPLE = 256, NHEADS = 12, HD = 128;
constexpr float RMS_EPS = 1e-6f;
constexpr float QSCALE = 0.08838834764831845f * 1.4426950408889634f;
constexpr float LOG2E = 1.4426950408889634f, LN2 = 0.6931471805599453f;
namespace pg8 {
#define PG8_LAS __attribute__((address_space(3)))
typedef unsigned short bf16_t;
typedef short bf16x8 __attribute__((ext_vector_type(8)));
typedef float f32x4 __attribute__((ext_vector_type(4)));
typedef unsigned u32x4 __attribute__((ext_vector_type(4)));
constexpr int BM = 256, BK = 64, HALF = 128, HTB = HALF * BK * 2  , STAGE_BYTES = 8 * HTB, NXCD = 8, WGM = 8;

__host__ __device__ __forceinline__ int lds_byte(int r, int c) { const int st = (r >> 4) * 2 + (c >> 5), rr = r & 15, cc = c & 31, ob = rr * 64 + cc * 2; return st * 1024 + (ob ^ (((ob >> 9) & 1) << 5)); }
__host__ __device__ __forceinline__ void stage_rc(int b, int& R, int& C) { const int st = b / 1024, sb = b % 1024, swz = sb ^ (((sb >> 9) & 1) << 5); R = (st >> 1) * 16 + swz / 64; C = (st & 1) * 32 + (swz % 64) / 2; }
__host__ __device__ __forceinline__ int perm32(int rho) { const int n = rho >> 4, i = rho & 15; return 8 * (i >> 2) + 4 * n + (i & 3); }

struct Unit { int pm, pn; };
struct Gemm { const bf16_t* A; const bf16_t* Bt; int M, N, K; };

struct StaticOrder {
    int nM, nN, nwg, G, c;
    __host__ __device__ void init(int M, int N, int G_, int c_) { nM = M / BM; nN = N / BM; nwg = nM * nN; G = G_; c = c_; }
    __host__ __device__ bool next(int i, Unit& u) const {
        const long L = (long)i * G + c; if (L >= nwg) return false;
        int wgid = (int)L; { const int q = nwg / NXCD, r = nwg % NXCD, xcd = wgid % NXCD, off = wgid / NXCD; wgid = (xcd < r ? xcd * (q + 1) : r * (q + 1) + (xcd - r) * q) + off; }
        const int nig = WGM * nN, gid = wgid / nig, fm = gid * WGM, gsz = (nM - fm) < WGM ? (nM - fm) : WGM;
        u.pm = fm + ((wgid % nig) % gsz); u.pn = (wgid % nig) / gsz; return true;
    }
    __device__ __forceinline__ void a_ready(const Unit&) const {}
    __device__ __forceinline__ void done(const Unit&) const {}
};

__device__ __forceinline__ unsigned cvt_pk_bf16(float lo, float hi) { unsigned r; asm volatile("v_cvt_pk_bf16_f32 %0, %1, %2" : "=v"(r) : "v"(lo), "v"(hi)); return r; }
__device__ __forceinline__ u32x4 pack8(const f32x4 v0, const f32x4 v1) { u32x4 w; w.x = cvt_pk_bf16(v0[0], v0[1]); w.y = cvt_pk_bf16(v0[2], v0[3]); w.z = cvt_pk_bf16(v1[0], v1[1]); w.w = cvt_pk_bf16(v1[2], v1[3]); return w; }
__device__ __forceinline__ float bf_lo(unsigned w) { return __uint_as_float(w << 16); }
__device__ __forceinline__ float bf_hi(unsigned w) { return __uint_as_float(w & 0xffff0000u); }
__device__ __forceinline__ float dot4(const f32x4 v) { return (v[0] * v[0] + v[1] * v[1]) + (v[2] * v[2] + v[3] * v[3]); }

struct EpiProj {
    static constexpr bool PERM = true, AFTER_DRAIN = false;
    bf16_t* O; int ldc; const float* rstd; int q_lo, q_hi; float qscale;
    __device__ __forceinline__ void operator()(const f32x4 (&acc)[2][2][4][2], const Unit& u, int wr, int wc, int fr, int fq) const {
        const int row0 = u.pm * BM + wr * 64 + fr, col0 = u.pn * BM + wc * 32 + 8 * fq;
        const float qs = (u.pn >= q_lo && u.pn < q_hi) ? qscale : 1.0f;
#pragma unroll
        for (int ai = 0; ai < 2; ++ai)
#pragma unroll
            for (int m = 0; m < 4; ++m) { const int row = row0 + ai * HALF + m * 16; const float s = rstd[row] * qs; bf16_t* rowp = O + (size_t)row * ldc + col0;
#pragma unroll
                for (int bj = 0; bj < 2; ++bj) *(u32x4*)(rowp + bj * HALF) = pack8(acc[ai][bj][m][0] * s, acc[ai][bj][m][1] * s); }
    }
};
struct EpiPlain {
    static constexpr bool PERM = true, AFTER_DRAIN = false;
    bf16_t* O; int ldc;
    __device__ __forceinline__ void operator()(const f32x4 (&acc)[2][2][4][2], const Unit& u, int wr, int wc, int fr, int fq) const {
        const int row0 = u.pm * BM + wr * 64 + fr, col0 = u.pn * BM + wc * 32 + 8 * fq;
#pragma unroll
        for (int ai = 0; ai < 2; ++ai)
#pragma unroll
            for (int m = 0; m < 4; ++m) { bf16_t* rowp = O + (size_t)(row0 + ai * HALF + m * 16) * ldc + col0;
#pragma unroll
                for (int bj = 0; bj < 2; ++bj) *(u32x4*)(rowp + bj * HALF) = pack8(acc[ai][bj][m][0], acc[ai][bj][m][1]); }
    }
};
struct EpiRes {
    static constexpr bool PERM = true, AFTER_DRAIN = false;
    const float* base; float* out; bf16_t* ob; float* ssq; int ldc;
    __device__ __forceinline__ void operator()(const f32x4 (&acc)[2][2][4][2], const Unit& u, int wr, int wc, int fr, int fq) const {
        const int row0 = u.pm * BM + wr * 64 + fr, col0 = u.pn * BM + wc * 32 + 8 * fq;
#pragma unroll
        for (int ai = 0; ai < 2; ++ai)
#pragma unroll
            for (int m = 0; m < 4; ++m) { const int row = row0 + ai * HALF + m * 16; const size_t off = (size_t)row * ldc + col0; float s = 0.f;
#pragma unroll
                for (int bj = 0; bj < 2; ++bj) {
                    const f32x4 v0 = *(const f32x4*)(base + off + bj * HALF) + acc[ai][bj][m][0], v1 = *(const f32x4*)(base + off + bj * HALF + 4) + acc[ai][bj][m][1];
                    *(f32x4*)(out + off + bj * HALF) = v0; *(f32x4*)(out + off + bj * HALF + 4) = v1;
                    *(u32x4*)(ob + off + bj * HALF) = pack8(v0, v1);
                    s += dot4(v0) + dot4(v1); }
                s += __shfl_xor(s, 16); s += __shfl_xor(s, 32);
                if (fq == 0) atomicAdd(ssq + row, s);
                if (m & 1) asm volatile("" ::: "memory"); }
    }
};
struct EpiSwiGLU {
    static constexpr bool PERM = true, AFTER_DRAIN = false;
    bf16_t* O; int ldc; const float* ssq; float inv_d, eps;
    __device__ __forceinline__ void operator()(const f32x4 (&acc)[2][2][4][2], const Unit& u, int wr, int wc, int fr, int fq) const {
        const int row0 = u.pm * BM + wr * 64 + fr, col0 = u.pn * HALF + wc * 32 + 8 * fq;
#pragma unroll
        for (int ai = 0; ai < 2; ++ai)
#pragma unroll
            for (int m = 0; m < 4; ++m) { const int row = row0 + ai * HALF + m * 16; const float r = __builtin_amdgcn_rsqf(ssq[row] * inv_d + eps);
                f32x4 o[2];
#pragma unroll
                for (int n = 0; n < 2; ++n)
#pragma unroll
                    for (int j = 0; j < 4; ++j) { const float g = acc[ai][0][m][n][j] * r, up = acc[ai][1][m][n][j] * r;
                        o[n][j] = g * up * __builtin_amdgcn_rcpf(1.0f + __builtin_amdgcn_exp2f(-1.4426950408889634f * g)); }
                *(u32x4*)(O + (size_t)row * ldc + col0) = pack8(o[0], o[1]); }
    }
};
struct EpiPle {
    static constexpr bool PERM = true, AFTER_DRAIN = false;
    float* h; const bf16_t* pp; const float* ssq2; float* ssq3; int ldc; float inv_d, eps;
    __device__ __forceinline__ void operator()(const f32x4 (&acc)[2][2][4][2], const Unit& u, int wr, int wc, int fr, int fq) const {
        const int row0 = u.pm * BM + wr * 64 + fr, col0 = u.pn * BM + wc * 32 + 8 * fq;
#pragma unroll
        for (int ai = 0; ai < 2; ++ai)
#pragma unroll
            for (int m = 0; m < 4; ++m) { const int row = row0 + ai * HALF + m * 16; const size_t off = (size_t)row * ldc + col0; float s = 0.f;
                const float r = __builtin_amdgcn_rsqf(ssq2[row] * inv_d + eps);
#pragma unroll
                for (int bj = 0; bj < 2; ++bj) {
                    const u32x4 pw = *(const u32x4*)(pp + off + bj * HALF);
                    f32x4 v0 = *(const f32x4*)(h + off + bj * HALF), v1 = *(const f32x4*)(h + off + bj * HALF + 4);
                    const f32x4 p0 = {bf_lo(pw.x), bf_hi(pw.x), bf_lo(pw.y), bf_hi(pw.y)}, p1 = {bf_lo(pw.z), bf_hi(pw.z), bf_lo(pw.w), bf_hi(pw.w)};
#pragma unroll
                    for (int j = 0; j < 4; ++j) {
                        v0[j] += p0[j] * __builtin_amdgcn_rcpf(1.0f + __builtin_amdgcn_exp2f(-1.4426950408889634f * r * acc[ai][bj][m][0][j]));
                        v1[j] += p1[j] * __builtin_amdgcn_rcpf(1.0f + __builtin_amdgcn_exp2f(-1.4426950408889634f * r * acc[ai][bj][m][1][j])); }
                    *(f32x4*)(h + off + bj * HALF) = v0; *(f32x4*)(h + off + bj * HALF + 4) = v1;
                    s += dot4(v0) + dot4(v1); }
                s += __shfl_xor(s, 16); s += __shfl_xor(s, 32);
                if (fq == 0) atomicAdd(ssq3 + row, s);
                if (m & 1) asm volatile("" ::: "memory"); }
    }
};

template <class Epi, class Sched, bool ALIGN_EPI = false, bool SP2 = false>
__device__ __forceinline__ void gemm_phase(PG8_LAS unsigned char* lds, const Gemm g, const Sched& S, const Epi& E) {
    const int tid = threadIdx.x, wid = __builtin_amdgcn_readfirstlane(tid >> 6), lane = tid & 63, wr = wid >> 2, wc = wid & 3, fr = lane & 15, fq = lane >> 4;
    const int K = g.K, nt = K / BK;
    unsigned voffA[2], voffB[2];
#pragma unroll
    for (int i = 0; i < 2; ++i) { int R, C; stage_rc(tid * 16 + i * 8192, R, C); const int Rb = Epi::PERM ? ((R & ~31) + perm32(R & 31)) : R;
        voffA[i] = (unsigned)(R * K + C) * 2u; voffB[i] = (unsigned)(Rb * K + C) * 2u; }
    const size_t kstep = (size_t)(BK * 2);
    const size_t hstep = (size_t)HALF * K * 2;
    const size_t tstep = 2 * hstep;
    const unsigned ldsw = (unsigned)wid * 1024u;
    const int aoff = lds_byte(wr * 64 + fr, fq * 8), boff = lds_byte(wc * 32 + fr, fq * 8);
#define PG8_SA(b, h) (((b) * 2 + (h)) * HTB)
#define PG8_SB(b, h) ((4 + (b) * 2 + (h)) * HTB)
#define PG8_STAGE(bufoff, gbase, voff) do { _Pragma("unroll") for (int _i = 0; _i < 2; ++_i) \
        __builtin_amdgcn_global_load_lds((const unsigned*)((const char*)(gbase) + (voff)[_i]), (PG8_LAS unsigned*)(lds + (bufoff) + ldsw + _i * 8192), 16, 0, 0); } while (0)
#define PG8_LDA(dst, b, h) do { _Pragma("unroll") for (int m = 0; m < 4; ++m) _Pragma("unroll") for (int k = 0; k < 2; ++k) dst[m][k] = *(const PG8_LAS bf16x8*)(lds + PG8_SA(b, h) + aoff + m * 2048 + k * 1024); } while (0)
#define PG8_LDB(dst, b, h) do { _Pragma("unroll") for (int n = 0; n < 2; ++n) _Pragma("unroll") for (int k = 0; k < 2; ++k) dst[n][k] = *(const PG8_LAS bf16x8*)(lds + PG8_SB(b, h) + boff + n * 2048 + k * 1024); } while (0)
#define PG8_MMA(ai, bj, At, Bt) do { __builtin_amdgcn_s_setprio(1); _Pragma("unroll") for (int m = 0; m < 4; ++m) _Pragma("unroll") for (int n = 0; n < 2; ++n) _Pragma("unroll") for (int k = 0; k < 2; ++k) \
        acc[ai][bj][m][n] = __builtin_amdgcn_mfma_f32_16x16x32_bf16(Bt[n][k], At[m][k], acc[ai][bj][m][n], 0, 0, 0); __builtin_amdgcn_s_setprio(0); } while (0)
#define PG8_WAIT_V(n) asm volatile("s_waitcnt vmcnt(" #n ")" ::: "memory")
#define PG8_WAIT_L(n) asm volatile("s_waitcnt lgkmcnt(" #n ")" ::: "memory")
#define PG8_BAR __builtin_amdgcn_s_barrier()
#define PG8_SCHED __builtin_amdgcn_sched_barrier(0)
    Unit cur, nxt; int ui = 0;
    if (!S.next(0, cur)) return;
    f32x4 acc[2][2][4][2];
#pragma unroll
    for (int a = 0; a < 2; ++a)
#pragma unroll
        for (int b = 0; b < 2; ++b)
#pragma unroll
            for (int m = 0; m < 4; ++m)
#pragma unroll
                for (int n = 0; n < 2; ++n) acc[a][b][m][n] = (f32x4){0.f, 0.f, 0.f, 0.f};
    bf16x8 At[4][2], B0[2][2], B1[2][2];
    const char* cA = (const char*)g.A + (size_t)cur.pm * tstep; const char* cB = (const char*)g.Bt + (size_t)cur.pn * tstep;
    S.a_ready(cur);
    if constexpr (SP2) {
        PG8_STAGE(PG8_SB(0, 0), cB, voffB); PG8_STAGE(PG8_SB(0, 1), cB + hstep, voffB); PG8_STAGE(PG8_SA(0, 0), cA, voffA); PG8_STAGE(PG8_SA(0, 1), cA + hstep, voffA);
        if (wr == 1) PG8_BAR;
        PG8_WAIT_V(2); PG8_BAR;
        PG8_STAGE(PG8_SB(1, 0), cB + kstep, voffB); PG8_STAGE(PG8_SA(1, 0), cA + kstep, voffA); PG8_STAGE(PG8_SB(1, 1), cB + hstep + kstep, voffB);
        PG8_WAIT_V(6); PG8_BAR;
    } else {
        PG8_STAGE(PG8_SB(0, 0), cB, voffB); PG8_STAGE(PG8_SA(0, 0), cA, voffA); PG8_STAGE(PG8_SB(0, 1), cB + hstep, voffB); PG8_STAGE(PG8_SA(0, 1), cA + hstep, voffA);
        if (wr == 1) PG8_BAR;
        PG8_WAIT_V(4); PG8_BAR;
        PG8_STAGE(PG8_SB(1, 0), cB + kstep, voffB); PG8_STAGE(PG8_SA(1, 0), cA + kstep, voffA); PG8_STAGE(PG8_SB(1, 1), cB + hstep + kstep, voffB);
        PG8_WAIT_V(6); PG8_BAR;
    }
    for (;;) {
        const bool has_next = S.next(ui + 1, nxt);
        const char* nA = has_next ? (const char*)g.A + (size_t)nxt.pm * tstep : cA; const char* nB = has_next ? (const char*)g.Bt + (size_t)nxt.pn * tstep : cB;
        for (int t = 0; t < nt; t += 2) {
            const bool last = (t == nt - 2);
            const char* a1 = cA + (size_t)(t + 1) * kstep;
            const char* a2 = last ? nA : cA + (size_t)(t + 2) * kstep; const char* b2 = last ? nB : cB + (size_t)(t + 2) * kstep;
            const char* a3 = a2 + kstep; const char* b3 = b2 + kstep;
            if (last && has_next) S.a_ready(nxt);
            if constexpr (SP2) {
            PG8_LDB(B0, 0, 0); PG8_LDB(B1, 0, 1); PG8_SCHED; PG8_LDA(At, 0, 0); PG8_STAGE(PG8_SA(1, 1), a1 + hstep, voffA);
            PG8_WAIT_V(8); PG8_WAIT_L(0); PG8_BAR; PG8_MMA(0, 0, At, B0); PG8_MMA(0, 1, At, B1); PG8_BAR; PG8_SCHED;
            PG8_LDA(At, 0, 1); PG8_STAGE(PG8_SB(0, 0), b2, voffB); PG8_STAGE(PG8_SB(0, 1), b2 + hstep, voffB); PG8_STAGE(PG8_SA(0, 0), a2, voffA);
            PG8_WAIT_V(8); PG8_WAIT_L(0); PG8_BAR; PG8_MMA(1, 0, At, B0); PG8_MMA(1, 1, At, B1); PG8_BAR; PG8_SCHED;
            PG8_LDB(B0, 1, 0); PG8_LDB(B1, 1, 1); PG8_SCHED; PG8_LDA(At, 1, 0); PG8_STAGE(PG8_SA(0, 1), a2 + hstep, voffA);
            PG8_WAIT_V(8); PG8_WAIT_L(0); PG8_BAR; PG8_MMA(0, 0, At, B0); PG8_MMA(0, 1, At, B1); PG8_BAR; PG8_SCHED;
            PG8_LDA(At, 1, 1); PG8_STAGE(PG8_SB(1, 0), b3, voffB); PG8_STAGE(PG8_SB(1, 1), b3 + hstep, voffB); PG8_STAGE(PG8_SA(1, 0), a3, voffA);
            PG8_WAIT_V(8); PG8_WAIT_L(0); PG8_BAR; PG8_MMA(1, 0, At, B0); PG8_MMA(1, 1, At, B1); PG8_BAR; PG8_SCHED;
            } else {
            PG8_LDB(B0, 0, 0); PG8_SCHED; PG8_LDA(At, 0, 0); PG8_STAGE(PG8_SA(1, 1), a1 + hstep, voffA);
            PG8_WAIT_L(8); PG8_BAR; PG8_WAIT_L(0); PG8_MMA(0, 0, At, B0); PG8_BAR; PG8_SCHED;
            PG8_LDB(B1, 0, 1); PG8_STAGE(PG8_SB(0, 0), b2, voffB);
            PG8_BAR; PG8_WAIT_L(0); PG8_MMA(0, 1, At, B1); PG8_BAR;
            PG8_LDA(At, 0, 1); PG8_STAGE(PG8_SA(0, 0), a2, voffA);
            PG8_BAR; PG8_WAIT_L(0); PG8_MMA(1, 0, At, B0); PG8_BAR; PG8_SCHED;
            PG8_STAGE(PG8_SB(0, 1), b2 + hstep, voffB);
            PG8_WAIT_V(6); PG8_BAR; PG8_MMA(1, 1, At, B1); PG8_BAR;
            PG8_LDB(B0, 1, 0); PG8_SCHED; PG8_LDA(At, 1, 0); PG8_STAGE(PG8_SA(0, 1), a2 + hstep, voffA);
            PG8_WAIT_L(8); PG8_BAR; PG8_WAIT_L(0); PG8_MMA(0, 0, At, B0); PG8_BAR; PG8_SCHED;
            PG8_LDB(B1, 1, 1); PG8_STAGE(PG8_SB(1, 0), b3, voffB);
            PG8_BAR; PG8_WAIT_L(0); PG8_MMA(0, 1, At, B1); PG8_BAR;
            PG8_LDA(At, 1, 1); PG8_STAGE(PG8_SA(1, 0), a3, voffA);
            PG8_BAR; PG8_WAIT_L(0); PG8_MMA(1, 0, At, B0); PG8_BAR; PG8_SCHED;
            PG8_STAGE(PG8_SB(1, 1), b3 + hstep, voffB);
            PG8_WAIT_V(6); PG8_BAR; PG8_MMA(1, 1, At, B1); PG8_BAR;
            }
        }
        if constexpr (ALIGN_EPI) { if (wr == 0) PG8_BAR; }
        if constexpr (!Epi::AFTER_DRAIN) { E(acc, cur, wr, wc, fr, fq); S.done(cur); }
        if (!has_next) break;
#pragma unroll
        for (int a = 0; a < 2; ++a)
#pragma unroll
            for (int b = 0; b < 2; ++b)
#pragma unroll
                for (int m = 0; m < 4; ++m)
#pragma unroll
                    for (int n = 0; n < 2; ++n) acc[a][b][m][n] = (f32x4){0.f, 0.f, 0.f, 0.f};
        cur = nxt; cA = nA; cB = nB; ++ui;
        if constexpr (ALIGN_EPI) { if (wr == 1) PG8_BAR; }
    }
    PG8_WAIT_V(0);
    if constexpr (!ALIGN_EPI) { if (wr == 0) PG8_BAR; }
    PG8_BAR;
    if constexpr (Epi::AFTER_DRAIN) { E.fused(acc, cur, wr, wc, fr, fq, lds, wid, lane); S.done(cur); }
#undef PG8_SA
#undef PG8_SB
#undef PG8_STAGE
#undef PG8_LDA
#undef PG8_LDB
#undef PG8_MMA
#undef PG8_WAIT_V
#undef PG8_WAIT_L
#undef PG8_BAR
#undef PG8_SCHED
}
}

#define LAS __attribute__((address_space(3)))
typedef unsigned short bf16_t;
typedef short bf16x8 __attribute__((ext_vector_type(8)));
typedef short s16x4 __attribute__((ext_vector_type(4)));
typedef float f32x4 __attribute__((ext_vector_type(4)));
typedef unsigned u32x4 __attribute__((ext_vector_type(4)));
typedef unsigned u32x2 __attribute__((ext_vector_type(2)));

__device__ __forceinline__ float wave_sum(float v) {
#pragma unroll
    for (int o = 1; o < 64; o <<= 1) v += __shfl_xor(v, o);
    return v;
}
__device__ __forceinline__ unsigned pk2(float lo, float hi) { return pg8::cvt_pk_bf16(lo, hi); }
__device__ __forceinline__ float bflo(unsigned w) { return __uint_as_float(w << 16); }
__device__ __forceinline__ float bfhi(unsigned w) { return __uint_as_float(w & 0xffff0000u); }

constexpr size_t MiB = 1u << 20;
constexpr size_t WS_SSQ1 = 64 * 1024, WS_SSQ2 = 128 * 1024, WS_SSQ3 = 192 * 1024, WS_RSTDX = 256 * 1024;
constexpr size_t WS_LSE = 1 * MiB;
constexpr size_t WS_BT1 = 2 * MiB;
constexpr size_t WS_BT2 = 22 * MiB;
constexpr size_t WS_BT3 = 30 * MiB;
constexpr size_t WS_BT4 = 74 * MiB;
constexpr size_t WS_BT5 = 96 * MiB;
constexpr size_t WS_BT6 = 104 * MiB;
constexpr size_t WS_PB = 105 * MiB;
constexpr size_t WS_XB = 114 * MiB;
constexpr size_t WS_YMIX = 178 * MiB;
constexpr size_t WS_PROJ = 242 * MiB;
constexpr size_t WS_END = 418 * MiB;

constexpr int RING_BYTES = 131072;
constexpr int LUT_OFF = RING_BYTES;
constexpr int LDS_BYTES = 147456;

constexpr int MISC_OFF = RING_BYTES + 1024;
constexpr size_t WS_BAR = 0;

#define XB_TMO      128
#define XB_XCNT(j)  (256  + 64 * (j))
#define XB_XSUB(j)  (1280 + 64 * (j))
#define XB_XGEN(j)  (2304 + 64 * (j))
#define XB_TOP      3328
#define XB_TOPGEN   3392
#define XCD_BAR_WORDS 3456
#define XB_SPIN_CAP (1u << 18)

__device__ __forceinline__ unsigned xb_ld(unsigned* p)              { return __hip_atomic_load(p, __ATOMIC_RELAXED, __HIP_MEMORY_SCOPE_AGENT); }
__device__ __forceinline__ unsigned xb_add(unsigned* p, unsigned v) { return __hip_atomic_fetch_add(p, v, __ATOMIC_RELAXED, __HIP_MEMORY_SCOPE_AGENT); }
__device__ __forceinline__ unsigned xb_xcc_id() { return (unsigned)__builtin_amdgcn_s_getreg((3 << 11) | 20) & 0xFu; }
#define XB_SPIN(cond, bar) do { unsigned _sp = 0; while (cond) { __builtin_amdgcn_s_sleep(1); \
    if ((++_sp & 255u) == 0u) { if (xb_ld(&(bar)[XB_TMO])) break; if (_sp > XB_SPIN_CAP) { atomicAdd(&(bar)[XB_TMO], 1u); break; } } } } while (0)

struct XcdBarrier {
    unsigned* bar; unsigned x;
    volatile LAS unsigned* st;
};

__device__ __forceinline__ XcdBarrier xcd_barrier_post(unsigned* bar, volatile LAS unsigned* st) {
    XcdBarrier b; b.bar = bar; b.x = xb_xcc_id(); b.st = st;
    if (threadIdx.x == 0) (void)xb_add(&bar[XB_XCNT(b.x)], 1u);
    return b;
}
__device__ __forceinline__ void xcd_barrier_complete(unsigned* bar, unsigned x, unsigned& nloc, unsigned& nx) {
    const unsigned G = gridDim.x * gridDim.y * gridDim.z;
    unsigned sum, cnt, mine, sp = 0u;
    for (;;) {
        sum = 0u; cnt = 0u; mine = 0u;
#pragma unroll
        for (unsigned j = 0; j < 16; ++j) { const unsigned c = xb_ld(&bar[XB_XCNT(j)]); sum += c; cnt += (c > 0u) ? 1u : 0u; mine = (j == x) ? c : mine; }
        if (sum == G) break;
        __builtin_amdgcn_s_sleep(1);
        if ((++sp & 255u) == 0u) { if (xb_ld(&bar[XB_TMO])) break; if (sp > XB_SPIN_CAP) { atomicAdd(&bar[XB_TMO], 1u); break; } }
    }
    nloc = mine > 0u ? mine : 1u; nx = cnt > 0u ? cnt : 1u;
}

__device__ __forceinline__ void xcd_barrier(const XcdBarrier& b) {
    asm volatile("s_waitcnt vmcnt(0)" ::: "memory");
    __syncthreads();
    if (threadIdx.x == 0) {
        unsigned* bar = b.bar;
        __builtin_amdgcn_s_waitcnt(0);
        unsigned nloc = b.st[0], nx = b.st[1];
        if (nloc == 0u) { xcd_barrier_complete(bar, b.x, nloc, nx); b.st[0] = nloc; b.st[1] = nx; }
        const unsigned old = xb_add(&bar[XB_XSUB(b.x)], 1u);
        const unsigned gen = old / nloc;
        if (old + 1u == (gen + 1u) * nloc) {
            __builtin_amdgcn_fence(__ATOMIC_RELEASE, "agent");
            asm volatile("s_waitcnt vmcnt(0)" ::: "memory");
            const unsigned og = xb_add(&bar[XB_TOP], 1u);
            const unsigned tg = og / nx;
            if (og + 1u == (tg + 1u) * nx) xb_add(&bar[XB_TOPGEN], 1u);
            else XB_SPIN(xb_ld(&bar[XB_TOPGEN]) == tg, bar);
            __builtin_amdgcn_fence(__ATOMIC_ACQUIRE, "agent");
            xb_add(&bar[XB_XGEN(b.x)], 1u);
            asm volatile("s_waitcnt vmcnt(0)" ::: "memory");
        } else {
            XB_SPIN(xb_ld(&bar[XB_XGEN(b.x)]) == gen, bar);
            __builtin_amdgcn_fence(__ATOMIC_ACQUIRE, "agent");
            asm volatile("s_waitcnt vmcnt(0)" ::: "memory");
        }
    }
    __syncthreads();
}

__device__ __forceinline__ void transpose_item(const float* W, int N, const float* gain, bf16_t* WT, int ldk, int drow0, int k0, int n0, LAS float* scr, int lane) {
#pragma unroll 8
    for (int i = 0; i < 32; ++i) { const int kk = 2 * i + (lane >> 5); float v = W[(size_t)(k0 + kk) * N + n0 + (lane & 31)]; if (gain) v *= gain[k0 + kk]; scr[kk * 33 + (lane & 31)] = v; }
    asm volatile("s_waitcnt lgkmcnt(0)" ::: "memory");
    const int c = lane & 7;
#pragma unroll
    for (int j = 0; j < 4; ++j) { const int n = (lane >> 3) + 8 * j; const LAS float* s = scr + (8 * c) * 33 + n;
        u32x4 o; o.x = pk2(s[0 * 33], s[1 * 33]); o.y = pk2(s[2 * 33], s[3 * 33]); o.z = pk2(s[4 * 33], s[5 * 33]); o.w = pk2(s[6 * 33], s[7 * 33]);
        *(u32x4*)(WT + (size_t)(drow0 + n) * ldk + k0 + 8 * c) = o; }
    asm volatile("s_waitcnt lgkmcnt(0)" ::: "memory");
}

struct Ptrs {
    const float *x, *p, *rel_bias, *g_mix, *w_in, *pool_w, *pool_scale, *w_out, *g_ffn, *w_gate, *w_up, *w_down, *g_ple, *w_pg, *w_pp, *g_final;
    float* out; unsigned char* ws;
};

__device__ __forceinline__ void prologue(const Ptrs& P, LAS unsigned char* lds, int gw, int NGW, int wid, int lane) {
    unsigned char* ws = P.ws;
    LAS float* scr = (LAS float*)(lds + wid * 16384);
    bf16_t* BT1 = (bf16_t*)(ws + WS_BT1); bf16_t* BT2 = (bf16_t*)(ws + WS_BT2); bf16_t* BT3 = (bf16_t*)(ws + WS_BT3);
    bf16_t* BT4 = (bf16_t*)(ws + WS_BT4); bf16_t* BT5 = (bf16_t*)(ws + WS_BT5); bf16_t* BT6 = (bf16_t*)(ws + WS_BT6);
    constexpr int I_IN = (DM / 64) * (NIN / 32);
    constexpr int I_OUT = ((DM - 512) / 64) * (DM / 32);
    constexpr int I_G = (DM / 64) * (DFF / 32);
    constexpr int I_DN = (DFF / 64) * (DM / 32);
    constexpr int I_PG = (DM / 64) * (DM / 32);
    constexpr int I_PP = (DPLE / 64) * (DM / 32);
    constexpr int NITEMS = I_IN + I_OUT + 2 * I_G + I_DN + I_PG + I_PP;
    for (int it = gw; it < NITEMS; it += NGW) {
        int r = it;
        if (r < I_IN) { const int nb = NIN / 32, kb = r / nb, n0 = 32 * (r % nb); transpose_item(P.w_in, NIN, P.g_mix, BT1, DM, n0, 64 * kb, n0, scr, lane); continue; } r -= I_IN;
        if (r < I_OUT) { const int nb = DM / 32, kb = r / nb, n0 = 32 * (r % nb); transpose_item(P.w_out, DM, nullptr, BT2, DM, n0, 512 + 64 * kb, n0, scr, lane); continue; } r -= I_OUT;
        if (r < I_G) { const int nb = DFF / 32, kb = r / nb, n0 = 32 * (r % nb); transpose_item(P.w_gate, DFF, P.g_ffn, BT3, DM, (n0 >> 7) * 256 + (n0 & 127), 64 * kb, n0, scr, lane); continue; } r -= I_G;
        if (r < I_G) { const int nb = DFF / 32, kb = r / nb, n0 = 32 * (r % nb); transpose_item(P.w_up, DFF, P.g_ffn, BT3, DM, (n0 >> 7) * 256 + 128 + (n0 & 127), 64 * kb, n0, scr, lane); continue; } r -= I_G;
        if (r < I_DN) { const int nb = DM / 32, kb = r / nb, n0 = 32 * (r % nb); transpose_item(P.w_down, DM, nullptr, BT4, DFF, n0, 64 * kb, n0, scr, lane); continue; } r -= I_DN;
        if (r < I_PG) { const int nb = DM / 32, kb = r / nb, n0 = 32 * (r % nb); transpose_item(P.w_pg, DM, P.g_ple, BT5, DM, n0, 64 * kb, n0, scr, lane); continue; } r -= I_PG;
        { const int nb = DM / 32, kb = r / nb, n0 = 32 * (r % nb); transpose_item(P.w_pp, DM, nullptr, BT6, DPLE, n0, 64 * kb, n0, scr, lane); }
    }
    for (int it = gw; it < 1024; it += NGW) {
        const int kq = it >> 3, nc = it & 7, k4 = kq * 4, g = k4 >> 7, n = nc * 256 + lane * 4;
        f32x4 acc[4] = {{0.f, 0.f, 0.f, 0.f}, {0.f, 0.f, 0.f, 0.f}, {0.f, 0.f, 0.f, 0.f}, {0.f, 0.f, 0.f, 0.f}};
        const float* pw = P.pool_w + (size_t)k4 * 128;
        const float* ps = P.pool_scale + g * 128;
        const float* wo = P.w_out + (size_t)(g * 128) * DM + n;
#pragma unroll 4
        for (int d = 0; d < 128; ++d) {
            const f32x4 wv = *(const f32x4*)(wo + (size_t)d * DM); const float sc = ps[d];
#pragma unroll
            for (int cc = 0; cc < 4; ++cc) acc[cc] += (pw[cc * 128 + d] * sc) * wv;
        }
#pragma unroll
        for (int j = 0; j < 4; ++j) { u32x2 o; o.x = pk2(acc[0][j], acc[1][j]); o.y = pk2(acc[2][j], acc[3][j]); *(u32x2*)(BT2 + (size_t)(n + j) * DM + k4) = o; }
    }
    bf16_t* XB = (bf16_t*)(ws + WS_XB); float* rstdx = (float*)(ws + WS_RSTDX);
    for (int row = gw; row < MROWS; row += NGW) {
        const float* xr = P.x + (size_t)row * DM + lane * 8; f32x4 v[4][2]; float s = 0.f;
#pragma unroll
        for (int j = 0; j < 4; ++j) { v[j][0] = *(const f32x4*)(xr + 512 * j); v[j][1] = *(const f32x4*)(xr + 512 * j + 4); s += pg8::dot4(v[j][0]) + pg8::dot4(v[j][1]); }
        s = wave_sum(s);
        if (lane == 0) rstdx[row] = 1.0f / sqrtf(s * (1.0f / DM) + RMS_EPS);
        bf16_t* o = XB + (size_t)row * DM + lane * 8;
#pragma unroll
        for (int j = 0; j < 4; ++j) *(u32x4*)(o + 512 * j) = pg8::pack8(v[j][0], v[j][1]);
    }
    bf16_t* PB = (bf16_t*)(ws + WS_PB);
    for (int c = gw * 64 + lane; c < MROWS * DPLE / 8; c += NGW * 64) {
        const f32x4 a = *(const f32x4*)(P.p + (size_t)c * 8), b = *(const f32x4*)(P.p + (size_t)c * 8 + 4);
        *(u32x4*)(PB + (size_t)c * 8) = pg8::pack8(a, b);
    }
    float* z = (float*)(ws + WS_SSQ1);
    for (int c = gw * 64 + lane; c < 3 * MROWS; c += NGW * 64) z[c] = 0.f;
}

__device__ __forceinline__ void ld8(const bf16_t* p, float (&f)[8]) { const u32x4 w = *(const u32x4*)p; f[0] = bflo(w.x); f[1] = bfhi(w.x); f[2] = bflo(w.y); f[3] = bfhi(w.y); f[4] = bflo(w.z); f[5] = bfhi(w.z); f[6] = bflo(w.w); f[7] = bfhi(w.w); }
__device__ __forceinline__ void pool_item(const bf16_t* proj, bf16_t* ymix, int item, int lane) {
    const int gi = item & 3, tg = item >> 2, w = 2 << gi, rq = lane >> 4, oct = lane & 15;
    const int t0 = tg * 16 + rq * 4, pos0 = t0 & (SEQ - 1), col = gi * 128 + oct * 8;
    const bf16_t* u = proj + (size_t)t0 * NIN + col;
    float acc[8] = {0.f, 0.f, 0.f, 0.f, 0.f, 0.f, 0.f, 0.f}, f[8];
#pragma unroll
    for (int k = 1; k < 16; ++k) if (k < w && pos0 - k >= 0) { ld8(u - (size_t)k * NIN, f);
#pragma unroll
        for (int e = 0; e < 8; ++e) acc[e] += f[e]; }
#pragma unroll
    for (int i = 0; i < 4; ++i) {
        float cur[8]; ld8(u + (size_t)i * NIN, cur);
#pragma unroll
        for (int e = 0; e < 8; ++e) acc[e] += cur[e];
        if (i > 0 && pos0 + i - w >= 0) { ld8(u + (size_t)(i - w) * NIN, f);
#pragma unroll
            for (int e = 0; e < 8; ++e) acc[e] -= f[e]; }
        const int cnt = (pos0 + i + 1 < w) ? (pos0 + i + 1) : w; const float ic = 1.0f / (float)cnt;
        u32x4 o; o.x = pk2(acc[0] * ic - cur[0], acc[1] * ic - cur[1]); o.y = pk2(acc[2] * ic - cur[2], acc[3] * ic - cur[3]);
        o.z = pk2(acc[4] * ic - cur[4], acc[5] * ic - cur[5]); o.w = pk2(acc[6] * ic - cur[6], acc[7] * ic - cur[7]);
        *(u32x4*)(ymix + (size_t)(t0 + i) * DM + col) = o;
    }
}

__device__ const unsigned char T5_BUCKET[3][129] = {
{0,1,2,3,4,5,6,7,8,9,10,11,12,13,14,15,16,16,16,16,16,16,17,17,17,17,17,17,17,17,18,18,18,18,18,18,18,18,18,18,19,19,19,19,19,19,19,19,19,19,19,19,19,19,20,20,20,20,20,20,20,20,20,20,20,20,20,20,20,20,20,20,20,21,21,21,21,21,21,21,21,21,21,21,21,21,21,21,21,21,21,21,21,21,21,21,21,21,21,22,22,22,22,22,22,22,22,22,22,22,22,22,22,22,22,22,22,22,22,22,22,22,22,22,22,22,22,22,22},
{0,4,8,12,16,16,17,17,18,18,19,19,19,19,20,20,20,20,20,21,21,21,21,21,21,22,22,22,22,22,22,22,22,22,23,23,23,23,23,23,23,23,23,23,23,23,24,24,24,24,24,24,24,24,24,24,24,24,24,24,24,24,25,25,25,25,25,25,25,25,25,25,25,25,25,25,25,25,25,25,25,25,25,26,26,26,26,26,26,26,26,26,26,26,26,26,26,26,26,26,26,26,26,26,26,26,26,26,26,26,26,26,26,27,27,27,27,27,27,27,27,27,27,27,27,27,27,27,27},
{0,16,18,19,20,21,21,22,22,23,23,23,24,24,24,24,25,25,25,25,25,26,26,26,26,26,26,26,26,27,27,27,27,27,27,27,27,27,27,28,28,28,28,28,28,28,28,28,28,28,28,28,29,29,29,29,29,29,29,29,29,29,29,29,29,29,29,29,29,29,30,30,30,30,30,30,30,30,30,30,30,30,30,30,30,30,30,30,30,30,30,30,30,30,30,31,31,31,31,31,31,31,31,31,31,31,31,31,31,31,31,31,31,31,31,31,31,31,31,31,31,31,31,31,31,31,31,31,31}};

__device__ __forceinline__ s16x4 vtr(LAS const unsigned char* p) { typedef short v4i16_t __attribute__((ext_vector_type(4))); return __builtin_bit_cast(s16x4, __builtin_amdgcn_ds_read_tr16_b64_v4i16((LAS v4i16_t*)p)); }

__device__ __forceinline__ void attn_item(LAS unsigned char* lds, const bf16_t* proj, bf16_t* ymix, float* lse, const float* rel_bias, int item) {
    const int tid = threadIdx.x, lane = tid & 63, wid = __builtin_amdgcn_readfirstlane(tid >> 6), fr = lane & 15, fq = lane >> 4;
    const int g = item >> 9, idx = item & 511, dsh = 2 * g, d = 1 << dsh, nbsh = 6 - dsh;
    const int seq = idx >> nbsh, n = idx & ((1 << nbsh) - 1), r = seq & (d - 1), bh = seq >> dsh, hl = bh & 3, b = bh >> 2, head = g * 4 + hl;
    const size_t rowbase = (size_t)b * SEQ;
    const bf16_t* kbase = proj + 2048 + head * HD; const bf16_t* vbase = proj + 3584 + head * HD;
#pragma unroll
    for (int j = 0; j < 8; ++j) {
        const int piece = wid * 8 + j, key = piece * 4 + (lane >> 4), cp = lane & 15;
        int l = 128 * (n - 1) + key; if (l < 0) l += 128;
        const size_t grow = rowbase + ((size_t)l << dsh) + r;
        const int kc = cp ^ (key & 15), vc = (((cp >> 1) ^ (key & 7)) << 1) | (cp & 1);
        __builtin_amdgcn_global_load_lds((const unsigned*)(kbase + grow * NIN + kc * 8), (LAS unsigned*)(lds + piece * 1024), 16, 0, 0);
        __builtin_amdgcn_global_load_lds((const unsigned*)(vbase + grow * NIN + vc * 8), (LAS unsigned*)(lds + 65536 + piece * 1024), 16, 0, 0);
    }
    if (tid < 129) ((LAS float*)(lds + LUT_OFF))[tid] = rel_bias[(int)T5_BUCKET[g][tid] * NHEADS + head] * LOG2E;
    const int q0 = wid * 16;
    const size_t qrow = rowbase + ((size_t)(128 * n + q0 + fr) << dsh) + r;
    bf16x8 qf[4];
#pragma unroll
    for (int s = 0; s < 4; ++s) qf[s] = *(const bf16x8*)(proj + qrow * NIN + 512 + head * HD + 32 * s + 8 * fq);
    asm volatile("s_waitcnt vmcnt(0) lgkmcnt(0)" ::: "memory");
    __syncthreads();
    f32x4 sc[9];
#pragma unroll
    for (int jt = 0; jt < 9; ++jt) {
        f32x4 a = {0.f, 0.f, 0.f, 0.f};
        LAS const unsigned char* kp = lds + (q0 + 16 * jt + fr) * 256;
#pragma unroll
        for (int s = 0; s < 4; ++s) { const bf16x8 kf = *(LAS const bf16x8*)(kp + (((4 * s + fq) ^ fr) << 4)); a = __builtin_amdgcn_mfma_f32_16x16x32_bf16(kf, qf[s], a, 0, 0, 0); }
        sc[jt] = a;
    }
    LAS const float* lut = (LAS const float*)(lds + LUT_OFF);
    float mx = -3.0e38f;
#pragma unroll
    for (int jt = 0; jt < 9; ++jt)
#pragma unroll
        for (int e = 0; e < 4; ++e) {
            const int off = 128 + fr - 16 * jt - 4 * fq - e, ki = q0 + 16 * jt + 4 * fq + e;
            const bool ok = (off >= 0) && (off <= 128) && (n > 0 || ki >= 128);
            const int oc = off < 0 ? 0 : (off > 128 ? 128 : off);
            const float v = ok ? sc[jt][e] + lut[oc] : -1.0e30f;
            sc[jt][e] = v; mx = fmaxf(mx, v);
        }
    mx = fmaxf(mx, __shfl_xor(mx, 16)); mx = fmaxf(mx, __shfl_xor(mx, 32));
    float den = 0.f;
#pragma unroll
    for (int jt = 0; jt < 9; ++jt)
#pragma unroll
        for (int e = 0; e < 4; ++e) { const float pv = __builtin_amdgcn_exp2f(sc[jt][e] - mx); sc[jt][e] = pv; den += pv; }
    den += __shfl_xor(den, 16); den += __shfl_xor(den, 32);
    bf16x8 pb[5];
#pragma unroll
    for (int ks = 0; ks < 5; ++ks) {
        u32x4 w; w.x = pk2(sc[2 * ks][0], sc[2 * ks][1]); w.y = pk2(sc[2 * ks][2], sc[2 * ks][3]);
        if (ks < 4) { w.z = pk2(sc[2 * ks + 1][0], sc[2 * ks + 1][1]); w.w = pk2(sc[2 * ks + 1][2], sc[2 * ks + 1][3]); } else { w.z = 0u; w.w = 0u; }
        pb[ks] = __builtin_bit_cast(bf16x8, w);
    }
    f32x4 o[8];
#pragma unroll
    for (int db = 0; db < 8; ++db) o[db] = (f32x4){0.f, 0.f, 0.f, 0.f};
#pragma unroll
    for (int ks = 0; ks < 5; ++ks) {
        const int rowA = q0 + 32 * ks + 4 * fq + (fr >> 2), rowB = (ks < 4) ? rowA + 16 : rowA;
        LAS const unsigned char* va = lds + 65536 + rowA * 256 + 8 * (fr & 3);
        LAS const unsigned char* vb = lds + 65536 + rowB * 256 + 8 * (fr & 3);
#pragma unroll
        for (int db = 0; db < 8; ++db) {
            const s16x4 lo = vtr(va + ((db ^ (rowA & 7)) << 5)), hi = vtr(vb + ((db ^ (rowB & 7)) << 5));
            const bf16x8 vf = {lo[0], lo[1], lo[2], lo[3], hi[0], hi[1], hi[2], hi[3]};
            o[db] = __builtin_amdgcn_mfma_f32_16x16x32_bf16(vf, pb[ks], o[db], 0, 0, 0);
        }
    }
    const float inv = 1.0f / den;
    bf16_t* orow = ymix + qrow * DM + 512 + head * HD + 4 * fq;
#pragma unroll
    for (int db = 0; db < 8; ++db) { u32x2 w; w.x = pk2(o[db][0] * inv, o[db][1] * inv); w.y = pk2(o[db][2] * inv, o[db][3] * inv); *(u32x2*)(orow + 16 * db) = w; }
    if (fq == 0) lse[qrow * NHEADS + head] = (mx + __builtin_amdgcn_logf(den)) * LN2;
    asm volatile("s_waitcnt lgkmcnt(0)" ::: "memory");
    __syncthreads();
}

__device__ __forceinline__ void mix_row(bf16_t* ymix, const float* lse, int row, int lane) {
    const int hs = lane >> 4; const float* l = lse + (size_t)row * NHEADS + hs;
    const float l0 = l[0], l1 = l[4], l2 = l[8], m = fmaxf(l0, fmaxf(l1, l2));
    const float e0 = __expf(l0 - m), e1 = __expf(l1 - m), e2 = __expf(l2 - m), inv = 1.0f / (e0 + e1 + e2);
    const float al[3] = {e0 * inv, e1 * inv, e2 * inv};
    bf16_t* y = ymix + (size_t)row * DM + 512 + lane * 8;
#pragma unroll
    for (int j = 0; j < 3; ++j) { const u32x4 w = *(const u32x4*)(y + 512 * j); const float a = al[j]; u32x4 o;
        o.x = pk2(bflo(w.x) * a, bfhi(w.x) * a); o.y = pk2(bflo(w.y) * a, bfhi(w.y) * a); o.z = pk2(bflo(w.z) * a, bfhi(w.z) * a); o.w = pk2(bflo(w.w) * a, bfhi(w.w) * a);
        *(u32x4*)(y + 512 * j) = o; }
}
__device__ __forceinline__ void final_row(float* out, const float* ssq, const float* gfin, int row, int lane) {
    const float r = 1.0f / sqrtf(ssq[row] * (1.0f / DM) + RMS_EPS);
    float* o = out + (size_t)row * DM + lane * 4;
#pragma unroll
    for (int j = 0; j < 8; ++j) { const f32x4 v = *(const f32x4*)(o + 256 * j), gg = *(const f32x4*)(gfin + lane * 4 + 256 * j); *(f32x4*)(o + 256 * j) = v * r * gg; }
}

struct Args { const float* in[16]; float* out; unsigned char* ws; };

#define PG8_ALIGN true
#define PG8_SP2 true

__global__ void __launch_bounds__(512, 2) hymba_fwd(Args args) {
    extern __shared__ __attribute__((aligned(16))) unsigned char lds_raw[];
    LAS unsigned char* lds = (LAS unsigned char*)lds_raw;
    cg::grid_group grid = cg::this_grid();
    const int tid = threadIdx.x, lane = tid & 63, wid = __builtin_amdgcn_readfirstlane(tid >> 6);
    const int G = gridDim.x, bx = blockIdx.x;
    const int vcu = (G % 8 == 0) ? (bx % 8) * (G / 8) + bx / 8 : bx;
    const int gw = vcu * 8 + wid, NGW = G * 8;
    Ptrs P;
    P.x = args.in[0]; P.p = args.in[1]; P.rel_bias = args.in[2]; P.g_mix = args.in[3]; P.w_in = args.in[4]; P.pool_w = args.in[5]; P.pool_scale = args.in[6]; P.w_out = args.in[7];
    P.g_ffn = args.in[8]; P.w_gate = args.in[9]; P.w_up = args.in[10]; P.w_down = args.in[11]; P.g_ple = args.in[12]; P.w_pg = args.in[13]; P.w_pp = args.in[14]; P.g_final = args.in[15];
    P.out = args.out; P.ws = args.ws;
    unsigned char* ws = args.ws;
    bf16_t* BT1 = (bf16_t*)(ws + WS_BT1); bf16_t* BT2 = (bf16_t*)(ws + WS_BT2); bf16_t* BT3 = (bf16_t*)(ws + WS_BT3);
    bf16_t* BT4 = (bf16_t*)(ws + WS_BT4); bf16_t* BT5 = (bf16_t*)(ws + WS_BT5); bf16_t* BT6 = (bf16_t*)(ws + WS_BT6);
    bf16_t* PB = (bf16_t*)(ws + WS_PB); bf16_t* XB = (bf16_t*)(ws + WS_XB); bf16_t* YMIX = (bf16_t*)(ws + WS_YMIX); bf16_t* PROJ = (bf16_t*)(ws + WS_PROJ);
    float* SSQ1 = (float*)(ws + WS_SSQ1); float* SSQ2 = (float*)(ws + WS_SSQ2); float* SSQ3 = (float*)(ws + WS_SSQ3); float* RSTDX = (float*)(ws + WS_RSTDX); float* LSE = (float*)(ws + WS_LSE);

    volatile LAS unsigned* MISC = (volatile LAS unsigned*)(lds + MISC_OFF);
    if (tid < 2) MISC[tid] = 0u;
    if (bx == 0) for (int u = tid; u < XCD_BAR_WORDS; u += 512) ((unsigned*)(ws + WS_BAR))[u] = 0u;
    prologue(P, lds, gw, NGW, wid, lane);
    grid.sync();
    const XcdBarrier bar = xcd_barrier_post((unsigned*)(ws + WS_BAR), MISC);

    { pg8::Gemm g{XB, BT1, MROWS, NIN, DM}; pg8::StaticOrder S; S.init(MROWS, NIN, G, bx);
      pg8::EpiProj E{PROJ, NIN, RSTDX, 2, 8, QSCALE};
      pg8::gemm_phase<pg8::EpiProj, pg8::StaticOrder, PG8_ALIGN, PG8_SP2>(lds, g, S, E); }
    xcd_barrier(bar);

    { const int per = (1536 + G - 1) / G;
      for (int i = 0; i < per; ++i) { const int item = vcu * per + i; if (item >= 1536) break; attn_item(lds, PROJ, YMIX, LSE, P.rel_bias, item); }
      for (int it = gw; it < 4096; it += NGW) pool_item(PROJ, YMIX, it, lane); }
    xcd_barrier(bar);

    for (int row = gw; row < MROWS; row += NGW) mix_row(YMIX, LSE, row, lane);
    xcd_barrier(bar);

    { pg8::Gemm g{YMIX, BT2, MROWS, DM, DM}; pg8::StaticOrder S; S.init(MROWS, DM, G, bx);
      pg8::EpiRes E{P.x, P.out, XB, SSQ1, DM};
      pg8::gemm_phase<pg8::EpiRes, pg8::StaticOrder, PG8_ALIGN, PG8_SP2>(lds, g, S, E); }
    xcd_barrier(bar);

    { pg8::Gemm g{XB, BT3, MROWS, 2 * DFF, DM}; pg8::StaticOrder S; S.init(MROWS, 2 * DFF, G, bx);
      pg8::EpiSwiGLU E{PROJ, DFF, SSQ1, 1.0f / DM, RMS_EPS};
      pg8::gemm_phase<pg8::EpiSwiGLU, pg8::StaticOrder, PG8_ALIGN, PG8_SP2>(lds, g, S, E); }
    { int kpp = DPLE; asm volatile("" : "+s"(kpp));
      pg8::Gemm g{PB, BT6, MROWS, DM, kpp}; pg8::StaticOrder S; S.init(MROWS, DM, G, bx);
      pg8::EpiPlain E{YMIX, DM};
      pg8::gemm_phase<pg8::EpiPlain, pg8::StaticOrder, PG8_ALIGN, PG8_SP2>(lds, g, S, E); }
    xcd_barrier(bar);

    { pg8::Gemm g{PROJ, BT4, MROWS, DM, DFF}; pg8::StaticOrder S; S.init(MROWS, DM, G, bx);
      pg8::EpiRes E{P.out, P.out, XB, SSQ2, DM};
      pg8::gemm_phase<pg8::EpiRes, pg8::StaticOrder, PG8_ALIGN, PG8_SP2>(lds, g, S, E); }
    xcd_barrier(bar);

    { pg8::Gemm g{XB, BT5, MROWS, DM, DM}; pg8::StaticOrder S; S.init(MROWS, DM, G, bx);
      pg8::EpiPle E{P.out, YMIX, SSQ2, SSQ3, DM, 1.0f / DM, RMS_EPS};
      pg8::gemm_phase<pg8::EpiPle, pg8::StaticOrder, PG8_ALIGN, PG8_SP2>(lds, g, S, E); }
    xcd_barrier(bar);

    for (int row = gw; row < MROWS; row += NGW) final_row(P.out, SSQ3, P.g_final, row, lane);
}

extern "C" void kernel_launch(void* const* d_in, const int* in_sizes, int n_in, void* d_out, int out_size, void* d_ws, size_t ws_size, hipStream_t stream) {
    static int grid = 0;
    if (grid == 0) {
        if (n_in != 16 || in_sizes[0] != MROWS * DM || out_size != MROWS * DM || ws_size < WS_END) {
            fprintf(stderr, "kernel_launch: unexpected shapes (n_in %d, in0 %d, out %d, ws %zu); nothing launched\n", n_in, n_in > 0 ? in_sizes[0] : -1, out_size, ws_size); grid = -1; return; }
        int dev = 0, cus = 0, per_cu = 0;
        if (hipGetDevice(&dev) != hipSuccess || hipDeviceGetAttribute(&cus, hipDeviceAttributeMultiprocessorCount, dev) != hipSuccess) { fprintf(stderr, "kernel_launch: device query failed\n"); grid = -1; return; }
        if (hipFuncSetAttribute((const void*)hymba_fwd, hipFuncAttributeMaxDynamicSharedMemorySize, LDS_BYTES) != hipSuccess) { fprintf(stderr, "kernel_launch: hipFuncSetAttribute failed\n"); grid = -1; return; }
        if (hipOccupancyMaxActiveBlocksPerMultiprocessor(&per_cu, (const void*)hymba_fwd, 512, LDS_BYTES) != hipSuccess || per_cu < 1) { fprintf(stderr, "kernel_launch: occupancy query says %d blocks per CU\n", per_cu); (void)hipGetLastError(); per_cu = 1; }
        if (per_cu > 1) per_cu = 1;
        grid = cus * per_cu;
    }
    if (grid < 0) return;
    Args a{};
    for (int i = 0; i < 16; ++i) a.in[i] = (const float*)d_in[i];
    a.out = (float*)d_out; a.ws = (unsigned char*)d_ws;
    void* kargs[] = {&a};
    hipError_t e = hipLaunchCooperativeKernel((const void*)hymba_fwd, dim3(grid), dim3(512), kargs, LDS_BYTES, stream);
    if (e != hipSuccess) fprintf(stderr, "kernel_launch: cooperative launch failed: %s (grid %d)\n", hipGetErrorString(e), grid);
}
```

```cpp
#include <hip/hip_runtime.h>
#include <hip/hip_cooperative_groups.h>
#include <cstdio>
#include <cstdint>
namespace cg = cooperative_groups;

constexpr int BATCH = 2, SEQ = 8192, DM = 2048, MROWS = BATCH * SEQ, NIN = 5120, DFF = 5632, DPLE = 256, NHEADS = 12, HD = 128;
constexpr float RMS_EPS = 1e-6f;
constexpr float QSCALE = 0.08838834764831845f * 1.4426950408889634f;
constexpr float LOG2E = 1.4426950408889634f, LN2 = 0.6931471805599453f;
namespace pg8 {
#define PG8_LAS __attribute__((address_space(3)))
typedef unsigned short bf16_t;
typedef short bf16x8 __attribute__((ext_vector_type(8)));
typedef float f32x4 __attribute__((ext_vector_type(4)));
typedef unsigned u32x4 __attribute__((ext_vector_type(4)));
constexpr int BM = 256, BK = 64, HALF = 128, HTB = HALF * BK * 2  , STAGE_BYTES = 8 * HTB, NXCD = 8, WGM = 8;

__host__ __device__ __forceinline__ int lds_byte(int r, int c) { const int st = (r >> 4) * 2 + (c >> 5), rr = r & 15, cc = c & 31, ob = rr * 64 + cc * 2; return st * 1024 + (ob ^ (((ob >> 9) & 1) << 5)); }
__host__ __device__ __forceinline__ void stage_rc(int b, int& R, int& C) { const int st = b / 1024, sb = b % 1024, swz = sb ^ (((sb >> 9) & 1) << 5); R = (st >> 1) * 16 + swz / 64; C = (st & 1) * 32 + (swz % 64) / 2; }
__host__ __device__ __forceinline__ int perm32(int rho) { const int n = rho >> 4, i = rho & 15; return 8 * (i >> 2) + 4 * n + (i & 3); }

struct Unit { int pm, pn; };
struct Gemm { const bf16_t* A; const bf16_t* Bt; int M, N, K; };

struct StaticOrder {
    int nM, nN, nwg, G, c;
    __host__ __device__ void init(int M, int N, int G_, int c_) { nM = M / BM; nN = N / BM; nwg = nM * nN; G = G_; c = c_; }
    __host__ __device__ bool next(int i, Unit& u) const {
        const long L = (long)i * G + c; if (L >= nwg) return false;
        int wgid = (int)L; { const int q = nwg / NXCD, r = nwg % NXCD, xcd = wgid % NXCD, off = wgid / NXCD; wgid = (xcd < r ? xcd * (q + 1) : r * (q + 1) + (xcd - r) * q) + off; }
        const int nig = WGM * nN, gid = wgid / nig, fm = gid * WGM, gsz = (nM - fm) < WGM ? (nM - fm) : WGM;
        u.pm = fm + ((wgid % nig) % gsz); u.pn = (wgid % nig) / gsz; return true;
    }
    __device__ __forceinline__ void a_ready(const Unit&) const {}
    __device__ __forceinline__ void done(const Unit&) const {}
};

__device__ __forceinline__ unsigned cvt_pk_bf16(float lo, float hi) { unsigned r; asm volatile("v_cvt_pk_bf16_f32 %0, %1, %2" : "=v"(r) : "v"(lo), "v"(hi)); return r; }
__device__ __forceinline__ u32x4 pack8(const f32x4 v0, const f32x4 v1) { u32x4 w; w.x = cvt_pk_bf16(v0[0], v0[1]); w.y = cvt_pk_bf16(v0[2], v0[3]); w.z = cvt_pk_bf16(v1[0], v1[1]); w.w = cvt_pk_bf16(v1[2], v1[3]); return w; }
__device__ __forceinline__ float bf_lo(unsigned w) { return __uint_as_float(w << 16); }
__device__ __forceinline__ float bf_hi(unsigned w) { return __uint_as_float(w & 0xffff0000u); }
__device__ __forceinline__ float dot4(const f32x4 v) { return (v[0] * v[0] + v[1] * v[1]) + (v[2] * v[2] + v[3] * v[3]); }

struct EpiProj {
    static constexpr bool PERM = true, AFTER_DRAIN = false;
    bf16_t* O; int ldc; const float* rstd; int q_lo, q_hi; float qscale;
    __device__ __forceinline__ void operator()(const f32x4 (&acc)[2][2][4][2], const Unit& u, int wr, int wc, int fr, int fq) const {
        const int row0 = u.pm * BM + wr * 64 + fr, col0 = u.pn * BM + wc * 32 + 8 * fq;
        const float qs = (u.pn >= q_lo && u.pn < q_hi) ? qscale : 1.0f;
#pragma unroll
        for (int ai = 0; ai < 2; ++ai)
#pragma unroll
            for (int m = 0; m < 4; ++m) { const int row = row0 + ai * HALF + m * 16; const float s = rstd[row] * qs; bf16_t* rowp = O + (size_t)row * ldc + col0;
#pragma unroll
                for (int bj = 0; bj < 2; ++bj) *(u32x4*)(rowp + bj * HALF) = pack8(acc[ai][bj][m][0] * s, acc[ai][bj][m][1] * s); }
    }
};
struct EpiPlain {
    static constexpr bool PERM = true, AFTER_DRAIN = false;
    bf16_t* O; int ldc;
    __device__ __forceinline__ void operator()(const f32x4 (&acc)[2][2][4][2], const Unit& u, int wr, int wc, int fr, int fq) const {
        const int row0 = u.pm * BM + wr * 64 + fr, col0 = u.pn * BM + wc * 32 + 8 * fq;
#pragma unroll
        for (int ai = 0; ai < 2; ++ai)
#pragma unroll
            for (int m = 0; m < 4; ++m) { bf16_t* rowp = O + (size_t)(row0 + ai * HALF + m * 16) * ldc + col0;
#pragma unroll
                for (int bj = 0; bj < 2; ++bj) *(u32x4*)(rowp + bj * HALF) = pack8(acc[ai][bj][m][0], acc[ai][bj][m][1]); }
    }
};
struct EpiRes {
    static constexpr bool PERM = true, AFTER_DRAIN = false;
    const bf16_t* base; bf16_t* ob; float* ssq; int ldc;
    __device__ __forceinline__ void operator()(const f32x4 (&acc)[2][2][4][2], const Unit& u, int wr, int wc, int fr, int fq) const {
        const int row0 = u.pm * BM + wr * 64 + fr, col0 = u.pn * BM + wc * 32 + 8 * fq;
#pragma unroll
        for (int ai = 0; ai < 2; ++ai)
#pragma unroll
            for (int m = 0; m < 4; ++m) { const int row = row0 + ai * HALF + m * 16; const size_t off = (size_t)row * ldc + col0; float s = 0.f;
#pragma unroll
                for (int bj = 0; bj < 2; ++bj) {
                    const u32x4 bw = *(const u32x4*)(base + off + bj * HALF);
                    const f32x4 v0 = (f32x4){bf_lo(bw.x), bf_hi(bw.x), bf_lo(bw.y), bf_hi(bw.y)} + acc[ai][bj][m][0], v1 = (f32x4){bf_lo(bw.z), bf_hi(bw.z), bf_lo(bw.w), bf_hi(bw.w)} + acc[ai][bj][m][1];
                    *(u32x4*)(ob + off + bj * HALF) = pack8(v0, v1);
                    s += dot4(v0) + dot4(v1); }
                s += __shfl_xor(s, 16); s += __shfl_xor(s, 32);
                if (fq == 0) atomicAdd(ssq + row, s); }
    }
};
struct EpiSwiGLU {
    static constexpr bool PERM = true, AFTER_DRAIN = false;
    bf16_t* O; int ldc; const float* ssq; float inv_d, eps;
    __device__ __forceinline__ void operator()(const f32x4 (&acc)[2][2][4][2], const Unit& u, int wr, int wc, int fr, int fq) const {
        const int row0 = u.pm * BM + wr * 64 + fr, col0 = u.pn * HALF + wc * 32 + 8 * fq;
#pragma unroll
        for (int ai = 0; ai < 2; ++ai)
#pragma unroll
            for (int m = 0; m < 4; ++m) { const int row = row0 + ai * HALF + m * 16; const float r = __builtin_amdgcn_rsqf(ssq[row] * inv_d + eps);
                f32x4 o[2];
#pragma unroll
                for (int n = 0; n < 2; ++n)
#pragma unroll
                    for (int j = 0; j < 4; ++j) { const float g = acc[ai][0][m][n][j] * r, up = acc[ai][1][m][n][j] * r;
                        o[n][j] = g * up * __builtin_amdgcn_rcpf(1.0f + __builtin_amdgcn_exp2f(-1.4426950408889634f * g)); }
                *(u32x4*)(O + (size_t)row * ldc + col0) = pack8(o[0], o[1]); }
    }
};
struct EpiPle {
    static constexpr bool PERM = true, AFTER_DRAIN = false;
    const bf16_t* h; const bf16_t* pp; bf16_t* o; const float* ssq2; float* ssq3; int ldc; float inv_d, eps;
    __device__ __forceinline__ void operator()(const f32x4 (&acc)[2][2][4][2], const Unit& u, int wr, int wc, int fr, int fq) const {
        const int row0 = u.pm * BM + wr * 64 + fr, col0 = u.pn * BM + wc * 32 + 8 * fq;
#pragma unroll
        for (int ai = 0; ai < 2; ++ai)
#pragma unroll
            for (int m = 0; m < 4; ++m) { const int row = row0 + ai * HALF + m * 16; const size_t off = (size_t)row * ldc + col0; float s = 0.f;
                const float r = __builtin_amdgcn_rsqf(ssq2[row] * inv_d + eps);
#pragma unroll
                for (int bj = 0; bj < 2; ++bj) {
                    const u32x4 pw = *(const u32x4*)(pp + off + bj * HALF), hw = *(const u32x4*)(h + off + bj * HALF);
                    f32x4 v0 = {bf_lo(hw.x), bf_hi(hw.x), bf_lo(hw.y), bf_hi(hw.y)}, v1 = {bf_lo(hw.z), bf_hi(hw.z), bf_lo(hw.w), bf_hi(hw.w)};
                    const f32x4 p0 = {bf_lo(pw.x), bf_hi(pw.x), bf_lo(pw.y), bf_hi(pw.y)}, p1 = {bf_lo(pw.z), bf_hi(pw.z), bf_lo(pw.w), bf_hi(pw.w)};
#pragma unroll
                    for (int j = 0; j < 4; ++j) {
                        v0[j] += p0[j] * __builtin_amdgcn_rcpf(1.0f + __builtin_amdgcn_exp2f(-1.4426950408889634f * r * acc[ai][bj][m][0][j]));
                        v1[j] += p1[j] * __builtin_amdgcn_rcpf(1.0f + __builtin_amdgcn_exp2f(-1.4426950408889634f * r * acc[ai][bj][m][1][j])); }
                    *(u32x4*)(o + off + bj * HALF) = pack8(v0, v1);
                    s += dot4(v0) + dot4(v1); }
                s += __shfl_xor(s, 16); s += __shfl_xor(s, 32);
                if (fq == 0) atomicAdd(ssq3 + row, s); }
    }
};

template <class Epi, class Sched, bool ALIGN_EPI = false, bool SP2 = false>
__device__ __forceinline__ void gemm_phase(PG8_LAS unsigned char* lds, const Gemm g, const Sched& S, const Epi& E) {
    const int tid = threadIdx.x, wid = __builtin_amdgcn_readfirstlane(tid >> 6), lane = tid & 63, wr = wid >> 2, wc = wid & 3, fr = lane & 15, fq = lane >> 4;
    const int K = g.K, nt = K / BK;
    unsigned voffA[2], voffB[2];
#pragma unroll
    for (int i = 0; i < 2; ++i) { int R, C; stage_rc(tid * 16 + i * 8192, R, C); const int Rb = Epi::PERM ? ((R & ~31) + perm32(R & 31)) : R;
        voffA[i] = (unsigned)(R * K + C) * 2u; voffB[i] = (unsigned)(Rb * K + C) * 2u; }
    const size_t kstep = (size_t)(BK * 2);
    const size_t hstep = (size_t)HALF * K * 2;
    const size_t tstep = 2 * hstep;
    const unsigned ldsw = (unsigned)wid * 1024u;
    const int aoff = lds_byte(wr * 64 + fr, fq * 8), boff = lds_byte(wc * 32 + fr, fq * 8);
#define PG8_SA(b, h) (((b) * 2 + (h)) * HTB)
#define PG8_SB(b, h) ((4 + (b) * 2 + (h)) * HTB)
#define PG8_STAGE(bufoff, gbase, voff) do { _Pragma("unroll") for (int _i = 0; _i < 2; ++_i) \
        __builtin_amdgcn_global_load_lds((const unsigned*)((const char*)(gbase) + (voff)[_i]), (PG8_LAS unsigned*)(lds + (bufoff) + ldsw + _i * 8192), 16, 0, 0); } while (0)
#define PG8_LDA(dst, b, h) do { _Pragma("unroll") for (int m = 0; m < 4; ++m) _Pragma("unroll") for (int k = 0; k < 2; ++k) dst[m][k] = *(const PG8_LAS bf16x8*)(lds + PG8_SA(b, h) + aoff + m * 2048 + k * 1024); } while (0)
#define PG8_LDB(dst, b, h) do { _Pragma("unroll") for (int n = 0; n < 2; ++n) _Pragma("unroll") for (int k = 0; k < 2; ++k) dst[n][k] = *(const PG8_LAS bf16x8*)(lds + PG8_SB(b, h) + boff + n * 2048 + k * 1024); } while (0)
#define PG8_MMA(ai, bj, At, Bt) do { __builtin_amdgcn_s_setprio(1); _Pragma("unroll") for (int m = 0; m < 4; ++m) _Pragma("unroll") for (int n = 0; n < 2; ++n) _Pragma("unroll") for (int k = 0; k < 2; ++k) \
        acc[ai][bj][m][n] = __builtin_amdgcn_mfma_f32_16x16x32_bf16(Bt[n][k], At[m][k], acc[ai][bj][m][n], 0, 0, 0); __builtin_amdgcn_s_setprio(0); } while (0)
#define PG8_WAIT_V(n) asm volatile("s_waitcnt vmcnt(" #n ")" ::: "memory")
#define PG8_WAIT_L(n) asm volatile("s_waitcnt lgkmcnt(" #n ")" ::: "memory")
#define PG8_BAR __builtin_amdgcn_s_barrier()
#define PG8_SCHED __builtin_amdgcn_sched_barrier(0)
    Unit cur, nxt; int ui = 0;
    if (!S.next(0, cur)) return;
    f32x4 acc[2][2][4][2];
#pragma unroll
    for (int a = 0; a < 2; ++a)
#pragma unroll
        for (int b = 0; b < 2; ++b)
#pragma unroll
            for (int m = 0; m < 4; ++m)
#pragma unroll
                for (int n = 0; n < 2; ++n) acc[a][b][m][n] = (f32x4){0.f, 0.f, 0.f, 0.f};
    bf16x8 At[4][2], B0[2][2], B1[2][2];
    const char* cA = (const char*)g.A + (size_t)cur.pm * tstep; const char* cB = (const char*)g.Bt + (size_t)cur.pn * tstep;
    S.a_ready(cur);
    if constexpr (SP2) {
        PG8_STAGE(PG8_SB(0, 0), cB, voffB); PG8_STAGE(PG8_SB(0, 1), cB + hstep, voffB); PG8_STAGE(PG8_SA(0, 0), cA, voffA); PG8_STAGE(PG8_SA(0, 1), cA + hstep, voffA);
        if (wr == 1) PG8_BAR;
        PG8_WAIT_V(2); PG8_BAR;
        PG8_STAGE(PG8_SB(1, 0), cB + kstep, voffB); PG8_STAGE(PG8_SA(1, 0), cA + kstep, voffA); PG8_STAGE(PG8_SB(1, 1), cB + hstep + kstep, voffB);
        PG8_WAIT_V(6); PG8_BAR;
    } else {
        PG8_STAGE(PG8_SB(0, 0), cB, voffB); PG8_STAGE(PG8_SA(0, 0), cA, voffA); PG8_STAGE(PG8_SB(0, 1), cB + hstep, voffB); PG8_STAGE(PG8_SA(0, 1), cA + hstep, voffA);
        if (wr == 1) PG8_BAR;
        PG8_WAIT_V(4); PG8_BAR;
        PG8_STAGE(PG8_SB(1, 0), cB + kstep, voffB); PG8_STAGE(PG8_SA(1, 0), cA + kstep, voffA); PG8_STAGE(PG8_SB(1, 1), cB + hstep + kstep, voffB);
        PG8_WAIT_V(6); PG8_BAR;
    }
    for (;;) {
        const bool has_next = S.next(ui + 1, nxt);
        const char* nA = has_next ? (const char*)g.A + (size_t)nxt.pm * tstep : cA; const char* nB = has_next ? (const char*)g.Bt + (size_t)nxt.pn * tstep : cB;
        for (int t = 0; t < nt; t += 2) {
            const bool last = (t == nt - 2);
            const char* a1 = cA + (size_t)(t + 1) * kstep;
            const char* a2 = last ? nA : cA + (size_t)(t + 2) * kstep; const char* b2 = last ? nB : cB + (size_t)(t + 2) * kstep;
            const char* a3 = a2 + kstep; const char* b3 = b2 + kstep;
            if (last && has_next) S.a_ready(nxt);
            if constexpr (SP2) {
            PG8_LDB(B0, 0, 0); PG8_LDB(B1, 0, 1); PG8_SCHED; PG8_LDA(At, 0, 0); PG8_STAGE(PG8_SA(1, 1), a1 + hstep, voffA);
            PG8_WAIT_V(8); PG8_WAIT_L(0); PG8_BAR; PG8_MMA(0, 0, At, B0); PG8_MMA(0, 1, At, B1); PG8_BAR; PG8_SCHED;
            PG8_LDA(At, 0, 1); PG8_STAGE(PG8_SB(0, 0), b2, voffB); PG8_STAGE(PG8_SB(0, 1), b2 + hstep, voffB); PG8_STAGE(PG8_SA(0, 0), a2, voffA);
            PG8_WAIT_V(8); PG8_WAIT_L(0); PG8_BAR; PG8_MMA(1, 0, At, B0); PG8_MMA(1, 1, At, B1); PG8_BAR; PG8_SCHED;
            PG8_LDB(B0, 1, 0); PG8_LDB(B1, 1, 1); PG8_SCHED; PG8_LDA(At, 1, 0); PG8_STAGE(PG8_SA(0, 1), a2 + hstep, voffA);
            PG8_WAIT_V(8); PG8_WAIT_L(0); PG8_BAR; PG8_MMA(0, 0, At, B0); PG8_MMA(0, 1, At, B1); PG8_BAR; PG8_SCHED;
            PG8_LDA(At, 1, 1); PG8_STAGE(PG8_SB(1, 0), b3, voffB); PG8_STAGE(PG8_SB(1, 1), b3 + hstep, voffB); PG8_STAGE(PG8_SA(1, 0), a3, voffA);
            PG8_WAIT_V(8); PG8_WAIT_L(0); PG8_BAR; PG8_MMA(1, 0, At, B0); PG8_MMA(1, 1, At, B1); PG8_BAR; PG8_SCHED;
            } else {
            PG8_LDB(B0, 0, 0); PG8_SCHED; PG8_LDA(At, 0, 0); PG8_STAGE(PG8_SA(1, 1), a1 + hstep, voffA);
            PG8_WAIT_L(8); PG8_BAR; PG8_WAIT_L(0); PG8_MMA(0, 0, At, B0); PG8_BAR; PG8_SCHED;
            PG8_LDB(B1, 0, 1); PG8_STAGE(PG8_SB(0, 0), b2, voffB);
            PG8_BAR; PG8_WAIT_L(0); PG8_MMA(0, 1, At, B1); PG8_BAR;
            PG8_LDA(At, 0, 1); PG8_STAGE(PG8_SA(0, 0), a2, voffA);
            PG8_BAR; PG8_WAIT_L(0); PG8_MMA(1, 0, At, B0); PG8_BAR; PG8_SCHED;
            PG8_STAGE(PG8_SB(0, 1), b2 + hstep, voffB);
            PG8_WAIT_V(6); PG8_BAR; PG8_MMA(1, 1, At, B1); PG8_BAR;
            PG8_LDB(B0, 1, 0); PG8_SCHED; PG8_LDA(At, 1, 0); PG8_STAGE(PG8_SA(0, 1), a2 + hstep, voffA);
            PG8_WAIT_L(8); PG8_BAR; PG8_WAIT_L(0); PG8_MMA(0, 0, At, B0); PG8_BAR; PG8_SCHED;
            PG8_LDB(B1, 1, 1); PG8_STAGE(PG8_SB(1, 0), b3, voffB);
            PG8_BAR; PG8_WAIT_L(0); PG8_MMA(0, 1, At, B1); PG8_BAR;
            PG8_LDA(At, 1, 1); PG8_STAGE(PG8_SA(1, 0), a3, voffA);
            PG8_BAR; PG8_WAIT_L(0); PG8_MMA(1, 0, At, B0); PG8_BAR; PG8_SCHED;
            PG8_STAGE(PG8_SB(1, 1), b3 + hstep, voffB);
            PG8_WAIT_V(6); PG8_BAR; PG8_MMA(1, 1, At, B1); PG8_BAR;
            }
        }
        if constexpr (ALIGN_EPI) { if (wr == 0) PG8_BAR; }
        if constexpr (!Epi::AFTER_DRAIN) { E(acc, cur, wr, wc, fr, fq); S.done(cur); }
        if (!has_next) break;
#pragma unroll
        for (int a = 0; a < 2; ++a)
#pragma unroll
            for (int b = 0; b < 2; ++b)
#pragma unroll
                for (int m = 0; m < 4; ++m)
#pragma unroll
                    for (int n = 0; n < 2; ++n) acc[a][b][m][n] = (f32x4){0.f, 0.f, 0.f, 0.f};
        cur = nxt; cA = nA; cB = nB; ++ui;
        if constexpr (ALIGN_EPI) { if (wr == 1) PG8_BAR; }
    }
    PG8_WAIT_V(0);
    if constexpr (!ALIGN_EPI) { if (wr == 0) PG8_BAR; }
    PG8_BAR;
    if constexpr (Epi::AFTER_DRAIN) { E.fused(acc, cur, wr, wc, fr, fq, lds, wid, lane); S.done(cur); }
#undef PG8_SA
#undef PG8_SB
#undef PG8_STAGE
#undef PG8_LDA
#undef PG8_LDB
#undef PG8_MMA
#undef PG8_WAIT_V
#undef PG8_WAIT_L
#undef PG8_BAR
#undef PG8_SCHED
}
}

#define LAS __attribute__((address_space(3)))
typedef unsigned short bf16_t;
typedef short bf16x8 __attribute__((ext_vector_type(8)));
typedef short s16x4 __attribute__((ext_vector_type(4)));
typedef float f32x4 __attribute__((ext_vector_type(4)));
typedef unsigned u32x4 __attribute__((ext_vector_type(4)));
typedef unsigned u32x2 __attribute__((ext_vector_type(2)));

__device__ __forceinline__ float wave_sum(float v) {
#pragma unroll
    for (int o = 1; o < 64; o <<= 1) v += __shfl_xor(v, o);
    return v;
}
__device__ __forceinline__ unsigned pk2(float lo, float hi) { return pg8::cvt_pk_bf16(lo, hi); }
__device__ __forceinline__ float bflo(unsigned w) { return __uint_as_float(w << 16); }
__device__ __forceinline__ float bfhi(unsigned w) { return __uint_as_float(w & 0xffff0000u); }

constexpr size_t MiB = 1u << 20;
constexpr size_t WS_SSQ1 = 64 * 1024, WS_SSQ2 = 128 * 1024, WS_SSQ3 = 192 * 1024, WS_RSTDX = 256 * 1024;
constexpr size_t WS_LSE = 1 * MiB;
constexpr size_t WS_BT1 = 2 * MiB;
constexpr size_t WS_BT2 = 22 * MiB;
constexpr size_t WS_BT3 = 30 * MiB;
constexpr size_t WS_BT4 = 74 * MiB;
constexpr size_t WS_BT5 = 96 * MiB;
constexpr size_t WS_BT6 = 104 * MiB;
constexpr size_t WS_PB = 105 * MiB;
constexpr size_t WS_XB = 114 * MiB;
constexpr size_t WS_YMIX = 178 * MiB;
constexpr size_t WS_PROJ = 242 * MiB;
constexpr size_t WS_END = 418 * MiB;

constexpr int RING_BYTES = 131072;
constexpr int LUT_OFF = RING_BYTES;
constexpr int LDS_BYTES = 147456;

constexpr int MISC_OFF = RING_BYTES + 1024;
constexpr size_t WS_BAR = 0;

#define XB_TMO      128
#define XB_XCNT(j)  (256  + 64 * (j))
#define XB_XSUB(j)  (1280 + 64 * (j))
#define XB_XGEN(j)  (2304 + 64 * (j))
#define XB_TOP      3328
#define XB_TOPGEN   3392
#define XCD_BAR_WORDS 3456
#define XB_SPIN_CAP (1u << 18)

__device__ __forceinline__ unsigned xb_ld(unsigned* p)              { return __hip_atomic_load(p, __ATOMIC_RELAXED, __HIP_MEMORY_SCOPE_AGENT); }
__device__ __forceinline__ unsigned xb_add(unsigned* p, unsigned v) { return __hip_atomic_fetch_add(p, v, __ATOMIC_RELAXED, __HIP_MEMORY_SCOPE_AGENT); }
__device__ __forceinline__ unsigned xb_xcc_id() { return (unsigned)__builtin_amdgcn_s_getreg((3 << 11) | 20) & 0xFu; }
#define XB_SPIN(cond, bar) do { unsigned _sp = 0; while (cond) { __builtin_amdgcn_s_sleep(1); \
    if ((++_sp & 255u) == 0u) { if (xb_ld(&(bar)[XB_TMO])) break; if (_sp > XB_SPIN_CAP) { atomicAdd(&(bar)[XB_TMO], 1u); break; } } } } while (0)

struct XcdBarrier {
    unsigned* bar; unsigned x;
    volatile LAS unsigned* st;
};

__device__ __forceinline__ XcdBarrier xcd_barrier_post(unsigned* bar, volatile LAS unsigned* st) {
    XcdBarrier b; b.bar = bar; b.x = xb_xcc_id(); b.st = st;
    if (threadIdx.x == 0) (void)xb_add(&bar[XB_XCNT(b.x)], 1u);
    return b;
}
__device__ __forceinline__ void xcd_barrier_complete(unsigned* bar, unsigned x, unsigned& nloc, unsigned& nx) {
    const unsigned G = gridDim.x * gridDim.y * gridDim.z;
    unsigned sum, cnt, mine, sp = 0u;
    for (;;) {
        sum = 0u; cnt = 0u; mine = 0u;
#pragma unroll
        for (unsigned j = 0; j < 16; ++j) { const unsigned c = xb_ld(&bar[XB_XCNT(j)]); sum += c; cnt += (c > 0u) ? 1u : 0u; mine = (j == x) ? c : mine; }
        if (sum == G) break;
        __builtin_amdgcn_s_sleep(1);
        if ((++sp & 255u) == 0u) { if (xb_ld(&bar[XB_TMO])) break; if (sp > XB_SPIN_CAP) { atomicAdd(&bar[XB_TMO], 1u); break; } }
    }
    nloc = mine > 0u ? mine : 1u; nx = cnt > 0u ? cnt : 1u;
}

__device__ __forceinline__ void xcd_barrier(const XcdBarrier& b) {
    asm volatile("s_waitcnt vmcnt(0)" ::: "memory");
    __syncthreads();
    if (threadIdx.x == 0) {
        unsigned* bar = b.bar;
        __builtin_amdgcn_s_waitcnt(0);
        unsigned nloc = b.st[0], nx = b.st[1];
        if (nloc == 0u) { xcd_barrier_complete(bar, b.x, nloc, nx); b.st[0] = nloc; b.st[1] = nx; }
        const unsigned old = xb_add(&bar[XB_XSUB(b.x)], 1u);
        const unsigned gen = old / nloc;
        if (old + 1u == (gen + 1u) * nloc) {
            __builtin_amdgcn_fence(__ATOMIC_RELEASE, "agent");
            asm volatile("s_waitcnt vmcnt(0)" ::: "memory");
            const unsigned og = xb_add(&bar[XB_TOP], 1u);
            const unsigned tg = og / nx;
            if (og + 1u == (tg + 1u) * nx) xb_add(&bar[XB_TOPGEN], 1u);
            else XB_SPIN(xb_ld(&bar[XB_TOPGEN]) == tg, bar);
            __builtin_amdgcn_fence(__ATOMIC_ACQUIRE, "agent");
            xb_add(&bar[XB_XGEN(b.x)], 1u);
            asm volatile("s_waitcnt vmcnt(0)" ::: "memory");
        } else {
            XB_SPIN(xb_ld(&bar[XB_XGEN(b.x)]) == gen, bar);
            __builtin_amdgcn_fence(__ATOMIC_ACQUIRE, "agent");
            asm volatile("s_waitcnt vmcnt(0)" ::: "memory");
        }
    }
    __syncthreads();
}

__device__ __forceinline__ void transpose_item(const float* W, int N, const float* gain, bf16_t* WT, int ldk, int drow0, int k0, int n0, LAS float* scr, int lane) {
#pragma unroll 8
    for (int i = 0; i < 32; ++i) { const int kk = 2 * i + (lane >> 5); float v = W[(size_t)(k0 + kk) * N + n0 + (lane & 31)]; if (gain) v *= gain[k0 + kk]; scr[kk * 33 + (lane & 31)] = v; }
    asm volatile("s_waitcnt lgkmcnt(0)" ::: "memory");
    const int c = lane & 7;
#pragma unroll
    for (int j = 0; j < 4; ++j) { const int n = (lane >> 3) + 8 * j; const LAS float* s = scr + (8 * c) * 33 + n;
        u32x4 o; o.x = pk2(s[0 * 33], s[1 * 33]); o.y = pk2(s[2 * 33], s[3 * 33]); o.z = pk2(s[4 * 33], s[5 * 33]); o.w = pk2(s[6 * 33], s[7 * 33]);
        *(u32x4*)(WT + (size_t)(drow0 + n) * ldk + k0 + 8 * c) = o; }
    asm volatile("s_waitcnt lgkmcnt(0)" ::: "memory");
}

struct Ptrs {
    const float *x, *p, *rel_bias, *g_mix, *w_in, *pool_w, *pool_scale, *w_out, *g_ffn, *w_gate, *w_up, *w_down, *g_ple, *w_pg, *w_pp, *g_final;
    float* out; unsigned char* ws;
};

__device__ __forceinline__ void prologue(const Ptrs& P, LAS unsigned char* lds, int gw, int NGW, int wid, int lane) {
    unsigned char* ws = P.ws;
    LAS float* scr = (LAS float*)(lds + wid * 16384);
    bf16_t* BT1 = (bf16_t*)(ws + WS_BT1); bf16_t* BT2 = (bf16_t*)(ws + WS_BT2); bf16_t* BT3 = (bf16_t*)(ws + WS_BT3);
    bf16_t* BT4 = (bf16_t*)(ws + WS_BT4); bf16_t* BT5 = (bf16_t*)(ws + WS_BT5); bf16_t* BT6 = (bf16_t*)(ws + WS_BT6);
    constexpr int I_IN = (DM / 64) * (NIN / 32);
    constexpr int I_OUT = ((DM - 512) / 64) * (DM / 32);
    constexpr int I_G = (DM / 64) * (DFF / 32);
    constexpr int I_DN = (DFF / 64) * (DM / 32);
    constexpr int I_PG = (DM / 64) * (DM / 32);
    constexpr int I_PP = (DPLE / 64) * (DM / 32);
    constexpr int NITEMS = I_IN + I_OUT + 2 * I_G + I_DN + I_PG + I_PP;
    for (int it = gw; it < NITEMS; it += NGW) {
        int r = it;
        if (r < I_IN) { const int nb = NIN / 32, kb = r / nb, n0 = 32 * (r % nb); transpose_item(P.w_in, NIN, P.g_mix, BT1, DM, n0, 64 * kb, n0, scr, lane); continue; } r -= I_IN;
        if (r < I_OUT) { const int nb = DM / 32, kb = r / nb, n0 = 32 * (r % nb); transpose_item(P.w_out, DM, nullptr, BT2, DM, n0, 512 + 64 * kb, n0, scr, lane); continue; } r -= I_OUT;
        if (r < I_G) { const int nb = DFF / 32, kb = r / nb, n0 = 32 * (r % nb); transpose_item(P.w_gate, DFF, P.g_ffn, BT3, DM, (n0 >> 7) * 256 + (n0 & 127), 64 * kb, n0, scr, lane); continue; } r -= I_G;
        if (r < I_G) { const int nb = DFF / 32, kb = r / nb, n0 = 32 * (r % nb); transpose_item(P.w_up, DFF, P.g_ffn, BT3, DM, (n0 >> 7) * 256 + 128 + (n0 & 127), 64 * kb, n0, scr, lane); continue; } r -= I_G;
        if (r < I_DN) { const int nb = DM / 32, kb = r / nb, n0 = 32 * (r % nb); transpose_item(P.w_down, DM, nullptr, BT4, DFF, n0, 64 * kb, n0, scr, lane); continue; } r -= I_DN;
        if (r < I_PG) { const int nb = DM / 32, kb = r / nb, n0 = 32 * (r % nb); transpose_item(P.w_pg, DM, P.g_ple, BT5, DM, n0, 64 * kb, n0, scr, lane); continue; } r -= I_PG;
        { const int nb = DM / 32, kb = r / nb, n0 = 32 * (r % nb); transpose_item(P.w_pp, DM, nullptr, BT6, DPLE, n0, 64 * kb, n0, scr, lane); }
    }
    for (int it = gw; it < 1024; it += NGW) {
        const int kq = it >> 3, nc = it & 7, k4 = kq * 4, g = k4 >> 7, n = nc * 256 + lane * 4;
        f32x4 acc[4] = {{0.f, 0.f, 0.f, 0.f}, {0.f, 0.f, 0.f, 0.f}, {0.f, 0.f, 0.f, 0.f}, {0.f, 0.f, 0.f, 0.f}};
        const float* pw = P.pool_w + (size_t)k4 * 128;
        const float* ps = P.pool_scale + g * 128;
        const float* wo = P.w_out + (size_t)(g * 128) * DM + n;
#pragma unroll 4
        for (int d = 0; d < 128; ++d) {
            const f32x4 wv = *(const f32x4*)(wo + (size_t)d * DM); const float sc = ps[d];
#pragma unroll
            for (int cc = 0; cc < 4; ++cc) acc[cc] += (pw[cc * 128 + d] * sc) * wv;
        }
#pragma unroll
        for (int j = 0; j < 4; ++j) { u32x2 o; o.x = pk2(acc[0][j], acc[1][j]); o.y = pk2(acc[2][j], acc[3][j]); *(u32x2*)(BT2 + (size_t)(n + j) * DM + k4) = o; }
    }
    bf16_t* XB = (bf16_t*)(ws + WS_XB); float* rstdx = (float*)(ws + WS_RSTDX);
    for (int row = gw; row < MROWS; row += NGW) {
        const float* xr = P.x + (size_t)row * DM + lane * 8; f32x4 v[4][2]; float s = 0.f;
#pragma unroll
        for (int j = 0; j < 4; ++j) { v[j][0] = *(const f32x4*)(xr + 512 * j); v[j][1] = *(const f32x4*)(xr + 512 * j + 4); s += pg8::dot4(v[j][0]) + pg8::dot4(v[j][1]); }
        s = wave_sum(s);
        if (lane == 0) rstdx[row] = 1.0f / sqrtf(s * (1.0f / DM) + RMS_EPS);
        bf16_t* o = XB + (size_t)row * DM + lane * 8;
#pragma unroll
        for (int j = 0; j < 4; ++j) *(u32x4*)(o + 512 * j) = pg8::pack8(v[j][0], v[j][1]);
    }
    bf16_t* PB = (bf16_t*)(ws + WS_PB);
    for (int c = gw * 64 + lane; c < MROWS * DPLE / 8; c += NGW * 64) {
        const f32x4 a = *(const f32x4*)(P.p + (size_t)c * 8), b = *(const f32x4*)(P.p + (size_t)c * 8 + 4);
        *(u32x4*)(PB + (size_t)c * 8) = pg8::pack8(a, b);
    }
    float* z = (float*)(ws + WS_SSQ1);
    for (int c = gw * 64 + lane; c < 3 * MROWS; c += NGW * 64) z[c] = 0.f;
}

__device__ __forceinline__ void ld8(const bf16_t* p, float (&f)[8]) { const u32x4 w = *(const u32x4*)p; f[0] = bflo(w.x); f[1] = bfhi(w.x); f[2] = bflo(w.y); f[3] = bfhi(w.y); f[4] = bflo(w.z); f[5] = bfhi(w.z); f[6] = bflo(w.w); f[7] = bfhi(w.w); }
__device__ __forceinline__ void pool_item(const bf16_t* proj, bf16_t* ymix, int item, int lane) {
    const int gi = item & 3, tg = item >> 2, w = 2 << gi, rq = lane >> 4, oct = lane & 15;
    const int t0 = tg * 16 + rq * 4, pos0 = t0 & (SEQ - 1), col = gi * 128 + oct * 8;
    const bf16_t* u = proj + (size_t)t0 * NIN + col;
    float acc[8] = {0.f, 0.f, 0.f, 0.f, 0.f, 0.f, 0.f, 0.f}, f[8];
#pragma unroll
    for (int k = 1; k < 16; ++k) if (k < w && pos0 - k >= 0) { ld8(u - (size_t)k * NIN, f);
#pragma unroll
        for (int e = 0; e < 8; ++e) acc[e] += f[e]; }
#pragma unroll
    for (int i = 0; i < 4; ++i) {
        float cur[8]; ld8(u + (size_t)i * NIN, cur);
#pragma unroll
        for (int e = 0; e < 8; ++e) acc[e] += cur[e];
        if (i > 0 && pos0 + i - w >= 0) { ld8(u + (size_t)(i - w) * NIN, f);
#pragma unroll
            for (int e = 0; e < 8; ++e) acc[e] -= f[e]; }
        const int cnt = (pos0 + i + 1 < w) ? (pos0 + i + 1) : w; const float ic = 1.0f / (float)cnt;
        u32x4 o; o.x = pk2(acc[0] * ic - cur[0], acc[1] * ic - cur[1]); o.y = pk2(acc[2] * ic - cur[2], acc[3] * ic - cur[3]);
        o.z = pk2(acc[4] * ic - cur[4], acc[5] * ic - cur[5]); o.w = pk2(acc[6] * ic - cur[6], acc[7] * ic - cur[7]);
        *(u32x4*)(ymix + (size_t)(t0 + i) * DM + col) = o;
    }
}

__device__ const unsigned char T5_BUCKET[3][129] = {
{0,1,2,3,4,5,6,7,8,9,10,11,12,13,14,15,16,16,16,16,16,16,17,17,17,17,17,17,17,17,18,18,18,18,18,18,18,18,18,18,19,19,19,19,19,19,19,19,19,19,19,19,19,19,20,20,20,20,20,20,20,20,20,20,20,20,20,20,20,20,20,20,20,21,21,21,21,21,21,21,21,21,21,21,21,21,21,21,21,21,21,21,21,21,21,21,21,21,21,22,22,22,22,22,22,22,22,22,22,22,22,22,22,22,22,22,22,22,22,22,22,22,22,22,22,22,22,22,22},
{0,4,8,12,16,16,17,17,18,18,19,19,19,19,20,20,20,20,20,21,21,21,21,21,21,22,22,22,22,22,22,22,22,22,23,23,23,23,23,23,23,23,23,23,23,23,24,24,24,24,24,24,24,24,24,24,24,24,24,24,24,24,25,25,25,25,25,25,25,25,25,25,25,25,25,25,25,25,25,25,25,25,25,26,26,26,26,26,26,26,26,26,26,26,26,26,26,26,26,26,26,26,26,26,26,26,26,26,26,26,26,26,26,27,27,27,27,27,27,27,27,27,27,27,27,27,27,27,27},
{0,16,18,19,20,21,21,22,22,23,23,23,24,24,24,24,25,25,25,25,25,26,26,26,26,26,26,26,26,27,27,27,27,27,27,27,27,27,27,28,28,28,28,28,28,28,28,28,28,28,28,28,29,29,29,29,29,29,29,29,29,29,29,29,29,29,29,29,29,29,30,30,30,30,30,30,30,30,30,30,30,30,30,30,30,30,30,30,30,30,30,30,30,30,30,31,31,31,31,31,31,31,31,31,31,31,31,31,31,31,31,31,31,31,31,31,31,31,31,31,31,31,31,31,31,31,31,31,31}};

__device__ __forceinline__ s16x4 vtr(LAS const unsigned char* p) { typedef short v4i16_t __attribute__((ext_vector_type(4))); return __builtin_bit_cast(s16x4, __builtin_amdgcn_ds_read_tr16_b64_v4i16((LAS v4i16_t*)p)); }

__device__ __forceinline__ void attn_item(LAS unsigned char* lds, const bf16_t* proj, bf16_t* ymix, float* lse, const float* rel_bias, int item) {
    const int tid = threadIdx.x, lane = tid & 63, wid = __builtin_amdgcn_readfirstlane(tid >> 6), fr = lane & 15, fq = lane >> 4;
    const int g = item >> 9, idx = item & 511, dsh = 2 * g, d = 1 << dsh, nbsh = 6 - dsh;
    const int seq = idx >> nbsh, n = idx & ((1 << nbsh) - 1), r = seq & (d - 1), bh = seq >> dsh, hl = bh & 3, b = bh >> 2, head = g * 4 + hl;
    const size_t rowbase = (size_t)b * SEQ;
    const bf16_t* kbase = proj + 2048 + head * HD; const bf16_t* vbase = proj + 3584 + head * HD;
#pragma unroll
    for (int j = 0; j < 8; ++j) {
        const int piece = wid * 8 + j, key = piece * 4 + (lane >> 4), cp = lane & 15;
        int l = 128 * (n - 1) + key; if (l < 0) l += 128;
        const size_t grow = rowbase + ((size_t)l << dsh) + r;
        const int kc = cp ^ (key & 15), vc = (((cp >> 1) ^ (key & 7)) << 1) | (cp & 1);
        __builtin_amdgcn_global_load_lds((const unsigned*)(kbase + grow * NIN + kc * 8), (LAS unsigned*)(lds + piece * 1024), 16, 0, 0);
        __builtin_amdgcn_global_load_lds((const unsigned*)(vbase + grow * NIN + vc * 8), (LAS unsigned*)(lds + 65536 + piece * 1024), 16, 0, 0);
    }
    if (tid < 129) ((LAS float*)(lds + LUT_OFF))[tid] = rel_bias[(int)T5_BUCKET[g][tid] * NHEADS + head] * LOG2E;
    const int q0 = wid * 16;
    const size_t qrow = rowbase + ((size_t)(128 * n + q0 + fr) << dsh) + r;
    bf16x8 qf[4];
#pragma unroll
    for (int s = 0; s < 4; ++s) qf[s] = *(const bf16x8*)(proj + qrow * NIN + 512 + head * HD + 32 * s + 8 * fq);
    asm volatile("s_waitcnt vmcnt(0) lgkmcnt(0)" ::: "memory");
    __syncthreads();
    f32x4 sc[9];
#pragma unroll
    for (int jt = 0; jt < 9; ++jt) {
        f32x4 a = {0.f, 0.f, 0.f, 0.f};
        LAS const unsigned char* kp = lds + (q0 + 16 * jt + fr) * 256;
#pragma unroll
        for (int s = 0; s < 4; ++s) { const bf16x8 kf = *(LAS const bf16x8*)(kp + (((4 * s + fq) ^ fr) << 4)); a = __builtin_amdgcn_mfma_f32_16x16x32_bf16(kf, qf[s], a, 0, 0, 0); }
        sc[jt] = a;
    }
    LAS const float* lut = (LAS const float*)(lds + LUT_OFF);
    float mx = -3.0e38f;
#pragma unroll
    for (int jt = 0; jt < 9; ++jt)
#pragma unroll
        for (int e = 0; e < 4; ++e) {
            const int off = 128 + fr - 16 * jt - 4 * fq - e, ki = q0 + 16 * jt + 4 * fq + e;
            const bool ok = (off >= 0) && (off <= 128) && (n > 0 || ki >= 128);
            const int oc = off < 0 ? 0 : (off > 128 ? 128 : off);
            const float v = ok ? sc[jt][e] + lut[oc] : -1.0e30f;
            sc[jt][e] = v; mx = fmaxf(mx, v);
        }
    mx = fmaxf(mx, __shfl_xor(mx, 16)); mx = fmaxf(mx, __shfl_xor(mx, 32));
    float den = 0.f;
#pragma unroll
    for (int jt = 0; jt < 9; ++jt)
#pragma unroll
        for (int e = 0; e < 4; ++e) { const float pv = __builtin_amdgcn_exp2f(sc[jt][e] - mx); sc[jt][e] = pv; den += pv; }
    den += __shfl_xor(den, 16); den += __shfl_xor(den, 32);
    bf16x8 pb[5];
#pragma unroll
    for (int ks = 0; ks < 5; ++ks) {
        u32x4 w; w.x = pk2(sc[2 * ks][0], sc[2 * ks][1]); w.y = pk2(sc[2 * ks][2], sc[2 * ks][3]);
        if (ks < 4) { w.z = pk2(sc[2 * ks + 1][0], sc[2 * ks + 1][1]); w.w = pk2(sc[2 * ks + 1][2], sc[2 * ks + 1][3]); } else { w.z = 0u; w.w = 0u; }
        pb[ks] = __builtin_bit_cast(bf16x8, w);
    }
    f32x4 o[8];
#pragma unroll
    for (int db = 0; db < 8; ++db) o[db] = (f32x4){0.f, 0.f, 0.f, 0.f};
#pragma unroll
    for (int ks = 0; ks < 5; ++ks) {
        const int rowA = q0 + 32 * ks + 4 * fq + (fr >> 2), rowB = (ks < 4) ? rowA + 16 : rowA;
        LAS const unsigned char* va = lds + 65536 + rowA * 256 + 8 * (fr & 3);
        LAS const unsigned char* vb = lds + 65536 + rowB * 256 + 8 * (fr & 3);
#pragma unroll
        for (int db = 0; db < 8; ++db) {
            const s16x4 lo = vtr(va + ((db ^ (rowA & 7)) << 5)), hi = vtr(vb + ((db ^ (rowB & 7)) << 5));
            const bf16x8 vf = {lo[0], lo[1], lo[2], lo[3], hi[0], hi[1], hi[2], hi[3]};
            o[db] = __builtin_amdgcn_mfma_f32_16x16x32_bf16(vf, pb[ks], o[db], 0, 0, 0);
        }
    }
    const float inv = 1.0f / den;
    bf16_t* orow = ymix + qrow * DM + 512 + head * HD + 4 * fq;
#pragma unroll
    for (int db = 0; db < 8; ++db) { u32x2 w; w.x = pk2(o[db][0] * inv, o[db][1] * inv); w.y = pk2(o[db][2] * inv, o[db][3] * inv); *(u32x2*)(orow + 16 * db) = w; }
    if (fq == 0) lse[qrow * NHEADS + head] = (mx + __builtin_amdgcn_logf(den)) * LN2;
    asm volatile("s_waitcnt lgkmcnt(0)" ::: "memory");
    __syncthreads();
}

__device__ __forceinline__ void mix_row(bf16_t* ymix, const float* lse, int row, int lane) {
    const int hs = lane >> 4; const float* l = lse + (size_t)row * NHEADS + hs;
    const float l0 = l[0], l1 = l[4], l2 = l[8], m = fmaxf(l0, fmaxf(l1, l2));
    const float e0 = __expf(l0 - m), e1 = __expf(l1 - m), e2 = __expf(l2 - m), inv = 1.0f / (e0 + e1 + e2);
    const float al[3] = {e0 * inv, e1 * inv, e2 * inv};
    bf16_t* y = ymix + (size_t)row * DM + 512 + lane * 8;
#pragma unroll
    for (int j = 0; j < 3; ++j) { const u32x4 w = *(const u32x4*)(y + 512 * j); const float a = al[j]; u32x4 o;
        o.x = pk2(bflo(w.x) * a, bfhi(w.x) * a); o.y = pk2(bflo(w.y) * a, bfhi(w.y) * a); o.z = pk2(bflo(w.z) * a, bfhi(w.z) * a); o.w = pk2(bflo(w.w) * a, bfhi(w.w) * a);
        *(u32x4*)(y + 512 * j) = o; }
}
__device__ __forceinline__ void final_row(float* out, const bf16_t* h3, const float* ssq, const float* gfin, int row, int lane) {
    const float r = 1.0f / sqrtf(ssq[row] * (1.0f / DM) + RMS_EPS);
    float* o = out + (size_t)row * DM + lane * 8; const bf16_t* hh = h3 + (size_t)row * DM + lane * 8;
#pragma unroll
    for (int j = 0; j < 4; ++j) { const u32x4 w = *(const u32x4*)(hh + 512 * j); const f32x4 g0 = *(const f32x4*)(gfin + lane * 8 + 512 * j), g1 = *(const f32x4*)(gfin + lane * 8 + 512 * j + 4);
        const f32x4 v0 = {bflo(w.x), bfhi(w.x), bflo(w.y), bfhi(w.y)}, v1 = {bflo(w.z), bfhi(w.z), bflo(w.w), bfhi(w.w)};
        *(f32x4*)(o + 512 * j) = v0 * r * g0; *(f32x4*)(o + 512 * j + 4) = v1 * r * g1; }
}

struct Args { const float* in[16]; float* out; unsigned char* ws; };

#define PG8_ALIGN true
#define PG8_SP2 true

__global__ void __launch_bounds__(512, 2) hymba_fwd(Args args) {
    extern __shared__ __attribute__((aligned(16))) unsigned char lds_raw[];
    LAS unsigned char* lds = (LAS unsigned char*)lds_raw;
    cg::grid_group grid = cg::this_grid();
    const int tid = threadIdx.x, lane = tid & 63, wid = __builtin_amdgcn_readfirstlane(tid >> 6);
    const int G = gridDim.x, bx = blockIdx.x;
    const int vcu = (G % 8 == 0) ? (bx % 8) * (G / 8) + bx / 8 : bx;
    const int gw = vcu * 8 + wid, NGW = G * 8;
    Ptrs P;
    P.x = args.in[0]; P.p = args.in[1]; P.rel_bias = args.in[2]; P.g_mix = args.in[3]; P.w_in = args.in[4]; P.pool_w = args.in[5]; P.pool_scale = args.in[6]; P.w_out = args.in[7];
    P.g_ffn = args.in[8]; P.w_gate = args.in[9]; P.w_up = args.in[10]; P.w_down = args.in[11]; P.g_ple = args.in[12]; P.w_pg = args.in[13]; P.w_pp = args.in[14]; P.g_final = args.in[15];
    P.out = args.out; P.ws = args.ws;
    unsigned char* ws = args.ws;
    bf16_t* BT1 = (bf16_t*)(ws + WS_BT1); bf16_t* BT2 = (bf16_t*)(ws + WS_BT2); bf16_t* BT3 = (bf16_t*)(ws + WS_BT3);
    bf16_t* BT4 = (bf16_t*)(ws + WS_BT4); bf16_t* BT5 = (bf16_t*)(ws + WS_BT5); bf16_t* BT6 = (bf16_t*)(ws + WS_BT6);
    bf16_t* PB = (bf16_t*)(ws + WS_PB); bf16_t* XB = (bf16_t*)(ws + WS_XB); bf16_t* YMIX = (bf16_t*)(ws + WS_YMIX); bf16_t* PROJ = (bf16_t*)(ws + WS_PROJ);
    float* SSQ1 = (float*)(ws + WS_SSQ1); float* SSQ2 = (float*)(ws + WS_SSQ2); float* SSQ3 = (float*)(ws + WS_SSQ3); float* RSTDX = (float*)(ws + WS_RSTDX); float* LSE = (float*)(ws + WS_LSE);

    volatile LAS unsigned* MISC = (volatile LAS unsigned*)(lds + MISC_OFF);
    if (tid < 2) MISC[tid] = 0u;
    if (bx == 0) for (int u = tid; u < XCD_BAR_WORDS; u += 512) ((unsigned*)(ws + WS_BAR))[u] = 0u;
    prologue(P, lds, gw, NGW, wid, lane);
    grid.sync();
    const XcdBarrier bar = xcd_barrier_post((unsigned*)(ws + WS_BAR), MISC);

    { pg8::Gemm g{XB, BT1, MROWS, NIN, DM}; pg8::StaticOrder S; S.init(MROWS, NIN, G, bx);
      pg8::EpiProj E{PROJ, NIN, RSTDX, 2, 8, QSCALE};
      pg8::gemm_phase<pg8::EpiProj, pg8::StaticOrder, PG8_ALIGN, PG8_SP2>(lds, g, S, E); }
    xcd_barrier(bar);

    { const int per = (1536 + G - 1) / G;
      for (int i = 0; i < per; ++i) { const int item = vcu * per + i; if (item >= 1536) break; attn_item(lds, PROJ, YMIX, LSE, P.rel_bias, item); }
      for (int it = gw; it < 4096; it += NGW) pool_item(PROJ, YMIX, it, lane); }
    xcd_barrier(bar);

    for (int row = gw; row < MROWS; row += NGW) mix_row(YMIX, LSE, row, lane);
    xcd_barrier(bar);

    { pg8::Gemm g{YMIX, BT2, MROWS, DM, DM}; pg8::StaticOrder S; S.init(MROWS, DM, G, bx);
      pg8::EpiRes E{XB, XB, SSQ1, DM};
      pg8::gemm_phase<pg8::EpiRes, pg8::StaticOrder, PG8_ALIGN, PG8_SP2>(lds, g, S, E); }
    xcd_barrier(bar);

    { pg8::Gemm g{XB, BT3, MROWS, 2 * DFF, DM}; pg8::StaticOrder S; S.init(MROWS, 2 * DFF, G, bx);
      pg8::EpiSwiGLU E{PROJ, DFF, SSQ1, 1.0f / DM, RMS_EPS};
      pg8::gemm_phase<pg8::EpiSwiGLU, pg8::StaticOrder, PG8_ALIGN, PG8_SP2>(lds, g, S, E); }
    { int kpp = DPLE; asm volatile("" : "+s"(kpp));
      pg8::Gemm g{PB, BT6, MROWS, DM, kpp}; pg8::StaticOrder S; S.init(MROWS, DM, G, bx);
      pg8::EpiPlain E{YMIX, DM};
      pg8::gemm_phase<pg8::EpiPlain, pg8::StaticOrder, PG8_ALIGN, PG8_SP2>(lds, g, S, E); }
    xcd_barrier(bar);

    { pg8::Gemm g{PROJ, BT4, MROWS, DM, DFF}; pg8::StaticOrder S; S.init(MROWS, DM, G, bx);
      pg8::EpiRes E{XB, XB, SSQ2, DM};
      pg8::gemm_phase<pg8::EpiRes, pg8::StaticOrder, PG8_ALIGN, PG8_SP2>(lds, g, S, E); }
    xcd_barrier(bar);

    { pg8::Gemm g{XB, BT5, MROWS, DM, DM}; pg8::StaticOrder S; S.init(MROWS, DM, G, bx);
      pg8::EpiPle E{XB, YMIX, PROJ, SSQ2, SSQ3, DM, 1.0f / DM, RMS_EPS};
      pg8::gemm_phase<pg8::EpiPle, pg8::StaticOrder, PG8_ALIGN, PG8_SP2>(lds, g, S, E); }
    xcd_barrier(bar);

    for (int row = gw; row < MROWS; row += NGW) final_row(P.out, PROJ, SSQ3, P.g_final, row, lane);
}

extern "C" void kernel_launch(void* const* d_in, const int* in_sizes, int n_in, void* d_out, int out_size, void* d_ws, size_t ws_size, hipStream_t stream) {
    static int grid = 0;
    if (grid == 0) {
        if (n_in != 16 || in_sizes[0] != MROWS * DM || out_size != MROWS * DM || ws_size < WS_END) {
            fprintf(stderr, "kernel_launch: unexpected shapes (n_in %d, in0 %d, out %d, ws %zu); nothing launched\n", n_in, n_in > 0 ? in_sizes[0] : -1, out_size, ws_size); grid = -1; return; }
        int dev = 0, cus = 0, per_cu = 0;
        if (hipGetDevice(&dev) != hipSuccess || hipDeviceGetAttribute(&cus, hipDeviceAttributeMultiprocessorCount, dev) != hipSuccess) { fprintf(stderr, "kernel_launch: device query failed\n"); grid = -1; return; }
        if (hipFuncSetAttribute((const void*)hymba_fwd, hipFuncAttributeMaxDynamicSharedMemorySize, LDS_BYTES) != hipSuccess) { fprintf(stderr, "kernel_launch: hipFuncSetAttribute failed\n"); grid = -1; return; }
        if (hipOccupancyMaxActiveBlocksPerMultiprocessor(&per_cu, (const void*)hymba_fwd, 512, LDS_BYTES) != hipSuccess || per_cu < 1) { fprintf(stderr, "kernel_launch: occupancy query says %d blocks per CU\n", per_cu); (void)hipGetLastError(); per_cu = 1; }
        if (per_cu > 1) per_cu = 1;
        grid = cus * per_cu;
    }
    if (grid < 0) return;
    Args a{};
    for (int i = 0; i < 16; ++i) a.in[i] = (const float*)d_in[i];
    a.out = (float*)d_out; a.ws = (unsigned char*)d_ws;
    void* kargs[] = {&a};
    hipError_t e = hipLaunchCooperativeKernel((const void*)hymba_fwd, dim3(grid), dim3(512), kargs, LDS_BYTES, stream);
    if (e != hipSuccess) fprintf(stderr, "kernel_launch: cooperative launch failed: %s (grid %d)\n", hipGetErrorString(e), grid);
}
```

```cpp
#include <hip/hip_runtime.h>
#include <hip/hip_cooperative_groups.h>
#include <cstdio>
#include <cstdint>
namespace cg = cooperative_groups;

constexpr int BATCH = 2, SEQ = 8192, DM = 2048, MROWS = BATCH * SEQ, NIN = 5120, DFF = 5632, DPLE = 256, NHEADS = 12, HD = 128;
constexpr float RMS_EPS = 1e-6f;
constexpr float QSCALE = 0.08838834764831845f * 1.4426950408889634f;
constexpr float LOG2E = 1.4426950408889634f, LN2 = 0.6931471805599453f;
namespace pg8 {
#define PG8_LAS __attribute__((address_space(3)))
typedef unsigned short bf16_t;
typedef short bf16x8 __attribute__((ext_vector_type(8)));
typedef float f32x4 __attribute__((ext_vector_type(4)));
typedef unsigned u32x4 __attribute__((ext_vector_type(4)));
constexpr int BM = 256, BK = 64, HALF = 128, HTB = HALF * BK * 2  , STAGE_BYTES = 8 * HTB, NXCD = 8, WGM = 8;

__host__ __device__ __forceinline__ int lds_byte(int r, int c) { const int st = (r >> 4) * 2 + (c >> 5), rr = r & 15, cc = c & 31, ob = rr * 64 + cc * 2; return st * 1024 + (ob ^ (((ob >> 9) & 1) << 5)); }
__host__ __device__ __forceinline__ void stage_rc(int b, int& R, int& C) { const int st = b / 1024, sb = b % 1024, swz = sb ^ (((sb >> 9) & 1) << 5); R = (st >> 1) * 16 + swz / 64; C = (st & 1) * 32 + (swz % 64) / 2; }
__host__ __device__ __forceinline__ int perm32(int rho) { const int n = rho >> 4, i = rho & 15; return 8 * (i >> 2) + 4 * n + (i & 3); }

struct Unit { int pm, pn; };
struct Gemm { const bf16_t* A; const bf16_t* Bt; int M, N, K; };

struct StaticOrder {
    int nM, nN, nwg, G, c;
    __host__ __device__ void init(int M, int N, int G_, int c_) { nM = M / BM; nN = N / BM; nwg = nM * nN; G = G_; c = c_; }
    __host__ __device__ bool next(int i, Unit& u) const {
        const long L = (long)i * G + c; if (L >= nwg) return false;
        int wgid = (int)L; { const int q = nwg / NXCD, r = nwg % NXCD, xcd = wgid % NXCD, off = wgid / NXCD; wgid = (xcd < r ? xcd * (q + 1) : r * (q + 1) + (xcd - r) * q) + off; }
        const int nig = WGM * nN, gid = wgid / nig, fm = gid * WGM, gsz = (nM - fm) < WGM ? (nM - fm) : WGM;
        u.pm = fm + ((wgid % nig) % gsz); u.pn = (wgid % nig) / gsz; return true;
    }
    __device__ __forceinline__ void a_ready(const Unit&) const {}
    __device__ __forceinline__ void done(const Unit&) const {}
};

__device__ __forceinline__ unsigned cvt_pk_bf16(float lo, float hi) { unsigned r; asm volatile("v_cvt_pk_bf16_f32 %0, %1, %2" : "=v"(r) : "v"(lo), "v"(hi)); return r; }
__device__ __forceinline__ u32x4 pack8(const f32x4 v0, const f32x4 v1) { u32x4 w; w.x = cvt_pk_bf16(v0[0], v0[1]); w.y = cvt_pk_bf16(v0[2], v0[3]); w.z = cvt_pk_bf16(v1[0], v1[1]); w.w = cvt_pk_bf16(v1[2], v1[3]); return w; }
__device__ __forceinline__ float bf_lo(unsigned w) { return __uint_as_float(w << 16); }
__device__ __forceinline__ float bf_hi(unsigned w) { return __uint_as_float(w & 0xffff0000u); }
__device__ __forceinline__ float dot4(const f32x4 v) { return (v[0] * v[0] + v[1] * v[1]) + (v[2] * v[2] + v[3] * v[3]); }

struct EpiProj {
    static constexpr bool PERM = true, AFTER_DRAIN = false;
    bf16_t* O; int ldc; const float* rstd; int q_lo, q_hi; float qscale;
    __device__ __forceinline__ void operator()(const f32x4 (&acc)[2][2][4][2], const Unit& u, int wr, int wc, int fr, int fq) const {
        const int row0 = u.pm * BM + wr * 64 + fr, col0 = u.pn * BM + wc * 32 + 8 * fq;
        const float qs = (u.pn >= q_lo && u.pn < q_hi) ? qscale : 1.0f;
#pragma unroll
        for (int ai = 0; ai < 2; ++ai)
#pragma unroll
            for (int m = 0; m < 4; ++m) { const int row = row0 + ai * HALF + m * 16; const float s = rstd[row] * qs; bf16_t* rowp = O + (size_t)row * ldc + col0;
#pragma unroll
                for (int bj = 0; bj < 2; ++bj) *(u32x4*)(rowp + bj * HALF) = pack8(acc[ai][bj][m][0] * s, acc[ai][bj][m][1] * s); }
    }
};
struct EpiPlain {
    static constexpr bool PERM = true, AFTER_DRAIN = false;
    bf16_t* O; int ldc;
    __device__ __forceinline__ void operator()(const f32x4 (&acc)[2][2][4][2], const Unit& u, int wr, int wc, int fr, int fq) const {
        const int row0 = u.pm * BM + wr * 64 + fr, col0 = u.pn * BM + wc * 32 + 8 * fq;
#pragma unroll
        for (int ai = 0; ai < 2; ++ai)
#pragma unroll
            for (int m = 0; m < 4; ++m) { bf16_t* rowp = O + (size_t)(row0 + ai * HALF + m * 16) * ldc + col0;
#pragma unroll
                for (int bj = 0; bj < 2; ++bj) *(u32x4*)(rowp + bj * HALF) = pack8(acc[ai][bj][m][0], acc[ai][bj][m][1]); }
    }
};
struct EpiRes {
    static constexpr bool PERM = true, AFTER_DRAIN = false;
    const bf16_t* base; bf16_t* ob; float* ssq; int ldc;
    __device__ __forceinline__ void operator()(const f32x4 (&acc)[2][2][4][2], const Unit& u, int wr, int wc, int fr, int fq) const {
        const int row0 = u.pm * BM + wr * 64 + fr, col0 = u.pn * BM + wc * 32 + 8 * fq;
#pragma unroll
        for (int ai = 0; ai < 2; ++ai)
#pragma unroll
            for (int m = 0; m < 4; ++m) { const int row = row0 + ai * HALF + m * 16; const size_t off = (size_t)row * ldc + col0; float s = 0.f;
#pragma unroll
                for (int bj = 0; bj < 2; ++bj) {
                    const u32x4 bw = *(const u32x4*)(base + off + bj * HALF);
                    const f32x4 v0 = (f32x4){bf_lo(bw.x), bf_hi(bw.x), bf_lo(bw.y), bf_hi(bw.y)} + acc[ai][bj][m][0], v1 = (f32x4){bf_lo(bw.z), bf_hi(bw.z), bf_lo(bw.w), bf_hi(bw.w)} + acc[ai][bj][m][1];
                    *(u32x4*)(ob + off + bj * HALF) = pack8(v0, v1);
                    s += dot4(v0) + dot4(v1); }
                s += __shfl_xor(s, 16); s += __shfl_xor(s, 32);
                if (fq == 0) atomicAdd(ssq + row, s); }
    }
};
struct EpiSwiGLU {
    static constexpr bool PERM = true, AFTER_DRAIN = false;
    bf16_t* O; int ldc; const float* ssq; float inv_d, eps;
    __device__ __forceinline__ void operator()(const f32x4 (&acc)[2][2][4][2], const Unit& u, int wr, int wc, int fr, int fq) const {
        const int row0 = u.pm * BM + wr * 64 + fr, col0 = u.pn * HALF + wc * 32 + 8 * fq;
#pragma unroll
        for (int ai = 0; ai < 2; ++ai)
#pragma unroll
            for (int m = 0; m < 4; ++m) { const int row = row0 + ai * HALF + m * 16; const float r = __builtin_amdgcn_rsqf(ssq[row] * inv_d + eps);
                f32x4 o[2];
#pragma unroll
                for (int n = 0; n < 2; ++n)
#pragma unroll
                    for (int j = 0; j < 4; ++j) { const float g = acc[ai][0][m][n][j] * r, up = acc[ai][1][m][n][j] * r;
                        o[n][j] = g * up * __builtin_amdgcn_rcpf(1.0f + __builtin_amdgcn_exp2f(-1.4426950408889634f * g)); }
                *(u32x4*)(O + (size_t)row * ldc + col0) = pack8(o[0], o[1]); }
    }
};
struct EpiPle {
    static constexpr bool PERM = true, AFTER_DRAIN = false;
    const bf16_t* h; const bf16_t* pp; bf16_t* o; const float* ssq2; float* ssq3; int ldc; float inv_d, eps;
    __device__ __forceinline__ void operator()(const f32x4 (&acc)[2][2][4][2], const Unit& u, int wr, int wc, int fr, int fq) const {
        const int row0 = u.pm * BM + wr * 64 + fr, col0 = u.pn * BM + wc * 32 + 8 * fq;
#pragma unroll
        for (int ai = 0; ai < 2; ++ai)
#pragma unroll
            for (int m = 0; m < 4; ++m) { const int row = row0 + ai * HALF + m * 16; const size_t off = (size_t)row * ldc + col0; float s = 0.f;
                const float r = __builtin_amdgcn_rsqf(ssq2[row] * inv_d + eps);
#pragma unroll
                for (int bj = 0; bj < 2; ++bj) {
                    const u32x4 pw = *(const u32x4*)(pp + off + bj * HALF), hw = *(const u32x4*)(h + off + bj * HALF);
                    f32x4 v0 = {bf_lo(hw.x), bf_hi(hw.x), bf_lo(hw.y), bf_hi(hw.y)}, v1 = {bf_lo(hw.z), bf_hi(hw.z), bf_lo(hw.w), bf_hi(hw.w)};
                    const f32x4 p0 = {bf_lo(pw.x), bf_hi(pw.x), bf_lo(pw.y), bf_hi(pw.y)}, p1 = {bf_lo(pw.z), bf_hi(pw.z), bf_lo(pw.w), bf_hi(pw.w)};
#pragma unroll
                    for (int j = 0; j < 4; ++j) {
                        v0[j] += p0[j] * __builtin_amdgcn_rcpf(1.0f + __builtin_amdgcn_exp2f(-1.4426950408889634f * r * acc[ai][bj][m][0][j]));
                        v1[j] += p1[j] * __builtin_amdgcn_rcpf(1.0f + __builtin_amdgcn_exp2f(-1.4426950408889634f * r * acc[ai][bj][m][1][j])); }
                    *(u32x4*)(o + off + bj * HALF) = pack8(v0, v1);
                    s += dot4(v0) + dot4(v1); }
                s += __shfl_xor(s, 16); s += __shfl_xor(s, 32);
                if (fq == 0) atomicAdd(ssq3 + row, s); }
    }
};

template <class Epi, class Sched, bool ALIGN_EPI = false, bool SP2 = false>
__device__ __forceinline__ void gemm_phase(PG8_LAS unsigned char* lds, const Gemm g, const Sched& S, const Epi& E) {
    const int tid = threadIdx.x, wid = __builtin_amdgcn_readfirstlane(tid >> 6), lane = tid & 63, wr = wid >> 2, wc = wid & 3, fr = lane & 15, fq = lane >> 4;
    const int K = g.K, nt = K / BK;
    unsigned voffA[2], voffB[2];
#pragma unroll
    for (int i = 0; i < 2; ++i) { int R, C; stage_rc(tid * 16 + i * 8192, R, C); const int Rb = Epi::PERM ? ((R & ~31) + perm32(R & 31)) : R;
        voffA[i] = (unsigned)(R * K + C) * 2u; voffB[i] = (unsigned)(Rb * K + C) * 2u; }
    const size_t kstep = (size_t)(BK * 2);
    const size_t hstep = (size_t)HALF * K * 2;
    const size_t tstep = 2 * hstep;
    const unsigned ldsw = (unsigned)wid * 1024u;
    const int aoff = lds_byte(wr * 64 + fr, fq * 8), boff = lds_byte(wc * 32 + fr, fq * 8);
#define PG8_SA(b, h) (((b) * 2 + (h)) * HTB)
#define PG8_SB(b, h) ((4 + (b) * 2 + (h)) * HTB)
#define PG8_STAGE(bufoff, gbase, voff) do { _Pragma("unroll") for (int _i = 0; _i < 2; ++_i) \
        __builtin_amdgcn_global_load_lds((const unsigned*)((const char*)(gbase) + (voff)[_i]), (PG8_LAS unsigned*)(lds + (bufoff) + ldsw + _i * 8192), 16, 0, 0); } while (0)
#define PG8_LDA(dst, b, h) do { _Pragma("unroll") for (int m = 0; m < 4; ++m) _Pragma("unroll") for (int k = 0; k < 2; ++k) dst[m][k] = *(const PG8_LAS bf16x8*)(lds + PG8_SA(b, h) + aoff + m * 2048 + k * 1024); } while (0)
#define PG8_LDB(dst, b, h) do { _Pragma("unroll") for (int n = 0; n < 2; ++n) _Pragma("unroll") for (int k = 0; k < 2; ++k) dst[n][k] = *(const PG8_LAS bf16x8*)(lds + PG8_SB(b, h) + boff + n * 2048 + k * 1024); } while (0)
#define PG8_MMA(ai, bj, At, Bt) do { __builtin_amdgcn_s_setprio(1); _Pragma("unroll") for (int m = 0; m < 4; ++m) _Pragma("unroll") for (int n = 0; n < 2; ++n) _Pragma("unroll") for (int k = 0; k < 2; ++k) \
        acc[ai][bj][m][n] = __builtin_amdgcn_mfma_f32_16x16x32_bf16(Bt[n][k], At[m][k], acc[ai][bj][m][n], 0, 0, 0); __builtin_amdgcn_s_setprio(0); } while (0)
#define PG8_WAIT_V(n) asm volatile("s_waitcnt vmcnt(" #n ")" ::: "memory")
#define PG8_WAIT_L(n) asm volatile("s_waitcnt lgkmcnt(" #n ")" ::: "memory")
#define PG8_BAR __builtin_amdgcn_s_barrier()
#define PG8_SCHED __builtin_amdgcn_sched_barrier(0)
    Unit cur, nxt; int ui = 0;
    if (!S.next(0, cur)) return;
    f32x4 acc[2][2][4][2];
#pragma unroll
    for (int a = 0; a < 2; ++a)
#pragma unroll
        for (int b = 0; b < 2; ++b)
#pragma unroll
            for (int m = 0; m < 4; ++m)
#pragma unroll
                for (int n = 0; n < 2; ++n) acc[a][b][m][n] = (f32x4){0.f, 0.f, 0.f, 0.f};
    bf16x8 At[4][2], B0[2][2], B1[2][2];
    const char* cA = (const char*)g.A + (size_t)cur.pm * tstep; const char* cB = (const char*)g.Bt + (size_t)cur.pn * tstep;
    S.a_ready(cur);
    if constexpr (SP2) {
        PG8_STAGE(PG8_SB(0, 0), cB, voffB); PG8_STAGE(PG8_SB(0, 1), cB + hstep, voffB); PG8_STAGE(PG8_SA(0, 0), cA, voffA); PG8_STAGE(PG8_SA(0, 1), cA + hstep, voffA);
        if (wr == 1) PG8_BAR;
        PG8_WAIT_V(2); PG8_BAR;
        PG8_STAGE(PG8_SB(1, 0), cB + kstep, voffB); PG8_STAGE(PG8_SA(1, 0), cA + kstep, voffA); PG8_STAGE(PG8_SB(1, 1), cB + hstep + kstep, voffB);
        PG8_WAIT_V(6); PG8_BAR;
    } else {
        PG8_STAGE(PG8_SB(0, 0), cB, voffB); PG8_STAGE(PG8_SA(0, 0), cA, voffA); PG8_STAGE(PG8_SB(0, 1), cB + hstep, voffB); PG8_STAGE(PG8_SA(0, 1), cA + hstep, voffA);
        if (wr == 1) PG8_BAR;
        PG8_WAIT_V(4); PG8_BAR;
        PG8_STAGE(PG8_SB(1, 0), cB + kstep, voffB); PG8_STAGE(PG8_SA(1, 0), cA + kstep, voffA); PG8_STAGE(PG8_SB(1, 1), cB + hstep + kstep, voffB);
        PG8_WAIT_V(6); PG8_BAR;
    }
    for (;;) {
        const bool has_next = S.next(ui + 1, nxt);
        const char* nA = has_next ? (const char*)g.A + (size_t)nxt.pm * tstep : cA; const char* nB = has_next ? (const char*)g.Bt + (size_t)nxt.pn * tstep : cB;
        for (int t = 0; t < nt; t += 2) {
            const bool last = (t == nt - 2);
            const char* a1 = cA + (size_t)(t + 1) * kstep;
            const char* a2 = last ? nA : cA + (size_t)(t + 2) * kstep; const char* b2 = last ? nB : cB + (size_t)(t + 2) * kstep;
            const char* a3 = a2 + kstep; const char* b3 = b2 + kstep;
            if (last && has_next) S.a_ready(nxt);
            if constexpr (SP2) {
            PG8_LDB(B0, 0, 0); PG8_LDB(B1, 0, 1); PG8_SCHED; PG8_LDA(At, 0, 0); PG8_STAGE(PG8_SA(1, 1), a1 + hstep, voffA);
            PG8_WAIT_V(8); PG8_WAIT_L(0); PG8_BAR; PG8_MMA(0, 0, At, B0); PG8_MMA(0, 1, At, B1); PG8_BAR; PG8_SCHED;
            PG8_LDA(At, 0, 1); PG8_STAGE(PG8_SB(0, 0), b2, voffB); PG8_STAGE(PG8_SB(0, 1), b2 + hstep, voffB); PG8_STAGE(PG8_SA(0, 0), a2, voffA);
            PG8_WAIT_V(8); PG8_WAIT_L(0); PG8_BAR; PG8_MMA(1, 0, At, B0); PG8_MMA(1, 1, At, B1); PG8_BAR; PG8_SCHED;
            PG8_LDB(B0, 1, 0); PG8_LDB(B1, 1, 1); PG8_SCHED; PG8_LDA(At, 1, 0); PG8_STAGE(PG8_SA(0, 1), a2 + hstep, voffA);
            PG8_WAIT_V(8); PG8_WAIT_L(0); PG8_BAR; PG8_MMA(0, 0, At, B0); PG8_MMA(0, 1, At, B1); PG8_BAR; PG8_SCHED;
            PG8_LDA(At, 1, 1); PG8_STAGE(PG8_SB(1, 0), b3, voffB); PG8_STAGE(PG8_SB(1, 1), b3 + hstep, voffB); PG8_STAGE(PG8_SA(1, 0), a3, voffA);
            PG8_WAIT_V(8); PG8_WAIT_L(0); PG8_BAR; PG8_MMA(1, 0, At, B0); PG8_MMA(1, 1, At, B1); PG8_BAR; PG8_SCHED;
            } else {
            PG8_LDB(B0, 0, 0); PG8_SCHED; PG8_LDA(At, 0, 0); PG8_STAGE(PG8_SA(1, 1), a1 + hstep, voffA);
            PG8_WAIT_L(8); PG8_BAR; PG8_WAIT_L(0); PG8_MMA(0, 0, At, B0); PG8_BAR; PG8_SCHED;
            PG8_LDB(B1, 0, 1); PG8_STAGE(PG8_SB(0, 0), b2, voffB);
            PG8_BAR; PG8_WAIT_L(0); PG8_MMA(0, 1, At, B1); PG8_BAR;
            PG8_LDA(At, 0, 1); PG8_STAGE(PG8_SA(0, 0), a2, voffA);
            PG8_BAR; PG8_WAIT_L(0); PG8_MMA(1, 0, At, B0); PG8_BAR; PG8_SCHED;
            PG8_STAGE(PG8_SB(0, 1), b2 + hstep, voffB);
            PG8_WAIT_V(6); PG8_BAR; PG8_MMA(1, 1, At, B1); PG8_BAR;
            PG8_LDB(B0, 1, 0); PG8_SCHED; PG8_LDA(At, 1, 0); PG8_STAGE(PG8_SA(0, 1), a2 + hstep, voffA);
            PG8_WAIT_L(8); PG8_BAR; PG8_WAIT_L(0); PG8_MMA(0, 0, At, B0); PG8_BAR; PG8_SCHED;
            PG8_LDB(B1, 1, 1); PG8_STAGE(PG8_SB(1, 0), b3, voffB);
            PG8_BAR; PG8_WAIT_L(0); PG8_MMA(0, 1, At, B1); PG8_BAR;
            PG8_LDA(At, 1, 1); PG8_STAGE(PG8_SA(1, 0), a3, voffA);
            PG8_BAR; PG8_WAIT_L(0); PG8_MMA(1, 0, At, B0); PG8_BAR; PG8_SCHED;
            PG8_STAGE(PG8_SB(1, 1), b3 + hstep, voffB);
            PG8_WAIT_V(6); PG8_BAR; PG8_MMA(1, 1, At, B1); PG8_BAR;
            }
        }
        if constexpr (ALIGN_EPI) { if (wr == 0) PG8_BAR; }
        if constexpr (!Epi::AFTER_DRAIN) { E(acc, cur, wr, wc, fr, fq); S.done(cur); }
        if (!has_next) break;
#pragma unroll
        for (int a = 0; a < 2; ++a)
#pragma unroll
            for (int b = 0; b < 2; ++b)
#pragma unroll
                for (int m = 0; m < 4; ++m)
#pragma unroll
                    for (int n = 0; n < 2; ++n) acc[a][b][m][n] = (f32x4){0.f, 0.f, 0.f, 0.f};
        cur = nxt; cA = nA; cB = nB; ++ui;
        if constexpr (ALIGN_EPI) { if (wr == 1) PG8_BAR; }
    }
    PG8_WAIT_V(0);
    if constexpr (!ALIGN_EPI) { if (wr == 0) PG8_BAR; }
    PG8_BAR;
    if constexpr (Epi::AFTER_DRAIN) { E.fused(acc, cur, wr, wc, fr, fq, lds, wid, lane); S.done(cur); }
#undef PG8_SA
#undef PG8_SB
#undef PG8_STAGE
#undef PG8_LDA
#undef PG8_LDB
#undef PG8_MMA
#undef PG8_WAIT_V
#undef PG8_WAIT_L
#undef PG8_BAR
#undef PG8_SCHED
}
}

#define LAS __attribute__((address_space(3)))
typedef unsigned short bf16_t;
typedef short bf16x8 __attribute__((ext_vector_type(8)));
typedef short s16x4 __attribute__((ext_vector_type(4)));
typedef float f32x4 __attribute__((ext_vector_type(4)));
typedef unsigned u32x4 __attribute__((ext_vector_type(4)));
typedef unsigned u32x2 __attribute__((ext_vector_type(2)));

__device__ __forceinline__ float wave_sum(float v) {
#pragma unroll
    for (int o = 1; o < 64; o <<= 1) v += __shfl_xor(v, o);
    return v;
}
__device__ __forceinline__ unsigned pk2(float lo, float hi) { return pg8::cvt_pk_bf16(lo, hi); }
__device__ __forceinline__ float bflo(unsigned w) { return __uint_as_float(w << 16); }
__device__ __forceinline__ float bfhi(unsigned w) { return __uint_as_float(w & 0xffff0000u); }

constexpr size_t MiB = 1u << 20;
constexpr size_t WS_SSQ1 = 64 * 1024, WS_SSQ2 = 128 * 1024, WS_SSQ3 = 192 * 1024, WS_RSTDX = 256 * 1024;
constexpr size_t WS_LSE = 1 * MiB;
constexpr size_t WS_BT1 = 2 * MiB;
constexpr size_t WS_BT2 = 22 * MiB;
constexpr size_t WS_BT3 = 30 * MiB;
constexpr size_t WS_BT4 = 74 * MiB;
constexpr size_t WS_BT5 = 96 * MiB;
constexpr size_t WS_BT6 = 104 * MiB;
constexpr size_t WS_PB = 105 * MiB;
constexpr size_t WS_XB = 114 * MiB;
constexpr size_t WS_YMIX = 178 * MiB;
constexpr size_t WS_PROJ = 242 * MiB;
constexpr size_t WS_END = 418 * MiB;

constexpr int RING_BYTES = 131072;
constexpr int LUT_OFF = RING_BYTES;
constexpr int LDS_BYTES = 147456;

constexpr int MISC_OFF = RING_BYTES + 1024;
constexpr size_t WS_BAR = 0;

#define XB_TMO      128
#define XB_XCNT(j)  (256  + 64 * (j))
#define XB_XSUB(j)  (1280 + 64 * (j))
#define XB_XGEN(j)  (2304 + 64 * (j))
#define XB_TOP      3328
#define XB_TOPGEN   3392
#define XCD_BAR_WORDS 3456
#define XB_SPIN_CAP (1u << 18)

__device__ __forceinline__ unsigned xb_ld(unsigned* p)              { return __hip_atomic_load(p, __ATOMIC_RELAXED, __HIP_MEMORY_SCOPE_AGENT); }
__device__ __forceinline__ unsigned xb_add(unsigned* p, unsigned v) { return __hip_atomic_fetch_add(p, v, __ATOMIC_RELAXED, __HIP_MEMORY_SCOPE_AGENT); }
__device__ __forceinline__ unsigned xb_xcc_id() { return (unsigned)__builtin_amdgcn_s_getreg((3 << 11) | 20) & 0xFu; }
#define XB_SPIN(cond, bar) do { unsigned _sp = 0; while (cond) { __builtin_amdgcn_s_sleep(1); \
    if ((++_sp & 255u) == 0u) { if (xb_ld(&(bar)[XB_TMO])) break; if (_sp > XB_SPIN_CAP) { atomicAdd(&(bar)[XB_TMO], 1u); break; } } } } while (0)

struct XcdBarrier {
    unsigned* bar; unsigned x;
    volatile LAS unsigned* st;
};

__device__ __forceinline__ XcdBarrier xcd_barrier_post(unsigned* bar, volatile LAS unsigned* st) {
    XcdBarrier b; b.bar = bar; b.x = xb_xcc_id(); b.st = st;
    if (threadIdx.x == 0) (void)xb_add(&bar[XB_XCNT(b.x)], 1u);
    return b;
}
__device__ __forceinline__ void xcd_barrier_complete(unsigned* bar, unsigned x, unsigned& nloc, unsigned& nx) {
    const unsigned G = gridDim.x * gridDim.y * gridDim.z;
    unsigned sum, cnt, mine, sp = 0u;
    for (;;) {
        sum = 0u; cnt = 0u; mine = 0u;
#pragma unroll
        for (unsigned j = 0; j < 16; ++j) { const unsigned c = xb_ld(&bar[XB_XCNT(j)]); sum += c; cnt += (c > 0u) ? 1u : 0u; mine = (j == x) ? c : mine; }
        if (sum == G) break;
        __builtin_amdgcn_s_sleep(1);
        if ((++sp & 255u) == 0u) { if (xb_ld(&bar[XB_TMO])) break; if (sp > XB_SPIN_CAP) { atomicAdd(&bar[XB_TMO], 1u); break; } }
    }
    nloc = mine > 0u ? mine : 1u; nx = cnt > 0u ? cnt : 1u;
}

__device__ __forceinline__ void xcd_barrier(const XcdBarrier& b) {
    asm volatile("s_waitcnt vmcnt(0)" ::: "memory");
    __syncthreads();
    if (threadIdx.x == 0) {
        unsigned* bar = b.bar;
        __builtin_amdgcn_s_waitcnt(0);
        unsigned nloc = b.st[0], nx = b.st[1];
        if (nloc == 0u) { xcd_barrier_complete(bar, b.x, nloc, nx); b.st[0] = nloc; b.st[1] = nx; }
        const unsigned old = xb_add(&bar[XB_XSUB(b.x)], 1u);
        const unsigned gen = old / nloc;
        if (old + 1u == (gen + 1u) * nloc) {
            __builtin_amdgcn_fence(__ATOMIC_RELEASE, "agent");
            asm volatile("s_waitcnt vmcnt(0)" ::: "memory");
            const unsigned og = xb_add(&bar[XB_TOP], 1u);
            const unsigned tg = og / nx;
            if (og + 1u == (tg + 1u) * nx) xb_add(&bar[XB_TOPGEN], 1u);
            else XB_SPIN(xb_ld(&bar[XB_TOPGEN]) == tg, bar);
            __builtin_amdgcn_fence(__ATOMIC_ACQUIRE, "agent");
            xb_add(&bar[XB_XGEN(b.x)], 1u);
            asm volatile("s_waitcnt vmcnt(0)" ::: "memory");
        } else {
            XB_SPIN(xb_ld(&bar[XB_XGEN(b.x)]) == gen, bar);
            __builtin_amdgcn_fence(__ATOMIC_ACQUIRE, "agent");
            asm volatile("s_waitcnt vmcnt(0)" ::: "memory");
        }
    }
    __syncthreads();
}

__device__ __forceinline__ void transpose_item(const float* W, int N, const float* gain, bf16_t* WT, int ldk, int drow0, int k0, int n0, int lane) {
    const int nq = lane & 15, kg = lane >> 4;
    const float* src = W + (size_t)(k0 + 8 * kg) * N + n0 + 4 * nq;
    f32x4 v[2][8];
#pragma unroll
    for (int h = 0; h < 2; ++h)
#pragma unroll
        for (int j = 0; j < 8; ++j) v[h][j] = *(const f32x4*)(src + (size_t)(32 * h + j) * N);
    if (gain) {
#pragma unroll
        for (int h = 0; h < 2; ++h) { const f32x4 g0 = *(const f32x4*)(gain + k0 + 32 * h + 8 * kg), g1 = *(const f32x4*)(gain + k0 + 32 * h + 8 * kg + 4);
#pragma unroll
            for (int j = 0; j < 4; ++j) { v[h][j] *= g0[j]; v[h][4 + j] *= g1[j]; } }
    }
#pragma unroll
    for (int h = 0; h < 2; ++h)
#pragma unroll
        for (int i = 0; i < 4; ++i) { u32x4 o; o.x = pk2(v[h][0][i], v[h][1][i]); o.y = pk2(v[h][2][i], v[h][3][i]); o.z = pk2(v[h][4][i], v[h][5][i]); o.w = pk2(v[h][6][i], v[h][7][i]);
            *(u32x4*)(WT + (size_t)(drow0 + 4 * nq + i) * ldk + k0 + 32 * h + 8 * kg) = o; }
}

struct Ptrs {
    const float *x, *p, *rel_bias, *g_mix, *w_in, *pool_w, *pool_scale, *w_out, *g_ffn, *w_gate, *w_up, *w_down, *g_ple, *w_pg, *w_pp, *g_final;
    float* out; unsigned char* ws;
};

__device__ __forceinline__ void prologue(const Ptrs& P, LAS unsigned char* lds, int gw, int NGW, int wid, int lane) {
    unsigned char* ws = P.ws;
    bf16_t* BT1 = (bf16_t*)(ws + WS_BT1); bf16_t* BT2 = (bf16_t*)(ws + WS_BT2); bf16_t* BT3 = (bf16_t*)(ws + WS_BT3);
    bf16_t* BT4 = (bf16_t*)(ws + WS_BT4); bf16_t* BT5 = (bf16_t*)(ws + WS_BT5); bf16_t* BT6 = (bf16_t*)(ws + WS_BT6);
    constexpr int I_IN = (DM / 64) * (NIN / 64);
    constexpr int I_OUT = ((DM - 512) / 64) * (DM / 64);
    constexpr int I_G = (DM / 64) * (DFF / 64);
    constexpr int I_DN = (DFF / 64) * (DM / 64);
    constexpr int I_PG = (DM / 64) * (DM / 64);
    constexpr int I_PP = (DPLE / 64) * (DM / 64);
    constexpr int NITEMS = I_IN + I_OUT + 2 * I_G + I_DN + I_PG + I_PP;
    for (int it = gw; it < NITEMS; it += NGW) {
        int r = it;
        if (r < I_IN) { const int nb = NIN / 64, kb = r / nb, n0 = 64 * (r % nb); transpose_item(P.w_in, NIN, P.g_mix, BT1, DM, n0, 64 * kb, n0, lane); continue; } r -= I_IN;
        if (r < I_OUT) { const int nb = DM / 64, kb = r / nb, n0 = 64 * (r % nb); transpose_item(P.w_out, DM, nullptr, BT2, DM, n0, 512 + 64 * kb, n0, lane); continue; } r -= I_OUT;
        if (r < I_G) { const int nb = DFF / 64, kb = r / nb, n0 = 64 * (r % nb); transpose_item(P.w_gate, DFF, P.g_ffn, BT3, DM, (n0 >> 7) * 256 + (n0 & 127), 64 * kb, n0, lane); continue; } r -= I_G;
        if (r < I_G) { const int nb = DFF / 64, kb = r / nb, n0 = 64 * (r % nb); transpose_item(P.w_up, DFF, P.g_ffn, BT3, DM, (n0 >> 7) * 256 + 128 + (n0 & 127), 64 * kb, n0, lane); continue; } r -= I_G;
        if (r < I_DN) { const int nb = DM / 64, kb = r / nb, n0 = 64 * (r % nb); transpose_item(P.w_down, DM, nullptr, BT4, DFF, n0, 64 * kb, n0, lane); continue; } r -= I_DN;
        if (r < I_PG) { const int nb = DM / 64, kb = r / nb, n0 = 64 * (r % nb); transpose_item(P.w_pg, DM, P.g_ple, BT5, DM, n0, 64 * kb, n0, lane); continue; } r -= I_PG;
        { const int nb = DM / 64, kb = r / nb, n0 = 64 * (r % nb); transpose_item(P.w_pp, DM, nullptr, BT6, DPLE, n0, 64 * kb, n0, lane); }
    }
    for (int it = gw; it < 1024; it += NGW) {
        const int kq = it >> 3, nc = it & 7, k4 = kq * 4, g = k4 >> 7, n = nc * 256 + lane * 4;
        f32x4 acc[4] = {{0.f, 0.f, 0.f, 0.f}, {0.f, 0.f, 0.f, 0.f}, {0.f, 0.f, 0.f, 0.f}, {0.f, 0.f, 0.f, 0.f}};
        const float* pw = P.pool_w + (size_t)k4 * 128;
        const float* ps = P.pool_scale + g * 128;
        const float* wo = P.w_out + (size_t)(g * 128) * DM + n;
#pragma unroll 4
        for (int d = 0; d < 128; ++d) {
            const f32x4 wv = *(const f32x4*)(wo + (size_t)d * DM); const float sc = ps[d];
#pragma unroll
            for (int cc = 0; cc < 4; ++cc) acc[cc] += (pw[cc * 128 + d] * sc) * wv;
        }
#pragma unroll
        for (int j = 0; j < 4; ++j) { u32x2 o; o.x = pk2(acc[0][j], acc[1][j]); o.y = pk2(acc[2][j], acc[3][j]); *(u32x2*)(BT2 + (size_t)(n + j) * DM + k4) = o; }
    }
    bf16_t* XB = (bf16_t*)(ws + WS_XB); float* rstdx = (float*)(ws + WS_RSTDX);
    for (int row = gw; row < MROWS; row += NGW) {
        const float* xr = P.x + (size_t)row * DM + lane * 8; f32x4 v[4][2]; float s = 0.f;
#pragma unroll
        for (int j = 0; j < 4; ++j) { v[j][0] = *(const f32x4*)(xr + 512 * j); v[j][1] = *(const f32x4*)(xr + 512 * j + 4); s += pg8::dot4(v[j][0]) + pg8::dot4(v[j][1]); }
        s = wave_sum(s);
        if (lane == 0) rstdx[row] = 1.0f / sqrtf(s * (1.0f / DM) + RMS_EPS);
        bf16_t* o = XB + (size_t)row * DM + lane * 8;
#pragma unroll
        for (int j = 0; j < 4; ++j) *(u32x4*)(o + 512 * j) = pg8::pack8(v[j][0], v[j][1]);
    }
    bf16_t* PB = (bf16_t*)(ws + WS_PB);
    for (int c = gw * 64 + lane; c < MROWS * DPLE / 8; c += NGW * 64) {
        const f32x4 a = *(const f32x4*)(P.p + (size_t)c * 8), b = *(const f32x4*)(P.p + (size_t)c * 8 + 4);
        *(u32x4*)(PB + (size_t)c * 8) = pg8::pack8(a, b);
    }
    float* z = (float*)(ws + WS_SSQ1);
    for (int c = gw * 64 + lane; c < 3 * MROWS; c += NGW * 64) z[c] = 0.f;
}

__device__ __forceinline__ void ld8(const bf16_t* p, float (&f)[8]) { const u32x4 w = *(const u32x4*)p; f[0] = bflo(w.x); f[1] = bfhi(w.x); f[2] = bflo(w.y); f[3] = bfhi(w.y); f[4] = bflo(w.z); f[5] = bfhi(w.z); f[6] = bflo(w.w); f[7] = bfhi(w.w); }
__device__ __forceinline__ void pool_item(const bf16_t* proj, bf16_t* ymix, int item, int lane) {
    const int gi = item & 3, tg = item >> 2, w = 2 << gi, rq = lane >> 4, oct = lane & 15;
    const int t0 = tg * 16 + rq * 4, pos0 = t0 & (SEQ - 1), col = gi * 128 + oct * 8;
    const bf16_t* u = proj + (size_t)t0 * NIN + col;
    float acc[8] = {0.f, 0.f, 0.f, 0.f, 0.f, 0.f, 0.f, 0.f}, f[8];
#pragma unroll
    for (int k = 1; k < 16; ++k) if (k < w && pos0 - k >= 0) { ld8(u - (size_t)k * NIN, f);
#pragma unroll
        for (int e = 0; e < 8; ++e) acc[e] += f[e]; }
#pragma unroll
    for (int i = 0; i < 4; ++i) {
        float cur[8]; ld8(u + (size_t)i * NIN, cur);
#pragma unroll
        for (int e = 0; e < 8; ++e) acc[e] += cur[e];
        if (i > 0 && pos0 + i - w >= 0) { ld8(u + (size_t)(i - w) * NIN, f);
#pragma unroll
            for (int e = 0; e < 8; ++e) acc[e] -= f[e]; }
        const int cnt = (pos0 + i + 1 < w) ? (pos0 + i + 1) : w; const float ic = 1.0f / (float)cnt;
        u32x4 o; o.x = pk2(acc[0] * ic - cur[0], acc[1] * ic - cur[1]); o.y = pk2(acc[2] * ic - cur[2], acc[3] * ic - cur[3]);
        o.z = pk2(acc[4] * ic - cur[4], acc[5] * ic - cur[5]); o.w = pk2(acc[6] * ic - cur[6], acc[7] * ic - cur[7]);
        *(u32x4*)(ymix + (size_t)(t0 + i) * DM + col) = o;
    }
}

__device__ const unsigned char T5_BUCKET[3][129] = {
{0,1,2,3,4,5,6,7,8,9,10,11,12,13,14,15,16,16,16,16,16,16,17,17,17,17,17,17,17,17,18,18,18,18,18,18,18,18,18,18,19,19,19,19,19,19,19,19,19,19,19,19,19,19,20,20,20,20,20,20,20,20,20,20,20,20,20,20,20,20,20,20,20,21,21,21,21,21,21,21,21,21,21,21,21,21,21,21,21,21,21,21,21,21,21,21,21,21,21,22,22,22,22,22,22,22,22,22,22,22,22,22,22,22,22,22,22,22,22,22,22,22,22,22,22,22,22,22,22},
{0,4,8,12,16,16,17,17,18,18,19,19,19,19,20,20,20,20,20,21,21,21,21,21,21,22,22,22,22,22,22,22,22,22,23,23,23,23,23,23,23,23,23,23,23,23,24,24,24,24,24,24,24,24,24,24,24,24,24,24,24,24,25,25,25,25,25,25,25,25,25,25,25,25,25,25,25,25,25,25,25,25,25,26,26,26,26,26,26,26,26,26,26,26,26,26,26,26,26,26,26,26,26,26,26,26,26,26,26,26,26,26,26,27,27,27,27,27,27,27,27,27,27,27,27,27,27,27,27},
{0,16,18,19,20,21,21,22,22,23,23,23,24,24,24,24,25,25,25,25,25,26,26,26,26,26,26,26,26,27,27,27,27,27,27,27,27,27,27,28,28,28,28,28,28,28,28,28,28,28,28,28,29,29,29,29,29,29,29,29,29,29,29,29,29,29,29,29,29,29,30,30,30,30,30,30,30,30,30,30,30,30,30,30,30,30,30,30,30,30,30,30,30,30,30,31,31,31,31,31,31,31,31,31,31,31,31,31,31,31,31,31,31,31,31,31,31,31,31,31,31,31,31,31,31,31,31,31,31}};

__device__ __forceinline__ s16x4 vtr(LAS const unsigned char* p) { typedef short v4i16_t __attribute__((ext_vector_type(4))); return __builtin_bit_cast(s16x4, __builtin_amdgcn_ds_read_tr16_b64_v4i16((LAS v4i16_t*)p)); }

__device__ __forceinline__ void attn_item(LAS unsigned char* lds, const bf16_t* proj, bf16_t* ymix, float* lse, const float* rel_bias, int item) {
    const int tid = threadIdx.x, lane = tid & 63, wid = __builtin_amdgcn_readfirstlane(tid >> 6), fr = lane & 15, fq = lane >> 4;
    const int g = item >> 9, idx = item & 511, dsh = 2 * g, d = 1 << dsh, nbsh = 6 - dsh;
    const int seq = idx >> nbsh, n = idx & ((1 << nbsh) - 1), r = seq & (d - 1), bh = seq >> dsh, hl = bh & 3, b = bh >> 2, head = g * 4 + hl;
    const size_t rowbase = (size_t)b * SEQ;
    const bf16_t* kbase = proj + 2048 + head * HD; const bf16_t* vbase = proj + 3584 + head * HD;
#pragma unroll
    for (int j = 0; j < 8; ++j) {
        const int piece = wid * 8 + j, key = piece * 4 + (lane >> 4), cp = lane & 15;
        int l = 128 * (n - 1) + key; if (l < 0) l += 128;
        const size_t grow = rowbase + ((size_t)l << dsh) + r;
        const int kc = cp ^ (key & 15), vc = (((cp >> 1) ^ (key & 7)) << 1) | (cp & 1);
        __builtin_amdgcn_global_load_lds((const unsigned*)(kbase + grow * NIN + kc * 8), (LAS unsigned*)(lds + piece * 1024), 16, 0, 0);
        __builtin_amdgcn_global_load_lds((const unsigned*)(vbase + grow * NIN + vc * 8), (LAS unsigned*)(lds + 65536 + piece * 1024), 16, 0, 0);
    }
    if (tid < 129) ((LAS float*)(lds + LUT_OFF))[tid] = rel_bias[(int)T5_BUCKET[g][tid] * NHEADS + head] * LOG2E;
    const int q0 = wid * 16;
    const size_t qrow = rowbase + ((size_t)(128 * n + q0 + fr) << dsh) + r;
    bf16x8 qf[4];
#pragma unroll
    for (int s = 0; s < 4; ++s) qf[s] = *(const bf16x8*)(proj + qrow * NIN + 512 + head * HD + 32 * s + 8 * fq);
    asm volatile("s_waitcnt vmcnt(0) lgkmcnt(0)" ::: "memory");
    __syncthreads();
    f32x4 sc[9];
#pragma unroll
    for (int jt = 0; jt < 9; ++jt) {
        f32x4 a = {0.f, 0.f, 0.f, 0.f};
        LAS const unsigned char* kp = lds + (q0 + 16 * jt + fr) * 256;
#pragma unroll
        for (int s = 0; s < 4; ++s) { const bf16x8 kf = *(LAS const bf16x8*)(kp + (((4 * s + fq) ^ fr) << 4)); a = __builtin_amdgcn_mfma_f32_16x16x32_bf16(kf, qf[s], a, 0, 0, 0); }
        sc[jt] = a;
    }
    LAS const float* lut = (LAS const float*)(lds + LUT_OFF);
    float mx = -3.0e38f;
#pragma unroll
    for (int jt = 0; jt < 9; ++jt)
#pragma unroll
        for (int e = 0; e < 4; ++e) {
            const int off = 128 + fr - 16 * jt - 4 * fq - e, ki = q0 + 16 * jt + 4 * fq + e;
            const bool ok = (off >= 0) && (off <= 128) && (n > 0 || ki >= 128);
            const int oc = off < 0 ? 0 : (off > 128 ? 128 : off);
            const float v = ok ? sc[jt][e] + lut[oc] : -1.0e30f;
            sc[jt][e] = v; mx = fmaxf(mx, v);
        }
    mx = fmaxf(mx, __shfl_xor(mx, 16)); mx = fmaxf(mx, __shfl_xor(mx, 32));
    float den = 0.f;
#pragma unroll
    for (int jt = 0; jt < 9; ++jt)
#pragma unroll
        for (int e = 0; e < 4; ++e) { const float pv = __builtin_amdgcn_exp2f(sc[jt][e] - mx); sc[jt][e] = pv; den += pv; }
    den += __shfl_xor(den, 16); den += __shfl_xor(den, 32);
    bf16x8 pb[5];
#pragma unroll
    for (int ks = 0; ks < 5; ++ks) {
        u32x4 w; w.x = pk2(sc[2 * ks][0], sc[2 * ks][1]); w.y = pk2(sc[2 * ks][2], sc[2 * ks][3]);
        if (ks < 4) { w.z = pk2(sc[2 * ks + 1][0], sc[2 * ks + 1][1]); w.w = pk2(sc[2 * ks + 1][2], sc[2 * ks + 1][3]); } else { w.z = 0u; w.w = 0u; }
        pb[ks] = __builtin_bit_cast(bf16x8, w);
    }
    f32x4 o[8];
#pragma unroll
    for (int db = 0; db < 8; ++db) o[db] = (f32x4){0.f, 0.f, 0.f, 0.f};
#pragma unroll
    for (int ks = 0; ks < 5; ++ks) {
        const int rowA = q0 + 32 * ks + 4 * fq + (fr >> 2), rowB = (ks < 4) ? rowA + 16 : rowA;
        LAS const unsigned char* va = lds + 65536 + rowA * 256 + 8 * (fr & 3);
        LAS const unsigned char* vb = lds + 65536 + rowB * 256 + 8 * (fr & 3);
#pragma unroll
        for (int db = 0; db < 8; ++db) {
            const s16x4 lo = vtr(va + ((db ^ (rowA & 7)) << 5)), hi = vtr(vb + ((db ^ (rowB & 7)) << 5));
            const bf16x8 vf = {lo[0], lo[1], lo[2], lo[3], hi[0], hi[1], hi[2], hi[3]};
            o[db] = __builtin_amdgcn_mfma_f32_16x16x32_bf16(vf, pb[ks], o[db], 0, 0, 0);
        }
    }
    const float inv = 1.0f / den;
    bf16_t* orow = ymix + qrow * DM + 512 + head * HD + 4 * fq;
#pragma unroll
    for (int db = 0; db < 8; ++db) { u32x2 w; w.x = pk2(o[db][0] * inv, o[db][1] * inv); w.y = pk2(o[db][2] * inv, o[db][3] * inv); *(u32x2*)(orow + 16 * db) = w; }
    if (fq == 0) lse[qrow * NHEADS + head] = (mx + __builtin_amdgcn_logf(den)) * LN2;
    asm volatile("s_waitcnt lgkmcnt(0)" ::: "memory");
    __syncthreads();
}

__device__ __forceinline__ void mix_row(bf16_t* ymix, const float* lse, int row, int lane) {
    const int hs = lane >> 4; const float* l = lse + (size_t)row * NHEADS + hs;
    const float l0 = l[0], l1 = l[4], l2 = l[8], m = fmaxf(l0, fmaxf(l1, l2));
    const float e0 = __expf(l0 - m), e1 = __expf(l1 - m), e2 = __expf(l2 - m), inv = 1.0f / (e0 + e1 + e2);
    const float al[3] = {e0 * inv, e1 * inv, e2 * inv};
    bf16_t* y = ymix + (size_t)row * DM + 512 + lane * 8;
#pragma unroll
    for (int j = 0; j < 3; ++j) { const u32x4 w = *(const u32x4*)(y + 512 * j); const float a = al[j]; u32x4 o;
        o.x = pk2(bflo(w.x) * a, bfhi(w.x) * a); o.y = pk2(bflo(w.y) * a, bfhi(w.y) * a); o.z = pk2(bflo(w.z) * a, bfhi(w.z) * a); o.w = pk2(bflo(w.w) * a, bfhi(w.w) * a);
        *(u32x4*)(y + 512 * j) = o; }
}
__device__ __forceinline__ void final_row(float* out, const bf16_t* h3, const float* ssq, const float* gfin, int row, int lane) {
    const float r = 1.0f / sqrtf(ssq[row] * (1.0f / DM) + RMS_EPS);
    float* o = out + (size_t)row * DM + lane * 8; const bf16_t* hh = h3 + (size_t)row * DM + lane * 8;
#pragma unroll
    for (int j = 0; j < 4; ++j) { const u32x4 w = *(const u32x4*)(hh + 512 * j); const f32x4 g0 = *(const f32x4*)(gfin + lane * 8 + 512 * j), g1 = *(const f32x4*)(gfin + lane * 8 + 512 * j + 4);
        const f32x4 v0 = {bflo(w.x), bfhi(w.x), bflo(w.y), bfhi(w.y)}, v1 = {bflo(w.z), bfhi(w.z), bflo(w.w), bfhi(w.w)};
        *(f32x4*)(o + 512 * j) = v0 * r * g0; *(f32x4*)(o + 512 * j + 4) = v1 * r * g1; }
}

struct Args { const float* in[16]; float* out; unsigned char* ws; };

#define PG8_ALIGN true
#define PG8_SP2 true

__global__ void __launch_bounds__(512, 2) hymba_fwd(Args args) {
    extern __shared__ __attribute__((aligned(16))) unsigned char lds_raw[];
    LAS unsigned char* lds = (LAS unsigned char*)lds_raw;
    cg::grid_group grid = cg::this_grid();
    const int tid = threadIdx.x, lane = tid & 63, wid = __builtin_amdgcn_readfirstlane(tid >> 6);
    const int G = gridDim.x, bx = blockIdx.x;
    const int vcu = (G % 8 == 0) ? (bx % 8) * (G / 8) + bx / 8 : bx;
    const int gw = vcu * 8 + wid, NGW = G * 8;
    Ptrs P;
    P.x = args.in[0]; P.p = args.in[1]; P.rel_bias = args.in[2]; P.g_mix = args.in[3]; P.w_in = args.in[4]; P.pool_w = args.in[5]; P.pool_scale = args.in[6]; P.w_out = args.in[7];
    P.g_ffn = args.in[8]; P.w_gate = args.in[9]; P.w_up = args.in[10]; P.w_down = args.in[11]; P.g_ple = args.in[12]; P.w_pg = args.in[13]; P.w_pp = args.in[14]; P.g_final = args.in[15];
    P.out = args.out; P.ws = args.ws;
    unsigned char* ws = args.ws;
    bf16_t* BT1 = (bf16_t*)(ws + WS_BT1); bf16_t* BT2 = (bf16_t*)(ws + WS_BT2); bf16_t* BT3 = (bf16_t*)(ws + WS_BT3);
    bf16_t* BT4 = (bf16_t*)(ws + WS_BT4); bf16_t* BT5 = (bf16_t*)(ws + WS_BT5); bf16_t* BT6 = (bf16_t*)(ws + WS_BT6);
    bf16_t* PB = (bf16_t*)(ws + WS_PB); bf16_t* XB = (bf16_t*)(ws + WS_XB); bf16_t* YMIX = (bf16_t*)(ws + WS_YMIX); bf16_t* PROJ = (bf16_t*)(ws + WS_PROJ);
    float* SSQ1 = (float*)(ws + WS_SSQ1); float* SSQ2 = (float*)(ws + WS_SSQ2); float* SSQ3 = (float*)(ws + WS_SSQ3); float* RSTDX = (float*)(ws + WS_RSTDX); float* LSE = (float*)(ws + WS_LSE);

    volatile LAS unsigned* MISC = (volatile LAS unsigned*)(lds + MISC_OFF);
    if (tid < 2) MISC[tid] = 0u;
    if (bx == 0) for (int u = tid; u < XCD_BAR_WORDS; u += 512) ((unsigned*)(ws + WS_BAR))[u] = 0u;
    prologue(P, lds, gw, NGW, wid, lane);
    grid.sync();
    const XcdBarrier bar = xcd_barrier_post((unsigned*)(ws + WS_BAR), MISC);

    { pg8::Gemm g{XB, BT1, MROWS, NIN, DM}; pg8::StaticOrder S; S.init(MROWS, NIN, G, bx);
      pg8::EpiProj E{PROJ, NIN, RSTDX, 2, 8, QSCALE};
      pg8::gemm_phase<pg8::EpiProj, pg8::StaticOrder, PG8_ALIGN, PG8_SP2>(lds, g, S, E); }
    xcd_barrier(bar);

    { const int per = (1536 + G - 1) / G;
      for (int i = 0; i < per; ++i) { const int item = vcu * per + i; if (item >= 1536) break; attn_item(lds, PROJ, YMIX, LSE, P.rel_bias, item); }
      for (int it = gw; it < 4096; it += NGW) pool_item(PROJ, YMIX, it, lane); }
    xcd_barrier(bar);

    for (int row = gw; row < MROWS; row += NGW) mix_row(YMIX, LSE, row, lane);
    xcd_barrier(bar);

    { pg8::Gemm g{YMIX, BT2, MROWS, DM, DM}; pg8::StaticOrder S; S.init(MROWS, DM, G, bx);
      pg8::EpiRes E{XB, XB, SSQ1, DM};
      pg8::gemm_phase<pg8::EpiRes, pg8::StaticOrder, PG8_ALIGN, PG8_SP2>(lds, g, S, E); }
    xcd_barrier(bar);

    { pg8::Gemm g{XB, BT3, MROWS, 2 * DFF, DM}; pg8::StaticOrder S; S.init(MROWS, 2 * DFF, G, bx);
      pg8::EpiSwiGLU E{PROJ, DFF, SSQ1, 1.0f / DM, RMS_EPS};
      pg8::gemm_phase<pg8::EpiSwiGLU, pg8::StaticOrder, PG8_ALIGN, PG8_SP2>(lds, g, S, E); }
    { int kpp = DPLE; asm volatile("" : "+s"(kpp));
      pg8::Gemm g{PB, BT6, MROWS, DM, kpp}; pg8::StaticOrder S; S.init(MROWS, DM, G, bx);
      pg8::EpiPlain E{YMIX, DM};
      pg8::gemm_phase<pg8::EpiPlain, pg8::StaticOrder, PG8_ALIGN, PG8_SP2>(lds, g, S, E); }
    xcd_barrier(bar);

    { pg8::Gemm g{PROJ, BT4, MROWS, DM, DFF}; pg8::StaticOrder S; S.init(MROWS, DM, G, bx);
      pg8::EpiRes E{XB, XB, SSQ2, DM};
      pg8::gemm_phase<pg8::EpiRes, pg8::StaticOrder, PG8_ALIGN, PG8_SP2>(lds, g, S, E); }
    xcd_barrier(bar);

    { pg8::Gemm g{XB, BT5, MROWS, DM, DM}; pg8::StaticOrder S; S.init(MROWS, DM, G, bx);
      pg8::EpiPle E{XB, YMIX, PROJ, SSQ2, SSQ3, DM, 1.0f / DM, RMS_EPS};
      pg8::gemm_phase<pg8::EpiPle, pg8::StaticOrder, PG8_ALIGN, PG8_SP2>(lds, g, S, E); }
    xcd_barrier(bar);

    for (int row = gw; row < MROWS; row += NGW) final_row(P.out, PROJ, SSQ3, P.g_final, row, lane);
}

extern "C" void kernel_launch(void* const* d_in, const int* in_sizes, int n_in, void* d_out, int out_size, void* d_ws, size_t ws_size, hipStream_t stream) {
    static int grid = 0;
    if (grid == 0) {
        if (n_in != 16 || in_sizes[0] != MROWS * DM || out_size != MROWS * DM || ws_size < WS_END) {
            fprintf(stderr, "kernel_launch: unexpected shapes (n_in %d, in0 %d, out %d, ws %zu); nothing launched\n", n_in, n_in > 0 ? in_sizes[0] : -1, out_size, ws_size); grid = -1; return; }
        int dev = 0, cus = 0, per_cu = 0;
        if (hipGetDevice(&dev) != hipSuccess || hipDeviceGetAttribute(&cus, hipDeviceAttributeMultiprocessorCount, dev) != hipSuccess) { fprintf(stderr, "kernel_launch: device query failed\n"); grid = -1; return; }
        if (hipFuncSetAttribute((const void*)hymba_fwd, hipFuncAttributeMaxDynamicSharedMemorySize, LDS_BYTES) != hipSuccess) { fprintf(stderr, "kernel_launch: hipFuncSetAttribute failed\n"); grid = -1; return; }
        if (hipOccupancyMaxActiveBlocksPerMultiprocessor(&per_cu, (const void*)hymba_fwd, 512, LDS_BYTES) != hipSuccess || per_cu < 1) { fprintf(stderr, "kernel_launch: occupancy query says %d blocks per CU\n", per_cu); (void)hipGetLastError(); per_cu = 1; }
        if (per_cu > 1) per_cu = 1;
        grid = cus * per_cu;
    }
    if (grid < 0) return;
    Args a{};
    for (int i = 0; i < 16; ++i) a.in[i] = (const float*)d_in[i];
    a.out = (float*)d_out; a.ws = (unsigned char*)d_ws;
    void* kargs[] = {&a};
    hipError_t e = hipLaunchCooperativeKernel((const void*)hymba_fwd, dim3(grid), dim3(512), kargs, LDS_BYTES, stream);
    if (e != hipSuccess) fprintf(stderr, "kernel_launch: cooperative launch failed: %s (grid %d)\n", hipGetErrorString(e), grid);
}
```

```cpp
#include <hip/hip_runtime.h>
#include <hip/hip_cooperative_groups.h>
#include <cstdio>
#include <cstdint>
namespace cg = cooperative_groups;

constexpr int BATCH = 2, SEQ = 8192, DM = 2048, MROWS = BATCH * SEQ, NIN = 5120, DFF = 5632, DPLE = 256, NHEADS = 12, HD = 128;
constexpr float RMS_EPS = 1e-6f;
constexpr float QSCALE = 0.08838834764831845f * 1.4426950408889634f;
constexpr float LOG2E = 1.4426950408889634f, LN2 = 0.6931471805599453f;
namespace pg8 {
#define PG8_LAS __attribute__((address_space(3)))
typedef unsigned short bf16_t;
typedef short bf16x8 __attribute__((ext_vector_type(8)));
typedef float f32x4 __attribute__((ext_vector_type(4)));
typedef unsigned u32x4 __attribute__((ext_vector_type(4)));
constexpr int BM = 256, BK = 64, HALF = 128, HTB = HALF * BK * 2  , STAGE_BYTES = 8 * HTB, NXCD = 8, WGM = 8;

__host__ __device__ __forceinline__ int lds_byte(int r, int c) { const int st = (r >> 4) * 2 + (c >> 5), rr = r & 15, cc = c & 31, ob = rr * 64 + cc * 2; return st * 1024 + (ob ^ (((ob >> 9) & 1) << 5)); }
__host__ __device__ __forceinline__ void stage_rc(int b, int& R, int& C) { const int st = b / 1024, sb = b % 1024, swz = sb ^ (((sb >> 9) & 1) << 5); R = (st >> 1) * 16 + swz / 64; C = (st & 1) * 32 + (swz % 64) / 2; }
__host__ __device__ __forceinline__ int perm32(int rho) { const int n = rho >> 4, i = rho & 15; return 8 * (i >> 2) + 4 * n + (i & 3); }

struct Unit { int pm, pn; };
struct Gemm { const bf16_t* A; const bf16_t* Bt; int M, N, K; };

struct StaticOrder {
    int nM, nN, nwg, G, c;
    __host__ __device__ void init(int M, int N, int G_, int c_) { nM = M / BM; nN = N / BM; nwg = nM * nN; G = G_; c = c_; }
    __host__ __device__ bool next(int i, Unit& u) const {
        const long L = (long)i * G + c; if (L >= nwg) return false;
        int wgid = (int)L; { const int q = nwg / NXCD, r = nwg % NXCD, xcd = wgid % NXCD, off = wgid / NXCD; wgid = (xcd < r ? xcd * (q + 1) : r * (q + 1) + (xcd - r) * q) + off; }
        const int nig = WGM * nN, gid = wgid / nig, fm = gid * WGM, gsz = (nM - fm) < WGM ? (nM - fm) : WGM;
        u.pm = fm + ((wgid % nig) % gsz); u.pn = (wgid % nig) / gsz; return true;
    }
    __device__ __forceinline__ void a_ready(const Unit&) const {}
    __device__ __forceinline__ void done(const Unit&) const {}
};

__device__ __forceinline__ unsigned cvt_pk_bf16(float lo, float hi) { unsigned r; asm volatile("v_cvt_pk_bf16_f32 %0, %1, %2" : "=v"(r) : "v"(lo), "v"(hi)); return r; }
__device__ __forceinline__ u32x4 pack8(const f32x4 v0, const f32x4 v1) { u32x4 w; w.x = cvt_pk_bf16(v0[0], v0[1]); w.y = cvt_pk_bf16(v0[2], v0[3]); w.z = cvt_pk_bf16(v1[0], v1[1]); w.w = cvt_pk_bf16(v1[2], v1[3]); return w; }
__device__ __forceinline__ float bf_lo(unsigned w) { return __uint_as_float(w << 16); }
__device__ __forceinline__ float bf_hi(unsigned w) { return __uint_as_float(w & 0xffff0000u); }
__device__ __forceinline__ float dot4(const f32x4 v) { return (v[0] * v[0] + v[1] * v[1]) + (v[2] * v[2] + v[3] * v[3]); }

constexpr int PF_SCRATCH = 131072 + 2048;
__device__ __forceinline__ void prefetch_tile(const bf16_t* base, int ldc, const Unit& u, PG8_LAS unsigned char* lds, int tid, int wid, int slot) {
#pragma unroll
    for (int j = 0; j < 2; ++j) { const int line = tid + 512 * j, row = line >> 2, seg = line & 3;
        __builtin_amdgcn_global_load_lds((const unsigned*)(base + (size_t)(u.pm * BM + row) * ldc + u.pn * BM + seg * 64), (PG8_LAS unsigned*)(lds + PF_SCRATCH + (slot * 16 + wid * 2 + j) * 256), 4, 0, 0); }
}
struct EpiProj {
    static constexpr bool PERM = true, AFTER_DRAIN = false;
    __device__ __forceinline__ void prefetch(const Unit&, PG8_LAS unsigned char*, int, int) const {}
    bf16_t* POOL; bf16_t* QKV; const float* rstd; float qscale; int seq_sh, mrows;
    __device__ __forceinline__ void operator()(const f32x4 (&acc)[2][2][4][2], const Unit& u, int wr, int wc, int fr, int fq) const {
        const int row0 = u.pm * BM + wr * 64 + fr, cin = wc * 32 + 8 * fq;
        if (u.pn < 2) {
#pragma unroll
            for (int ai = 0; ai < 2; ++ai)
#pragma unroll
                for (int m = 0; m < 4; ++m) { const int row = row0 + ai * HALF + m * 16; const float s = rstd[row]; bf16_t* rowp = POOL + (size_t)row * 512 + u.pn * BM + cin;
#pragma unroll
                    for (int bj = 0; bj < 2; ++bj) *(u32x4*)(rowp + bj * HALF) = pack8(acc[ai][bj][m][0] * s, acc[ai][bj][m][1] * s); }
        } else {
            const int tq = (u.pn - 2) / 6, hp = (u.pn - 2) - 6 * tq;
            const float qs = tq == 0 ? qscale : 1.0f;
#pragma unroll
            for (int ai = 0; ai < 2; ++ai)
#pragma unroll
                for (int m = 0; m < 4; ++m) { const int row = row0 + ai * HALF + m * 16; const float s = rstd[row] * qs;
                    const int b = row >> seq_sh, t = row & ((1 << seq_sh) - 1);
#pragma unroll
                    for (int bj = 0; bj < 2; ++bj) { const int head = 2 * hp + bj, dsh = 2 * (head >> 2);
                        const int idx = (b << seq_sh) + ((t & ((1 << dsh) - 1)) << (seq_sh - dsh)) + (t >> dsh);
                        *(u32x4*)(QKV + ((size_t)(tq * 12 + head) * mrows + idx) * 128 + cin) = pack8(acc[ai][bj][m][0] * s, acc[ai][bj][m][1] * s); } }
        }
    }
};
struct EpiPlain {
    static constexpr bool PERM = true, AFTER_DRAIN = false;
    __device__ __forceinline__ void prefetch(const Unit&, PG8_LAS unsigned char*, int, int) const {}
    bf16_t* O; int ldc;
    __device__ __forceinline__ void operator()(const f32x4 (&acc)[2][2][4][2], const Unit& u, int wr, int wc, int fr, int fq) const {
        const int row0 = u.pm * BM + wr * 64 + fr, col0 = u.pn * BM + wc * 32 + 8 * fq;
#pragma unroll
        for (int ai = 0; ai < 2; ++ai)
#pragma unroll
            for (int m = 0; m < 4; ++m) { bf16_t* rowp = O + (size_t)(row0 + ai * HALF + m * 16) * ldc + col0;
#pragma unroll
                for (int bj = 0; bj < 2; ++bj) *(u32x4*)(rowp + bj * HALF) = pack8(acc[ai][bj][m][0], acc[ai][bj][m][1]); }
    }
};
struct EpiRes {
    static constexpr bool PERM = true, AFTER_DRAIN = false;
    const bf16_t* base; bf16_t* ob; float* ssq; int ldc;
    __device__ __forceinline__ void prefetch(const Unit& u, PG8_LAS unsigned char* lds, int tid, int wid) const { prefetch_tile(base, ldc, u, lds, tid, wid, 0); }
    __device__ __forceinline__ void operator()(const f32x4 (&acc)[2][2][4][2], const Unit& u, int wr, int wc, int fr, int fq) const {
        const int row0 = u.pm * BM + wr * 64 + fr, col0 = u.pn * BM + wc * 32 + 8 * fq;
#pragma unroll
        for (int ai = 0; ai < 2; ++ai)
#pragma unroll
            for (int m = 0; m < 4; ++m) { const int row = row0 + ai * HALF + m * 16; const size_t off = (size_t)row * ldc + col0; float s = 0.f;
#pragma unroll
                for (int bj = 0; bj < 2; ++bj) {
                    const u32x4 bw = *(const u32x4*)(base + off + bj * HALF);
                    const f32x4 v0 = (f32x4){bf_lo(bw.x), bf_hi(bw.x), bf_lo(bw.y), bf_hi(bw.y)} + acc[ai][bj][m][0], v1 = (f32x4){bf_lo(bw.z), bf_hi(bw.z), bf_lo(bw.w), bf_hi(bw.w)} + acc[ai][bj][m][1];
                    *(u32x4*)(ob + off + bj * HALF) = pack8(v0, v1);
                    s += dot4(v0) + dot4(v1); }
                s += __shfl_xor(s, 16); s += __shfl_xor(s, 32);
                if (fq == 0) atomicAdd(ssq + row, s); }
    }
};
struct EpiSwiGLU {
    static constexpr bool PERM = true, AFTER_DRAIN = false;
    __device__ __forceinline__ void prefetch(const Unit&, PG8_LAS unsigned char*, int, int) const {}
    bf16_t* O; int ldc; const float* ssq; float inv_d, eps;
    __device__ __forceinline__ void operator()(const f32x4 (&acc)[2][2][4][2], const Unit& u, int wr, int wc, int fr, int fq) const {
        const int row0 = u.pm * BM + wr * 64 + fr, col0 = u.pn * HALF + wc * 32 + 8 * fq;
#pragma unroll
        for (int ai = 0; ai < 2; ++ai)
#pragma unroll
            for (int m = 0; m < 4; ++m) { const int row = row0 + ai * HALF + m * 16; const float r = __builtin_amdgcn_rsqf(ssq[row] * inv_d + eps);
                f32x4 o[2];
#pragma unroll
                for (int n = 0; n < 2; ++n)
#pragma unroll
                    for (int j = 0; j < 4; ++j) { const float g = acc[ai][0][m][n][j] * r, up = acc[ai][1][m][n][j] * r;
                        o[n][j] = g * up * __builtin_amdgcn_rcpf(1.0f + __builtin_amdgcn_exp2f(-1.4426950408889634f * g)); }
                *(u32x4*)(O + (size_t)row * ldc + col0) = pack8(o[0], o[1]); }
    }
};
struct EpiPle {
    static constexpr bool PERM = true, AFTER_DRAIN = false;
    const bf16_t* h; const bf16_t* pp; bf16_t* o; const float* ssq2; float* ssq3; int ldc; float inv_d, eps;
    __device__ __forceinline__ void prefetch(const Unit& u, PG8_LAS unsigned char* lds, int tid, int wid) const { prefetch_tile(h, ldc, u, lds, tid, wid, 0); prefetch_tile(pp, ldc, u, lds, tid, wid, 1); }
    __device__ __forceinline__ void operator()(const f32x4 (&acc)[2][2][4][2], const Unit& u, int wr, int wc, int fr, int fq) const {
        const int row0 = u.pm * BM + wr * 64 + fr, col0 = u.pn * BM + wc * 32 + 8 * fq;
#pragma unroll
        for (int ai = 0; ai < 2; ++ai)
#pragma unroll
            for (int m = 0; m < 4; ++m) { const int row = row0 + ai * HALF + m * 16; const size_t off = (size_t)row * ldc + col0; float s = 0.f;
                const float r = __builtin_amdgcn_rsqf(ssq2[row] * inv_d + eps);
#pragma unroll
                for (int bj = 0; bj < 2; ++bj) {
                    const u32x4 pw = *(const u32x4*)(pp + off + bj * HALF), hw = *(const u32x4*)(h + off + bj * HALF);
                    f32x4 v0 = {bf_lo(hw.x), bf_hi(hw.x), bf_lo(hw.y), bf_hi(hw.y)}, v1 = {bf_lo(hw.z), bf_hi(hw.z), bf_lo(hw.w), bf_hi(hw.w)};
                    const f32x4 p0 = {bf_lo(pw.x), bf_hi(pw.x), bf_lo(pw.y), bf_hi(pw.y)}, p1 = {bf_lo(pw.z), bf_hi(pw.z), bf_lo(pw.w), bf_hi(pw.w)};
#pragma unroll
                    for (int j = 0; j < 4; ++j) {
                        v0[j] += p0[j] * __builtin_amdgcn_rcpf(1.0f + __builtin_amdgcn_exp2f(-1.4426950408889634f * r * acc[ai][bj][m][0][j]));
                        v1[j] += p1[j] * __builtin_amdgcn_rcpf(1.0f + __builtin_amdgcn_exp2f(-1.4426950408889634f * r * acc[ai][bj][m][1][j])); }
                    *(u32x4*)(o + off + bj * HALF) = pack8(v0, v1);
                    s += dot4(v0) + dot4(v1); }
                s += __shfl_xor(s, 16); s += __shfl_xor(s, 32);
                if (fq == 0) atomicAdd(ssq3 + row, s); }
    }
};

template <class Epi, class Sched, bool ALIGN_EPI = false, bool SP2 = false>
__device__ __forceinline__ void gemm_phase(PG8_LAS unsigned char* lds, const Gemm g, const Sched& S, const Epi& E) {
    int tid_ = threadIdx.x; asm volatile("" : "+v"(tid_));
    const int tid = tid_, wid = __builtin_amdgcn_readfirstlane(tid >> 6), lane = tid & 63, wr = wid >> 2, wc = wid & 3, fr = lane & 15, fq = lane >> 4;
    const int K = g.K, nt = K / BK;
    unsigned voffA[2], voffB[2];
#pragma unroll
    for (int i = 0; i < 2; ++i) { int R, C; stage_rc(tid * 16 + i * 8192, R, C); const int Rb = Epi::PERM ? ((R & ~31) + perm32(R & 31)) : R;
        voffA[i] = (unsigned)(R * K + C) * 2u; voffB[i] = (unsigned)(Rb * K + C) * 2u; }
    const size_t kstep = (size_t)(BK * 2);
    const size_t hstep = (size_t)HALF * K * 2;
    const size_t tstep = 2 * hstep;
    const unsigned ldsw = (unsigned)wid * 1024u;
    const int aoff = lds_byte(wr * 64 + fr, fq * 8), boff = lds_byte(wc * 32 + fr, fq * 8);
#define PG8_SA(b, h) (((b) * 2 + (h)) * HTB)
#define PG8_SB(b, h) ((4 + (b) * 2 + (h)) * HTB)
#define PG8_STAGE(bufoff, gbase, voff) do { _Pragma("unroll") for (int _i = 0; _i < 2; ++_i) \
        __builtin_amdgcn_global_load_lds((const unsigned*)((const char*)(gbase) + (voff)[_i]), (PG8_LAS unsigned*)(lds + (bufoff) + ldsw + _i * 8192), 16, 0, 0); } while (0)
#define PG8_LDA(dst, b, h) do { _Pragma("unroll") for (int m = 0; m < 4; ++m) _Pragma("unroll") for (int k = 0; k < 2; ++k) dst[m][k] = *(const PG8_LAS bf16x8*)(lds + PG8_SA(b, h) + aoff + m * 2048 + k * 1024); } while (0)
#define PG8_LDB(dst, b, h) do { _Pragma("unroll") for (int n = 0; n < 2; ++n) _Pragma("unroll") for (int k = 0; k < 2; ++k) dst[n][k] = *(const PG8_LAS bf16x8*)(lds + PG8_SB(b, h) + boff + n * 2048 + k * 1024); } while (0)
#define PG8_MMA(ai, bj, At, Bt) do { __builtin_amdgcn_s_setprio(1); _Pragma("unroll") for (int m = 0; m < 4; ++m) _Pragma("unroll") for (int n = 0; n < 2; ++n) _Pragma("unroll") for (int k = 0; k < 2; ++k) \
        acc[ai][bj][m][n] = __builtin_amdgcn_mfma_f32_16x16x32_bf16(Bt[n][k], At[m][k], acc[ai][bj][m][n], 0, 0, 0); __builtin_amdgcn_s_setprio(0); } while (0)
#define PG8_WAIT_V(n) asm volatile("s_waitcnt vmcnt(" #n ")" ::: "memory")
#define PG8_WAIT_L(n) asm volatile("s_waitcnt lgkmcnt(" #n ")" ::: "memory")
#define PG8_BAR __builtin_amdgcn_s_barrier()
#define PG8_SCHED __builtin_amdgcn_sched_barrier(0)
    Unit cur, nxt; int ui = 0;
    if (!S.next(0, cur)) return;
    f32x4 acc[2][2][4][2];
#pragma unroll
    for (int a = 0; a < 2; ++a)
#pragma unroll
        for (int b = 0; b < 2; ++b)
#pragma unroll
            for (int m = 0; m < 4; ++m)
#pragma unroll
                for (int n = 0; n < 2; ++n) acc[a][b][m][n] = (f32x4){0.f, 0.f, 0.f, 0.f};
    bf16x8 At[4][2], B0[2][2], B1[2][2];
    const char* cA = (const char*)g.A + (size_t)cur.pm * tstep; const char* cB = (const char*)g.Bt + (size_t)cur.pn * tstep;
    S.a_ready(cur);
    if constexpr (SP2) {
        PG8_STAGE(PG8_SB(0, 0), cB, voffB); PG8_STAGE(PG8_SB(0, 1), cB + hstep, voffB); PG8_STAGE(PG8_SA(0, 0), cA, voffA); PG8_STAGE(PG8_SA(0, 1), cA + hstep, voffA);
        if (wr == 1) PG8_BAR;
        PG8_WAIT_V(2); PG8_BAR;
        PG8_STAGE(PG8_SB(1, 0), cB + kstep, voffB); PG8_STAGE(PG8_SA(1, 0), cA + kstep, voffA); PG8_STAGE(PG8_SB(1, 1), cB + hstep + kstep, voffB);
        PG8_WAIT_V(6); PG8_BAR;
    } else {
        PG8_STAGE(PG8_SB(0, 0), cB, voffB); PG8_STAGE(PG8_SA(0, 0), cA, voffA); PG8_STAGE(PG8_SB(0, 1), cB + hstep, voffB); PG8_STAGE(PG8_SA(0, 1), cA + hstep, voffA);
        if (wr == 1) PG8_BAR;
        PG8_WAIT_V(4); PG8_BAR;
        PG8_STAGE(PG8_SB(1, 0), cB + kstep, voffB); PG8_STAGE(PG8_SA(1, 0), cA + kstep, voffA); PG8_STAGE(PG8_SB(1, 1), cB + hstep + kstep, voffB);
        PG8_WAIT_V(6); PG8_BAR;
    }
    for (;;) {
        const bool has_next = S.next(ui + 1, nxt);
        const char* nA = has_next ? (const char*)g.A + (size_t)nxt.pm * tstep : cA; const char* nB = has_next ? (const char*)g.Bt + (size_t)nxt.pn * tstep : cB;
        for (int t = 0; t < nt; t += 2) {
            const bool last = (t == nt - 2);
            const char* a1 = cA + (size_t)(t + 1) * kstep;
            const char* a2 = last ? nA : cA + (size_t)(t + 2) * kstep; const char* b2 = last ? nB : cB + (size_t)(t + 2) * kstep;
            const char* a3 = a2 + kstep; const char* b3 = b2 + kstep;
            if (last && has_next) S.a_ready(nxt);
            if (t == nt - 4) E.prefetch(cur, lds, tid, wid);
            if constexpr (SP2) {
            PG8_LDB(B0, 0, 0); PG8_LDB(B1, 0, 1); PG8_SCHED; PG8_LDA(At, 0, 0); PG8_STAGE(PG8_SA(1, 1), a1 + hstep, voffA);
            PG8_WAIT_V(8); PG8_WAIT_L(0); PG8_BAR; PG8_MMA(0, 0, At, B0); PG8_MMA(0, 1, At, B1); PG8_BAR; PG8_SCHED;
            PG8_LDA(At, 0, 1); PG8_STAGE(PG8_SB(0, 0), b2, voffB); PG8_STAGE(PG8_SB(0, 1), b2 + hstep, voffB); PG8_STAGE(PG8_SA(0, 0), a2, voffA);
            PG8_WAIT_V(8); PG8_WAIT_L(0); PG8_BAR; PG8_MMA(1, 0, At, B0); PG8_MMA(1, 1, At, B1); PG8_BAR; PG8_SCHED;
            PG8_LDB(B0, 1, 0); PG8_LDB(B1, 1, 1); PG8_SCHED; PG8_LDA(At, 1, 0); PG8_STAGE(PG8_SA(0, 1), a2 + hstep, voffA);
            PG8_WAIT_V(8); PG8_WAIT_L(0); PG8_BAR; PG8_MMA(0, 0, At, B0); PG8_MMA(0, 1, At, B1); PG8_BAR; PG8_SCHED;
            PG8_LDA(At, 1, 1); PG8_STAGE(PG8_SB(1, 0), b3, voffB); PG8_STAGE(PG8_SB(1, 1), b3 + hstep, voffB); PG8_STAGE(PG8_SA(1, 0), a3, voffA);
            PG8_WAIT_V(8); PG8_WAIT_L(0); PG8_BAR; PG8_MMA(1, 0, At, B0); PG8_MMA(1, 1, At, B1); PG8_BAR; PG8_SCHED;
            } else {
            PG8_LDB(B0, 0, 0); PG8_SCHED; PG8_LDA(At, 0, 0); PG8_STAGE(PG8_SA(1, 1), a1 + hstep, voffA);
            PG8_WAIT_L(8); PG8_BAR; PG8_WAIT_L(0); PG8_MMA(0, 0, At, B0); PG8_BAR; PG8_SCHED;
            PG8_LDB(B1, 0, 1); PG8_STAGE(PG8_SB(0, 0), b2, voffB);
            PG8_BAR; PG8_WAIT_L(0); PG8_MMA(0, 1, At, B1); PG8_BAR;
            PG8_LDA(At, 0, 1); PG8_STAGE(PG8_SA(0, 0), a2, voffA);
            PG8_BAR; PG8_WAIT_L(0); PG8_MMA(1, 0, At, B0); PG8_BAR; PG8_SCHED;
            PG8_STAGE(PG8_SB(0, 1), b2 + hstep, voffB);
            PG8_WAIT_V(6); PG8_BAR; PG8_MMA(1, 1, At, B1); PG8_BAR;
            PG8_LDB(B0, 1, 0); PG8_SCHED; PG8_LDA(At, 1, 0); PG8_STAGE(PG8_SA(0, 1), a2 + hstep, voffA);
            PG8_WAIT_L(8); PG8_BAR; PG8_WAIT_L(0); PG8_MMA(0, 0, At, B0); PG8_BAR; PG8_SCHED;
            PG8_LDB(B1, 1, 1); PG8_STAGE(PG8_SB(1, 0), b3, voffB);
            PG8_BAR; PG8_WAIT_L(0); PG8_MMA(0, 1, At, B1); PG8_BAR;
            PG8_LDA(At, 1, 1); PG8_STAGE(PG8_SA(1, 0), a3, voffA);
            PG8_BAR; PG8_WAIT_L(0); PG8_MMA(1, 0, At, B0); PG8_BAR; PG8_SCHED;
            PG8_STAGE(PG8_SB(1, 1), b3 + hstep, voffB);
            PG8_WAIT_V(6); PG8_BAR; PG8_MMA(1, 1, At, B1); PG8_BAR;
            }
        }
        if constexpr (ALIGN_EPI) { if (wr == 0) PG8_BAR; }
        if constexpr (!Epi::AFTER_DRAIN) { E(acc, cur, wr, wc, fr, fq); S.done(cur); }
        if (!has_next) break;
#pragma unroll
        for (int a = 0; a < 2; ++a)
#pragma unroll
            for (int b = 0; b < 2; ++b)
#pragma unroll
                for (int m = 0; m < 4; ++m)
#pragma unroll
                    for (int n = 0; n < 2; ++n) acc[a][b][m][n] = (f32x4){0.f, 0.f, 0.f, 0.f};
        cur = nxt; cA = nA; cB = nB; ++ui;
        if constexpr (ALIGN_EPI) { if (wr == 1) PG8_BAR; }
    }
    PG8_WAIT_V(0);
    if constexpr (!ALIGN_EPI) { if (wr == 0) PG8_BAR; }
    PG8_BAR;
    if constexpr (Epi::AFTER_DRAIN) { E.fused(acc, cur, wr, wc, fr, fq, lds, wid, lane); S.done(cur); }
#undef PG8_SA
#undef PG8_SB
#undef PG8_STAGE
#undef PG8_LDA
#undef PG8_LDB
#undef PG8_MMA
#undef PG8_WAIT_V
#undef PG8_WAIT_L
#undef PG8_BAR
#undef PG8_SCHED
}
}

#define LAS __attribute__((address_space(3)))
typedef unsigned short bf16_t;
typedef short bf16x8 __attribute__((ext_vector_type(8)));
typedef short s16x4 __attribute__((ext_vector_type(4)));
typedef float f32x4 __attribute__((ext_vector_type(4)));
typedef unsigned u32x4 __attribute__((ext_vector_type(4)));
typedef unsigned u32x2 __attribute__((ext_vector_type(2)));

__device__ __forceinline__ float wave_sum(float v) {
#pragma unroll
    for (int o = 1; o < 64; o <<= 1) v += __shfl_xor(v, o);
    return v;
}
__device__ __forceinline__ unsigned pk2(float lo, float hi) { return pg8::cvt_pk_bf16(lo, hi); }
__device__ __forceinline__ float bflo(unsigned w) { return __uint_as_float(w << 16); }
__device__ __forceinline__ float bfhi(unsigned w) { return __uint_as_float(w & 0xffff0000u); }

constexpr size_t MiB = 1u << 20;
constexpr size_t WS_SSQ1 = 64 * 1024, WS_SSQ2 = 128 * 1024, WS_SSQ3 = 192 * 1024, WS_RSTDX = 256 * 1024;
constexpr size_t WS_LSE = 1 * MiB;
constexpr size_t WS_BT1 = 2 * MiB;
constexpr size_t WS_BT2 = 22 * MiB;
constexpr size_t WS_BT3 = 30 * MiB;
constexpr size_t WS_BT4 = 74 * MiB;
constexpr size_t WS_BT5 = 96 * MiB;
constexpr size_t WS_BT6 = 104 * MiB;
constexpr size_t WS_PB = 105 * MiB;
constexpr size_t WS_XB = 114 * MiB;
constexpr size_t WS_YMIX = 178 * MiB;
constexpr size_t WS_PROJ = 242 * MiB;
constexpr size_t WS_END = 418 * MiB;

constexpr int RING_BYTES = 131072;
constexpr int LUT_OFF = RING_BYTES;
constexpr int OSTG_OFF = RING_BYTES + 2048;
constexpr int LUTALL_OFF = OSTG_OFF + 8 * 2304;
constexpr int LDS_BYTES = 163840;

constexpr int MISC_OFF = RING_BYTES + 1024;
constexpr size_t WS_BAR = 0;

#define XB_TMO      128
#define XB_XCNT(j)  (256  + 64 * (j))
#define XB_XSUB(j)  (1280 + 64 * (j))
#define XB_XGEN(j)  (2304 + 64 * (j))
#define XB_TOP      3328
#define XB_TOPGEN   3392
#define XCD_BAR_WORDS 3456
#define XB_SPIN_CAP (1u << 18)

__device__ __forceinline__ unsigned xb_ld(unsigned* p)              { return __hip_atomic_load(p, __ATOMIC_RELAXED, __HIP_MEMORY_SCOPE_AGENT); }
__device__ __forceinline__ unsigned xb_add(unsigned* p, unsigned v) { return __hip_atomic_fetch_add(p, v, __ATOMIC_RELAXED, __HIP_MEMORY_SCOPE_AGENT); }
__device__ __forceinline__ unsigned xb_xcc_id() { return (unsigned)__builtin_amdgcn_s_getreg((3 << 11) | 20) & 0xFu; }
#define XB_SPIN(cond, bar) do { unsigned _sp = 0; while (cond) { __builtin_amdgcn_s_sleep(1); \
    if ((++_sp & 255u) == 0u) { if (xb_ld(&(bar)[XB_TMO])) break; if (_sp > XB_SPIN_CAP) { atomicAdd(&(bar)[XB_TMO], 1u); break; } } } } while (0)

struct XcdBarrier {
    unsigned* bar; unsigned x;
    volatile LAS unsigned* st;
};

__device__ __forceinline__ XcdBarrier xcd_barrier_post(unsigned* bar, volatile LAS unsigned* st) {
    XcdBarrier b; b.bar = bar; b.x = xb_xcc_id(); b.st = st;
    if (threadIdx.x == 0) (void)xb_add(&bar[XB_XCNT(b.x)], 1u);
    return b;
}
__device__ __forceinline__ void xcd_barrier_complete(unsigned* bar, unsigned x, unsigned& nloc, unsigned& nx) {
    const unsigned G = gridDim.x * gridDim.y * gridDim.z;
    unsigned sum, cnt, mine, sp = 0u;
    for (;;) {
        sum = 0u; cnt = 0u; mine = 0u;
#pragma unroll
        for (unsigned j = 0; j < 16; ++j) { const unsigned c = xb_ld(&bar[XB_XCNT(j)]); sum += c; cnt += (c > 0u) ? 1u : 0u; mine = (j == x) ? c : mine; }
        if (sum == G) break;
        __builtin_amdgcn_s_sleep(1);
        if ((++sp & 255u) == 0u) { if (xb_ld(&bar[XB_TMO])) break; if (sp > XB_SPIN_CAP) { atomicAdd(&bar[XB_TMO], 1u); break; } }
    }
    nloc = mine > 0u ? mine : 1u; nx = cnt > 0u ? cnt : 1u;
}

__device__ __forceinline__ void xcd_barrier(const XcdBarrier& b) {
    asm volatile("s_waitcnt vmcnt(0)" ::: "memory");
    __syncthreads();
    if (threadIdx.x == 0) {
        unsigned* bar = b.bar;
        __builtin_amdgcn_s_waitcnt(0);
        unsigned nloc = b.st[0], nx = b.st[1];
        if (nloc == 0u) { xcd_barrier_complete(bar, b.x, nloc, nx); b.st[0] = nloc; b.st[1] = nx; }
        const unsigned old = xb_add(&bar[XB_XSUB(b.x)], 1u);
        const unsigned gen = old / nloc;
        if (old + 1u == (gen + 1u) * nloc) {
            __builtin_amdgcn_fence(__ATOMIC_RELEASE, "agent");
            asm volatile("s_waitcnt vmcnt(0)" ::: "memory");
            const unsigned og = xb_add(&bar[XB_TOP], 1u);
            const unsigned tg = og / nx;
            if (og + 1u == (tg + 1u) * nx) xb_add(&bar[XB_TOPGEN], 1u);
            else XB_SPIN(xb_ld(&bar[XB_TOPGEN]) == tg, bar);
            __builtin_amdgcn_fence(__ATOMIC_ACQUIRE, "agent");
            xb_add(&bar[XB_XGEN(b.x)], 1u);
            asm volatile("s_waitcnt vmcnt(0)" ::: "memory");
        } else {
            XB_SPIN(xb_ld(&bar[XB_XGEN(b.x)]) == gen, bar);
            __builtin_amdgcn_fence(__ATOMIC_ACQUIRE, "agent");
            asm volatile("s_waitcnt vmcnt(0)" ::: "memory");
        }
    }
    __syncthreads();
}

__device__ __forceinline__ void transpose_item(const float* W, int N, const float* gain, bf16_t* WT, int ldk, int drow0, int k0, int n0, int lane) {
    const int nq = lane & 15, kg = lane >> 4;
    const float* src = W + (size_t)(k0 + 8 * kg) * N + n0 + 4 * nq;
    f32x4 v[2][8];
#pragma unroll
    for (int h = 0; h < 2; ++h)
#pragma unroll
        for (int j = 0; j < 8; ++j) v[h][j] = *(const f32x4*)(src + (size_t)(32 * h + j) * N);
    if (gain) {
#pragma unroll
        for (int h = 0; h < 2; ++h) { const f32x4 g0 = *(const f32x4*)(gain + k0 + 32 * h + 8 * kg), g1 = *(const f32x4*)(gain + k0 + 32 * h + 8 * kg + 4);
#pragma unroll
            for (int j = 0; j < 4; ++j) { v[h][j] *= g0[j]; v[h][4 + j] *= g1[j]; } }
    }
#pragma unroll
    for (int h = 0; h < 2; ++h)
#pragma unroll
        for (int i = 0; i < 4; ++i) { u32x4 o; o.x = pk2(v[h][0][i], v[h][1][i]); o.y = pk2(v[h][2][i], v[h][3][i]); o.z = pk2(v[h][4][i], v[h][5][i]); o.w = pk2(v[h][6][i], v[h][7][i]);
            *(u32x4*)(WT + (size_t)(drow0 + 4 * nq + i) * ldk + k0 + 32 * h + 8 * kg) = o; }
}

struct Ptrs {
    const float *x, *p, *rel_bias, *g_mix, *w_in, *pool_w, *pool_scale, *w_out, *g_ffn, *w_gate, *w_up, *w_down, *g_ple, *w_pg, *w_pp, *g_final;
    float* out; unsigned char* ws;
};

__device__ __forceinline__ void prologue(const Ptrs& P, LAS unsigned char* lds, int gw, int NGW, int wid, int lane) {
    unsigned char* ws = P.ws;
    bf16_t* BT1 = (bf16_t*)(ws + WS_BT1); bf16_t* BT2 = (bf16_t*)(ws + WS_BT2); bf16_t* BT3 = (bf16_t*)(ws + WS_BT3);
    bf16_t* BT4 = (bf16_t*)(ws + WS_BT4); bf16_t* BT5 = (bf16_t*)(ws + WS_BT5); bf16_t* BT6 = (bf16_t*)(ws + WS_BT6);
    constexpr int I_IN = (DM / 64) * (NIN / 64);
    constexpr int I_OUT = ((DM - 512) / 64) * (DM / 64);
    constexpr int I_G = (DM / 64) * (DFF / 64);
    constexpr int I_DN = (DFF / 64) * (DM / 64);
    constexpr int I_PG = (DM / 64) * (DM / 64);
    constexpr int I_PP = (DPLE / 64) * (DM / 64);
    constexpr int NITEMS = I_IN + I_OUT + 2 * I_G + I_DN + I_PG + I_PP;
#define DEC(NB) const int nbh_ = (NB) / 8, blk_ = r >> 6, loc_ = r & 63, kb = (blk_ / nbh_) * 8 + (loc_ >> 3), n0 = 64 * ((blk_ % nbh_) * 8 + (loc_ & 7));
    for (int it = gw; it < NITEMS; it += NGW) {
        int r = it;
        if (r < I_IN) { DEC(NIN / 64) transpose_item(P.w_in, NIN, P.g_mix, BT1, DM, n0, 64 * kb, n0, lane); continue; } r -= I_IN;
        if (r < I_OUT) { DEC(DM / 64) transpose_item(P.w_out, DM, nullptr, BT2, DM, n0, 512 + 64 * kb, n0, lane); continue; } r -= I_OUT;
        if (r < I_G) { DEC(DFF / 64) transpose_item(P.w_gate, DFF, P.g_ffn, BT3, DM, (n0 >> 7) * 256 + (n0 & 127), 64 * kb, n0, lane); continue; } r -= I_G;
        if (r < I_G) { DEC(DFF / 64) transpose_item(P.w_up, DFF, P.g_ffn, BT3, DM, (n0 >> 7) * 256 + 128 + (n0 & 127), 64 * kb, n0, lane); continue; } r -= I_G;
        if (r < I_DN) { DEC(DM / 64) transpose_item(P.w_down, DM, nullptr, BT4, DFF, n0, 64 * kb, n0, lane); continue; } r -= I_DN;
        if (r < I_PG) { DEC(DM / 64) transpose_item(P.w_pg, DM, P.g_ple, BT5, DM, n0, 64 * kb, n0, lane); continue; } r -= I_PG;
        { const int nb = DM / 64, kb = r / nb, n0 = 64 * (r % nb); transpose_item(P.w_pp, DM, nullptr, BT6, DPLE, n0, 64 * kb, n0, lane); }
    }
    for (int it = gw; it < 1024; it += NGW) {
        const int kq = it >> 3, nc = it & 7, k4 = kq * 4, g = k4 >> 7, n = nc * 256 + lane * 4;
        f32x4 acc[4] = {{0.f, 0.f, 0.f, 0.f}, {0.f, 0.f, 0.f, 0.f}, {0.f, 0.f, 0.f, 0.f}, {0.f, 0.f, 0.f, 0.f}};
        const float* pw = P.pool_w + (size_t)k4 * 128;
        const float* ps = P.pool_scale + g * 128;
        const float* wo = P.w_out + (size_t)(g * 128) * DM + n;
#pragma unroll 4
        for (int d = 0; d < 128; ++d) {
            const f32x4 wv = *(const f32x4*)(wo + (size_t)d * DM); const float sc = ps[d];
#pragma unroll
            for (int cc = 0; cc < 4; ++cc) acc[cc] += (pw[cc * 128 + d] * sc) * wv;
        }
#pragma unroll
        for (int j = 0; j < 4; ++j) { u32x2 o; o.x = pk2(acc[0][j], acc[1][j]); o.y = pk2(acc[2][j], acc[3][j]); *(u32x2*)(BT2 + (size_t)(n + j) * DM + k4) = o; }
    }
    bf16_t* XB = (bf16_t*)(ws + WS_XB); float* rstdx = (float*)(ws + WS_RSTDX);
    for (int row = gw; row < MROWS; row += NGW) {
        const float* xr = P.x + (size_t)row * DM + lane * 8; f32x4 v[4][2]; float s = 0.f;
#pragma unroll
        for (int j = 0; j < 4; ++j) { v[j][0] = *(const f32x4*)(xr + 512 * j); v[j][1] = *(const f32x4*)(xr + 512 * j + 4); s += pg8::dot4(v[j][0]) + pg8::dot4(v[j][1]); }
        s = wave_sum(s);
        if (lane == 0) rstdx[row] = 1.0f / sqrtf(s * (1.0f / DM) + RMS_EPS);
        bf16_t* o = XB + (size_t)row * DM + lane * 8;
#pragma unroll
        for (int j = 0; j < 4; ++j) *(u32x4*)(o + 512 * j) = pg8::pack8(v[j][0], v[j][1]);
    }
    bf16_t* PB = (bf16_t*)(ws + WS_PB);
    for (int c = gw * 64 + lane; c < MROWS * DPLE / 8; c += NGW * 64) {
        const f32x4 a = *(const f32x4*)(P.p + (size_t)c * 8), b = *(const f32x4*)(P.p + (size_t)c * 8 + 4);
        *(u32x4*)(PB + (size_t)c * 8) = pg8::pack8(a, b);
    }
    float* z = (float*)(ws + WS_SSQ1);
    for (int c = gw * 64 + lane; c < 3 * MROWS; c += NGW * 64) z[c] = 0.f;
}

__device__ __forceinline__ void up8(const u32x4 w, float (&f)[8]) { f[0] = bflo(w.x); f[1] = bfhi(w.x); f[2] = bflo(w.y); f[3] = bfhi(w.y); f[4] = bflo(w.z); f[5] = bfhi(w.z); f[6] = bflo(w.w); f[7] = bfhi(w.w); }
template <int W> __device__ __forceinline__ void pool_item_w(const bf16_t* upool, bf16_t* ymix, int tg, int gi, int lane) {
    const int rq = lane >> 4, oct = lane & 15;
    const int t0 = tg * 16 + rq * 4, pos0 = t0 & (SEQ - 1), col = gi * 128 + oct * 8;
    const bf16_t* u = upool + (size_t)t0 * 512 + col;
    u32x4 prev[W - 1], cur[4];
#pragma unroll
    for (int k = 1; k < W; ++k) { const bool ok = pos0 - k >= 0; prev[k - 1] = *(const u32x4*)(u - (size_t)(ok ? k : 0) * 512); }
#pragma unroll
    for (int i = 0; i < 4; ++i) cur[i] = *(const u32x4*)(u + (size_t)i * 512);
    float acc[8] = {0.f, 0.f, 0.f, 0.f, 0.f, 0.f, 0.f, 0.f}, f[8];
#pragma unroll
    for (int k = 1; k < W; ++k) { if (pos0 - k < 0) prev[k - 1] = (u32x4){0u, 0u, 0u, 0u}; up8(prev[k - 1], f);
#pragma unroll
        for (int e = 0; e < 8; ++e) acc[e] += f[e]; }
#pragma unroll
    for (int i = 0; i < 4; ++i) {
        float c[8]; up8(cur[i], c);
#pragma unroll
        for (int e = 0; e < 8; ++e) acc[e] += c[e];
        if (i > 0) { if (i >= W) up8(cur[i >= W ? i - W : 0], f); else up8(prev[(W - i - 1) >= 0 && (W - i - 1) < W - 1 ? W - i - 1 : 0], f);
#pragma unroll
            for (int e = 0; e < 8; ++e) acc[e] -= f[e]; }
        const int cnt = (pos0 + i + 1 < W) ? (pos0 + i + 1) : W; const float ic = 1.0f / (float)cnt;
        u32x4 o; o.x = pk2(acc[0] * ic - c[0], acc[1] * ic - c[1]); o.y = pk2(acc[2] * ic - c[2], acc[3] * ic - c[3]);
        o.z = pk2(acc[4] * ic - c[4], acc[5] * ic - c[5]); o.w = pk2(acc[6] * ic - c[6], acc[7] * ic - c[7]);
        *(u32x4*)(ymix + (size_t)(t0 + i) * DM + col) = o;
    }
}
__device__ __forceinline__ void pool_item(const bf16_t* upool, bf16_t* ymix, int item, int lane) {
    const int gi = item & 3, tg = item >> 2;
    if (gi == 0) pool_item_w<2>(upool, ymix, tg, gi, lane); else if (gi == 1) pool_item_w<4>(upool, ymix, tg, gi, lane);
    else if (gi == 2) pool_item_w<8>(upool, ymix, tg, gi, lane); else pool_item_w<16>(upool, ymix, tg, gi, lane);
}

__device__ const unsigned char T5_BUCKET[3][129] = {
{0,1,2,3,4,5,6,7,8,9,10,11,12,13,14,15,16,16,16,16,16,16,17,17,17,17,17,17,17,17,18,18,18,18,18,18,18,18,18,18,19,19,19,19,19,19,19,19,19,19,19,19,19,19,20,20,20,20,20,20,20,20,20,20,20,20,20,20,20,20,20,20,20,21,21,21,21,21,21,21,21,21,21,21,21,21,21,21,21,21,21,21,21,21,21,21,21,21,21,22,22,22,22,22,22,22,22,22,22,22,22,22,22,22,22,22,22,22,22,22,22,22,22,22,22,22,22,22,22},
{0,4,8,12,16,16,17,17,18,18,19,19,19,19,20,20,20,20,20,21,21,21,21,21,21,22,22,22,22,22,22,22,22,22,23,23,23,23,23,23,23,23,23,23,23,23,24,24,24,24,24,24,24,24,24,24,24,24,24,24,24,24,25,25,25,25,25,25,25,25,25,25,25,25,25,25,25,25,25,25,25,25,25,26,26,26,26,26,26,26,26,26,26,26,26,26,26,26,26,26,26,26,26,26,26,26,26,26,26,26,26,26,26,27,27,27,27,27,27,27,27,27,27,27,27,27,27,27,27},
{0,16,18,19,20,21,21,22,22,23,23,23,24,24,24,24,25,25,25,25,25,26,26,26,26,26,26,26,26,27,27,27,27,27,27,27,27,27,27,28,28,28,28,28,28,28,28,28,28,28,28,28,29,29,29,29,29,29,29,29,29,29,29,29,29,29,29,29,29,29,30,30,30,30,30,30,30,30,30,30,30,30,30,30,30,30,30,30,30,30,30,30,30,30,30,31,31,31,31,31,31,31,31,31,31,31,31,31,31,31,31,31,31,31,31,31,31,31,31,31,31,31,31,31,31,31,31,31,31}};

__device__ __forceinline__ s16x4 vtr(LAS const unsigned char* p) { typedef short v4i16_t __attribute__((ext_vector_type(4))); return __builtin_bit_cast(s16x4, __builtin_amdgcn_ds_read_tr16_b64_v4i16((LAS v4i16_t*)p)); }

struct AttnItem { int g, dsh, n, r, b, head; size_t subbase, rowbase; };
__device__ __forceinline__ AttnItem attn_decode(int item) {
    AttnItem a; a.g = item >> 9; const int idx = item & 511; a.dsh = 2 * a.g; const int nbsh = 6 - a.dsh, seq = idx >> nbsh;
    a.n = idx & ((1 << nbsh) - 1); a.r = seq & ((1 << a.dsh) - 1); const int bh = seq >> a.dsh; a.head = a.g * 4 + (bh & 3); a.b = bh >> 2;
    a.rowbase = (size_t)a.b * SEQ; a.subbase = a.rowbase + ((size_t)a.r << (13 - a.dsh)); return a;
}
__device__ __forceinline__ void glds16_asm(const void* gsrc, unsigned lds_dst) { unsigned keep;
    asm volatile("s_mov_b32 %0, m0\n\ts_mov_b32 m0, %2\n\ts_nop 0\n\tglobal_load_lds_dwordx4 %1, off\n\ts_mov_b32 m0, %0" : "=&s"(keep) : "v"(gsrc), "s"(lds_dst) : "memory"); }
template <bool ISV> __device__ __forceinline__ void attn_stage_half(LAS unsigned char* dst, const bf16_t* th, size_t gidx0, int wid, int lane) {
#pragma unroll
    for (int j = 0; j < 4; ++j) {
        const int piece = wid * 4 + j, key = piece * 4 + (lane >> 4), cp = lane & 15;
        const int ch = ISV ? ((((cp >> 1) ^ (key & 7)) << 1) | (cp & 1)) : (cp ^ (key & 15));
        glds16_asm(th + (gidx0 + key) * HD + ch * 8, (unsigned)__builtin_amdgcn_readfirstlane((int)(unsigned)(size_t)(dst + piece * 1024)));
    }
}
__device__ __forceinline__ void attn_phase(LAS unsigned char* lds, const bf16_t* qkv, bf16_t* ymix, float* lse, const float* rel_bias, int item0, int nitems) {
    const int tid = threadIdx.x, lane = tid & 63, wid = __builtin_amdgcn_readfirstlane(tid >> 6), fr = lane & 15, fq = lane >> 4;
    const int q0 = wid * 16;
    LAS unsigned char* KB = lds; LAS unsigned char* VB = lds + 65536;
    LAS float* lutall = (LAS float*)(lds + LUTALL_OFF);
    if (nitems <= 0) return;
    if (tid < 129) {
#pragma unroll
        for (int h = 0; h < NHEADS; ++h) lutall[h * 132 + tid] = rel_bias[(int)T5_BUCKET[h >> 2][tid] * NHEADS + h] * LOG2E;
    }
    bf16x8 qf[4];
    {
        const AttnItem a = attn_decode(item0);
        const bf16_t* kh = qkv + (size_t)(12 + a.head) * MROWS * HD; const bf16_t* vh = qkv + (size_t)(24 + a.head) * MROWS * HD; const bf16_t* qh = qkv + (size_t)a.head * MROWS * HD;
        const size_t cur = a.subbase + 128 * a.n, prv = a.n > 0 ? cur - 128 : cur;
        attn_stage_half<false>(KB, kh, cur, wid, lane); attn_stage_half<false>(KB + 32768, kh, prv, wid, lane);
        attn_stage_half<true>(VB, vh, cur, wid, lane); attn_stage_half<true>(VB + 32768, vh, prv, wid, lane);
        const bf16_t* qp = qh + (cur + q0 + fr) * HD + 8 * fq;
#pragma unroll
        for (int s = 0; s < 4; ++s) qf[s] = *(const bf16x8*)(qp + 32 * s);
    }
    for (int i = 0; i < nitems; ++i) {
        const AttnItem a = attn_decode(item0 + i);
        const int cs = i & 1;
        const bool has_next = i + 1 < nitems;
        AttnItem an = a; if (has_next) an = attn_decode(item0 + i + 1);
        asm volatile("s_waitcnt vmcnt(0) lgkmcnt(0)" ::: "memory");
        __builtin_amdgcn_s_barrier();
        asm volatile("" ::: "memory");
        f32x4 sc[9];
#pragma unroll
        for (int jt = 0; jt < 9; ++jt) {
            const int kt = q0 + 16 * jt, prow = ((((kt >> 7) ^ 1 ^ cs) & 1) << 7) | (kt & 127);
            f32x4 acc = {0.f, 0.f, 0.f, 0.f};
            LAS const unsigned char* kp = KB + (prow + fr) * 256;
#pragma unroll
            for (int s = 0; s < 4; ++s) { const bf16x8 kf = *(LAS const bf16x8*)(kp + (((4 * s + fq) ^ fr) << 4)); acc = __builtin_amdgcn_mfma_f32_16x16x32_bf16(kf, qf[s], acc, 0, 0, 0); }
            sc[jt] = acc;
        }
        asm volatile("s_waitcnt lgkmcnt(0)" ::: "memory");
        __builtin_amdgcn_s_barrier();
        asm volatile("" ::: "memory");
        if (has_next) {
            const bf16_t* qh = qkv + (size_t)an.head * MROWS * HD; const bf16_t* kh = qkv + (size_t)(12 + an.head) * MROWS * HD;
            const size_t cur = an.subbase + 128 * an.n;
            const bf16_t* qp = qh + (cur + q0 + fr) * HD + 8 * fq;
#pragma unroll
            for (int s = 0; s < 4; ++s) qf[s] = *(const bf16x8*)(qp + 32 * s);
            attn_stage_half<false>(KB + (cs ^ 1) * 32768, kh, cur, wid, lane);
        }
        LAS const float* lut = lutall + a.head * 132;
        float mx = -3.0e38f;
#pragma unroll
        for (int jt = 0; jt < 9; ++jt)
#pragma unroll
            for (int e = 0; e < 4; ++e) {
                const int off = 128 + fr - 16 * jt - 4 * fq - e, ki = q0 + 16 * jt + 4 * fq + e;
                const bool ok = (off >= 0) && (off <= 128) && (a.n > 0 || ki >= 128);
                const int oc = off < 0 ? 0 : (off > 128 ? 128 : off);
                const float v = ok ? sc[jt][e] + lut[oc] : -1.0e30f;
                sc[jt][e] = v; mx = fmaxf(mx, v);
            }
        mx = fmaxf(mx, __shfl_xor(mx, 16)); mx = fmaxf(mx, __shfl_xor(mx, 32));
        float den = 0.f;
#pragma unroll
        for (int jt = 0; jt < 9; ++jt)
#pragma unroll
            for (int e = 0; e < 4; ++e) { const float pv = __builtin_amdgcn_exp2f(sc[jt][e] - mx); sc[jt][e] = pv; den += pv; }
        den += __shfl_xor(den, 16); den += __shfl_xor(den, 32);
        bf16x8 pb[5];
#pragma unroll
        for (int ks = 0; ks < 5; ++ks) {
            u32x4 w; w.x = pk2(sc[2 * ks][0], sc[2 * ks][1]); w.y = pk2(sc[2 * ks][2], sc[2 * ks][3]);
            if (ks < 4) { w.z = pk2(sc[2 * ks + 1][0], sc[2 * ks + 1][1]); w.w = pk2(sc[2 * ks + 1][2], sc[2 * ks + 1][3]); } else { w.z = 0u; w.w = 0u; }
            pb[ks] = __builtin_bit_cast(bf16x8, w);
        }
        f32x4 o[8];
#pragma unroll
        for (int db = 0; db < 8; ++db) o[db] = (f32x4){0.f, 0.f, 0.f, 0.f};
#pragma unroll
        for (int ks = 0; ks < 5; ++ks) {
            const int ktA = q0 + 32 * ks, ktB = (ks < 4) ? ktA + 16 : ktA;
            const int prA = ((((ktA >> 7) ^ 1 ^ cs) & 1) << 7) | (ktA & 127), prB = ((((ktB >> 7) ^ 1 ^ cs) & 1) << 7) | (ktB & 127);
            const int rl = 4 * fq + (fr >> 2);
            LAS const unsigned char* va = VB + (prA + rl) * 256 + 8 * (fr & 3);
            LAS const unsigned char* vb = VB + (prB + rl) * 256 + 8 * (fr & 3);
#pragma unroll
            for (int db = 0; db < 8; ++db) {
                const s16x4 lo = vtr(va + ((db ^ (rl & 7)) << 5)), hi = vtr(vb + ((db ^ (rl & 7)) << 5));
                const bf16x8 vf = {lo[0], lo[1], lo[2], lo[3], hi[0], hi[1], hi[2], hi[3]};
                o[db] = __builtin_amdgcn_mfma_f32_16x16x32_bf16(vf, pb[ks], o[db], 0, 0, 0);
            }
        }
        asm volatile("s_waitcnt lgkmcnt(0)" ::: "memory");
        __builtin_amdgcn_s_barrier();
        asm volatile("" ::: "memory");
        if (has_next) {
            const bf16_t* vh = qkv + (size_t)(24 + an.head) * MROWS * HD;
            attn_stage_half<true>(VB + (cs ^ 1) * 32768, vh, an.subbase + 128 * an.n, wid, lane);
        }
        const float inv = 1.0f / den;
        LAS unsigned char* stg = lds + OSTG_OFF + wid * 2304;
        const size_t qrow_w = a.rowbase + ((size_t)(128 * a.n + q0) << a.dsh) + a.r;
#pragma unroll
        for (int hh = 0; hh < 2; ++hh) {
#pragma unroll
            for (int d4 = 0; d4 < 4; ++d4) { const int db = 4 * hh + d4; u32x2 w; w.x = pk2(o[db][0] * inv, o[db][1] * inv); w.y = pk2(o[db][2] * inv, o[db][3] * inv);
                *(LAS u32x2*)(stg + fr * 144 + d4 * 32 + 8 * fq) = w; }
            asm volatile("s_waitcnt lgkmcnt(0)" ::: "memory");
#pragma unroll
            for (int p = 0; p < 2; ++p) { const int rw = (lane >> 3) + 8 * p, ch = lane & 7;
                const u32x4 v = *(LAS const u32x4*)(stg + rw * 144 + ch * 16);
                *(u32x4*)(ymix + (qrow_w + ((size_t)rw << a.dsh)) * DM + 512 + a.head * HD + 64 * hh + 8 * ch) = v; }
            asm volatile("s_waitcnt lgkmcnt(0)" ::: "memory");
        }
        if (fq == 0) lse[(qrow_w + ((size_t)fr << a.dsh)) * NHEADS + a.head] = (mx + __builtin_amdgcn_logf(den)) * LN2;
    }
    asm volatile("s_waitcnt vmcnt(0) lgkmcnt(0)" ::: "memory");
    __builtin_amdgcn_s_barrier();
    asm volatile("" ::: "memory");
}

__device__ __forceinline__ void mix_row(bf16_t* ymix, const float* lse, int row, int lane) {
    const int hs = lane >> 4; const float* l = lse + (size_t)row * NHEADS + hs;
    const float l0 = l[0], l1 = l[4], l2 = l[8], m = fmaxf(l0, fmaxf(l1, l2));
    const float e0 = __expf(l0 - m), e1 = __expf(l1 - m), e2 = __expf(l2 - m), inv = 1.0f / (e0 + e1 + e2);
    const float al[3] = {e0 * inv, e1 * inv, e2 * inv};
    bf16_t* y = ymix + (size_t)row * DM + 512 + lane * 8;
#pragma unroll
    for (int j = 0; j < 3; ++j) { const u32x4 w = *(const u32x4*)(y + 512 * j); const float a = al[j]; u32x4 o;
        o.x = pk2(bflo(w.x) * a, bfhi(w.x) * a); o.y = pk2(bflo(w.y) * a, bfhi(w.y) * a); o.z = pk2(bflo(w.z) * a, bfhi(w.z) * a); o.w = pk2(bflo(w.w) * a, bfhi(w.w) * a);
        *(u32x4*)(y + 512 * j) = o; }
}
__device__ __forceinline__ void final_row(float* out, const bf16_t* h3, const float* ssq, const float* gfin, int row, int lane) {
    const float r = 1.0f / sqrtf(ssq[row] * (1.0f / DM) + RMS_EPS);
    float* o = out + (size_t)row * DM + lane * 8; const bf16_t* hh = h3 + (size_t)row * DM + lane * 8;
#pragma unroll
    for (int j = 0; j < 4; ++j) { const u32x4 w = *(const u32x4*)(hh + 512 * j); const f32x4 g0 = *(const f32x4*)(gfin + lane * 8 + 512 * j), g1 = *(const f32x4*)(gfin + lane * 8 + 512 * j + 4);
        const f32x4 v0 = {bflo(w.x), bfhi(w.x), bflo(w.y), bfhi(w.y)}, v1 = {bflo(w.z), bfhi(w.z), bflo(w.w), bfhi(w.w)};
        *(f32x4*)(o + 512 * j) = v0 * r * g0; *(f32x4*)(o + 512 * j + 4) = v1 * r * g1; }
}


struct Args { const float* in[16]; float* out; unsigned char* ws; };

#define PG8_ALIGN true
#define PG8_SP2 true

__global__ void __launch_bounds__(512, 2) hymba_fwd(Args args) {
    extern __shared__ __attribute__((aligned(16))) unsigned char lds_raw[];
    LAS unsigned char* lds = (LAS unsigned char*)lds_raw;
    cg::grid_group grid = cg::this_grid();
    const int tid = threadIdx.x, lane = tid & 63, wid = __builtin_amdgcn_readfirstlane(tid >> 6);
    const int G = gridDim.x, bx = blockIdx.x;
    const int vcu = (G % 8 == 0) ? (bx % 8) * (G / 8) + bx / 8 : bx;
    const int gw = vcu * 8 + wid, NGW = G * 8;
    Ptrs P;
    P.x = args.in[0]; P.p = args.in[1]; P.rel_bias = args.in[2]; P.g_mix = args.in[3]; P.w_in = args.in[4]; P.pool_w = args.in[5]; P.pool_scale = args.in[6]; P.w_out = args.in[7];
    P.g_ffn = args.in[8]; P.w_gate = args.in[9]; P.w_up = args.in[10]; P.w_down = args.in[11]; P.g_ple = args.in[12]; P.w_pg = args.in[13]; P.w_pp = args.in[14]; P.g_final = args.in[15];
    P.out = args.out; P.ws = args.ws;
    unsigned char* ws = args.ws;
    bf16_t* BT1 = (bf16_t*)(ws + WS_BT1); bf16_t* BT2 = (bf16_t*)(ws + WS_BT2); bf16_t* BT3 = (bf16_t*)(ws + WS_BT3);
    bf16_t* BT4 = (bf16_t*)(ws + WS_BT4); bf16_t* BT5 = (bf16_t*)(ws + WS_BT5); bf16_t* BT6 = (bf16_t*)(ws + WS_BT6);
    bf16_t* PB = (bf16_t*)(ws + WS_PB); bf16_t* XB = (bf16_t*)(ws + WS_XB); bf16_t* YMIX = (bf16_t*)(ws + WS_YMIX); bf16_t* PROJ = (bf16_t*)(ws + WS_PROJ);
    float* SSQ1 = (float*)(ws + WS_SSQ1); float* SSQ2 = (float*)(ws + WS_SSQ2); float* SSQ3 = (float*)(ws + WS_SSQ3); float* RSTDX = (float*)(ws + WS_RSTDX); float* LSE = (float*)(ws + WS_LSE);

    volatile LAS unsigned* MISC = (volatile LAS unsigned*)(lds + MISC_OFF);
    if (tid < 2) MISC[tid] = 0u;
    if (bx == 0) for (int u = tid; u < XCD_BAR_WORDS; u += 512) ((unsigned*)(ws + WS_BAR))[u] = 0u;
    prologue(P, lds, gw, NGW, wid, lane);
    grid.sync();
    const XcdBarrier bar = xcd_barrier_post((unsigned*)(ws + WS_BAR), MISC);

    { pg8::Gemm g{XB, BT1, MROWS, NIN, DM}; pg8::StaticOrder S; S.init(MROWS, NIN, G, bx);
      pg8::EpiProj E{PROJ, PROJ + (size_t)MROWS * 512, RSTDX, QSCALE, 13, MROWS};
      pg8::gemm_phase<pg8::EpiProj, pg8::StaticOrder, PG8_ALIGN, PG8_SP2>(lds, g, S, E); }
    xcd_barrier(bar);

    { const int per = (1536 + G - 1) / G;
      { const int i0 = vcu * per, cnt = (i0 + per <= 1536) ? per : (1536 - i0); attn_phase(lds, PROJ + (size_t)MROWS * 512, YMIX, LSE, P.rel_bias, i0, cnt); }
      for (int it = gw; it < 4096; it += NGW) pool_item(PROJ, YMIX, it, lane); }
    xcd_barrier(bar);

    for (int row = gw; row < MROWS; row += NGW) mix_row(YMIX, LSE, row, lane);
    xcd_barrier(bar);

    { pg8::Gemm g{YMIX, BT2, MROWS, DM, DM}; pg8::StaticOrder S; S.init(MROWS, DM, G, bx);
      pg8::EpiRes E{XB, XB, SSQ1, DM};
      pg8::gemm_phase<pg8::EpiRes, pg8::StaticOrder, PG8_ALIGN, PG8_SP2>(lds, g, S, E); }
    xcd_barrier(bar);

    { pg8::Gemm g{XB, BT3, MROWS, 2 * DFF, DM}; pg8::StaticOrder S; S.init(MROWS, 2 * DFF, G, bx);
      pg8::EpiSwiGLU E{PROJ, DFF, SSQ1, 1.0f / DM, RMS_EPS};
      pg8::gemm_phase<pg8::EpiSwiGLU, pg8::StaticOrder, PG8_ALIGN, PG8_SP2>(lds, g, S, E); }
    { int kpp = DPLE; asm volatile("" : "+s"(kpp));
      pg8::Gemm g{PB, BT6, MROWS, DM, kpp}; pg8::StaticOrder S; S.init(MROWS, DM, G, bx);
      pg8::EpiPlain E{YMIX, DM};
      pg8::gemm_phase<pg8::EpiPlain, pg8::StaticOrder, PG8_ALIGN, PG8_SP2>(lds, g, S, E); }
    xcd_barrier(bar);

    { pg8::Gemm g{PROJ, BT4, MROWS, DM, DFF}; pg8::StaticOrder S; S.init(MROWS, DM, G, bx);
      pg8::EpiRes E{XB, XB, SSQ2, DM};
      pg8::gemm_phase<pg8::EpiRes, pg8::StaticOrder, PG8_ALIGN, PG8_SP2>(lds, g, S, E); }
    xcd_barrier(bar);

    { pg8::Gemm g{XB, BT5, MROWS, DM, DM}; pg8::StaticOrder S; S.init(MROWS, DM, G, bx);
      pg8::EpiPle E{XB, YMIX, PROJ, SSQ2, SSQ3, DM, 1.0f / DM, RMS_EPS};
      pg8::gemm_phase<pg8::EpiPle, pg8::StaticOrder, PG8_ALIGN, PG8_SP2>(lds, g, S, E); }
    xcd_barrier(bar);

    for (int row = gw; row < MROWS; row += NGW) final_row(P.out, PROJ, SSQ3, P.g_final, row, lane);
}

extern "C" void kernel_launch(void* const* d_in, const int* in_sizes, int n_in, void* d_out, int out_size, void* d_ws, size_t ws_size, hipStream_t stream) {
    static int grid = 0;
    if (grid == 0) {
        if (n_in != 16 || in_sizes[0] != MROWS * DM || out_size != MROWS * DM || ws_size < WS_END) {
            fprintf(stderr, "kernel_launch: unexpected shapes (n_in %d, in0 %d, out %d, ws %zu); nothing launched\n", n_in, n_in > 0 ? in_sizes[0] : -1, out_size, ws_size); grid = -1; return; }
        int dev = 0, cus = 0, per_cu = 0;
        if (hipGetDevice(&dev) != hipSuccess || hipDeviceGetAttribute(&cus, hipDeviceAttributeMultiprocessorCount, dev) != hipSuccess) { fprintf(stderr, "kernel_launch: device query failed\n"); grid = -1; return; }
        if (hipFuncSetAttribute((const void*)hymba_fwd, hipFuncAttributeMaxDynamicSharedMemorySize, LDS_BYTES) != hipSuccess) { fprintf(stderr, "kernel_launch: hipFuncSetAttribute failed\n"); grid = -1; return; }
        if (hipOccupancyMaxActiveBlocksPerMultiprocessor(&per_cu, (const void*)hymba_fwd, 512, LDS_BYTES) != hipSuccess || per_cu < 1) { fprintf(stderr, "kernel_launch: occupancy query says %d blocks per CU\n", per_cu); (void)hipGetLastError(); per_cu = 1; }
        if (per_cu > 1) per_cu = 1;
        grid = cus * per_cu;
    }
    if (grid < 0) return;
    Args a{};
    for (int i = 0; i < 16; ++i) a.in[i] = (const float*)d_in[i];
    a.out = (float*)d_out; a.ws = (unsigned char*)d_ws;
    void* kargs[] = {&a};
    hipError_t e = hipLaunchCooperativeKernel((const void*)hymba_fwd, dim3(grid), dim3(512), kargs, LDS_BYTES, stream);
    if (e != hipSuccess) fprintf(stderr, "kernel_launch: cooperative launch failed: %s (grid %d)\n", hipGetErrorString(e), grid);
}
```

```cpp
#include <hip/hip_runtime.h>
#include <hip/hip_cooperative_groups.h>
#include <cstdio>
#include <cstdint>
namespace cg = cooperative_groups;

constexpr int BATCH = 2, SEQ = 8192, DM = 2048, MROWS = BATCH * SEQ, NIN = 5120, DFF = 5632, DPLE = 256, NHEADS = 12, HD = 128;
constexpr float RMS_EPS = 1e-6f;
constexpr float QSCALE = 0.08838834764831845f * 1.4426950408889634f;
constexpr float LOG2E = 1.4426950408889634f, LN2 = 0.6931471805599453f;
namespace pg8 {
#define PG8_LAS __attribute__((address_space(3)))
typedef unsigned short bf16_t;
typedef short bf16x8 __attribute__((ext_vector_type(8)));
typedef float f32x4 __attribute__((ext_vector_type(4)));
typedef unsigned u32x4 __attribute__((ext_vector_type(4)));
constexpr int BM = 256, BK = 64, HALF = 128, HTB = HALF * BK * 2  , STAGE_BYTES = 8 * HTB, NXCD = 8, WGM = 8;

__host__ __device__ __forceinline__ int lds_byte(int r, int c) { const int st = (r >> 4) * 2 + (c >> 5), rr = r & 15, cc = c & 31, ob = rr * 64 + cc * 2; return st * 1024 + (ob ^ (((ob >> 9) & 1) << 5)); }
__host__ __device__ __forceinline__ void stage_rc(int b, int& R, int& C) { const int st = b / 1024, sb = b % 1024, swz = sb ^ (((sb >> 9) & 1) << 5); R = (st >> 1) * 16 + swz / 64; C = (st & 1) * 32 + (swz % 64) / 2; }
__host__ __device__ __forceinline__ int perm32(int rho) { const int n = rho >> 4, i = rho & 15; return 8 * (i >> 2) + 4 * n + (i & 3); }

struct Unit { int pm, pn; };
struct Gemm { const bf16_t* A; const bf16_t* Bt; int M, N, K; };

struct StaticOrder {
    int nM, nN, nwg, G, c;
    __host__ __device__ void init(int M, int N, int G_, int c_) { nM = M / BM; nN = N / BM; nwg = nM * nN; G = G_; c = c_; }
    __host__ __device__ bool next(int i, Unit& u) const {
        const long L = (long)i * G + c; if (L >= nwg) return false;
        int wgid = (int)L; { const int q = nwg / NXCD, r = nwg % NXCD, xcd = wgid % NXCD, off = wgid / NXCD; wgid = (xcd < r ? xcd * (q + 1) : r * (q + 1) + (xcd - r) * q) + off; }
        const int nig = WGM * nN, gid = wgid / nig, fm = gid * WGM, gsz = (nM - fm) < WGM ? (nM - fm) : WGM;
        u.pm = fm + ((wgid % nig) % gsz); u.pn = (wgid % nig) / gsz; return true;
    }
    __device__ __forceinline__ void a_ready(const Unit&) const {}
    __device__ __forceinline__ void done(const Unit&) const {}
};

__device__ __forceinline__ unsigned cvt_pk_bf16(float lo, float hi) { unsigned r; asm volatile("v_cvt_pk_bf16_f32 %0, %1, %2" : "=v"(r) : "v"(lo), "v"(hi)); return r; }
__device__ __forceinline__ u32x4 pack8(const f32x4 v0, const f32x4 v1) { u32x4 w; w.x = cvt_pk_bf16(v0[0], v0[1]); w.y = cvt_pk_bf16(v0[2], v0[3]); w.z = cvt_pk_bf16(v1[0], v1[1]); w.w = cvt_pk_bf16(v1[2], v1[3]); return w; }
__device__ __forceinline__ float bf_lo(unsigned w) { return __uint_as_float(w << 16); }
__device__ __forceinline__ float bf_hi(unsigned w) { return __uint_as_float(w & 0xffff0000u); }
__device__ __forceinline__ float dot4(const f32x4 v) { return (v[0] * v[0] + v[1] * v[1]) + (v[2] * v[2] + v[3] * v[3]); }

constexpr int PF_SCRATCH = 131072 + 2048;
__device__ __forceinline__ void prefetch_tile(const bf16_t* base, int ldc, const Unit& u, PG8_LAS unsigned char* lds, int tid, int wid, int slot) {
#pragma unroll
    for (int j = 0; j < 2; ++j) { const int line = tid + 512 * j, row = line >> 2, seg = line & 3;
        __builtin_amdgcn_global_load_lds((const unsigned*)(base + (size_t)(u.pm * BM + row) * ldc + u.pn * BM + seg * 64), (PG8_LAS unsigned*)(lds + PF_SCRATCH + (slot * 16 + wid * 2 + j) * 256), 4, 0, 0); }
}
struct EpiProj {
    static constexpr bool PERM = true, AFTER_DRAIN = false;
    __device__ __forceinline__ void prefetch(const Unit&, PG8_LAS unsigned char*, int, int) const {}
    bf16_t* POOL; bf16_t* QKV; const float* rstd; float qscale; int seq_sh, mrows;
    __device__ __forceinline__ void operator()(const f32x4 (&acc)[2][2][4][2], const Unit& u, int wr, int wc, int fr, int fq) const {
        const int row0 = u.pm * BM + wr * 64 + fr, cin = wc * 32 + 8 * fq;
        if (u.pn < 2) {
#pragma unroll
            for (int ai = 0; ai < 2; ++ai)
#pragma unroll
                for (int m = 0; m < 4; ++m) { const int row = row0 + ai * HALF + m * 16; const float s = rstd[row]; bf16_t* rowp = POOL + (size_t)row * 512 + u.pn * BM + cin;
#pragma unroll
                    for (int bj = 0; bj < 2; ++bj) *(u32x4*)(rowp + bj * HALF) = pack8(acc[ai][bj][m][0] * s, acc[ai][bj][m][1] * s); }
        } else {
            const int tq = (u.pn - 2) / 6, hp = (u.pn - 2) - 6 * tq;
            const float qs = tq == 0 ? qscale : 1.0f;
#pragma unroll
            for (int ai = 0; ai < 2; ++ai)
#pragma unroll
                for (int m = 0; m < 4; ++m) { const int row = row0 + ai * HALF + m * 16; const float s = rstd[row] * qs;
                    const int b = row >> seq_sh, t = row & ((1 << seq_sh) - 1);
#pragma unroll
                    for (int bj = 0; bj < 2; ++bj) { const int head = 2 * hp + bj, dsh = 2 * (head >> 2);
                        const int idx = (b << seq_sh) + ((t & ((1 << dsh) - 1)) << (seq_sh - dsh)) + (t >> dsh);
                        *(u32x4*)(QKV + ((size_t)(tq * 12 + head) * mrows + idx) * 128 + cin) = pack8(acc[ai][bj][m][0] * s, acc[ai][bj][m][1] * s); } }
        }
    }
};
struct EpiPlain {
    static constexpr bool PERM = true, AFTER_DRAIN = false;
    __device__ __forceinline__ void prefetch(const Unit&, PG8_LAS unsigned char*, int, int) const {}
    bf16_t* O; int ldc;
    __device__ __forceinline__ void operator()(const f32x4 (&acc)[2][2][4][2], const Unit& u, int wr, int wc, int fr, int fq) const {
        const int row0 = u.pm * BM + wr * 64 + fr, col0 = u.pn * BM + wc * 32 + 8 * fq;
#pragma unroll
        for (int ai = 0; ai < 2; ++ai)
#pragma unroll
            for (int m = 0; m < 4; ++m) { bf16_t* rowp = O + (size_t)(row0 + ai * HALF + m * 16) * ldc + col0;
#pragma unroll
                for (int bj = 0; bj < 2; ++bj) *(u32x4*)(rowp + bj * HALF) = pack8(acc[ai][bj][m][0], acc[ai][bj][m][1]); }
    }
};
struct EpiRes {
    static constexpr bool PERM = true, AFTER_DRAIN = false;
    const bf16_t* base; bf16_t* ob; float* ssq; int ldc;
    __device__ __forceinline__ void prefetch(const Unit& u, PG8_LAS unsigned char* lds, int tid, int wid) const { prefetch_tile(base, ldc, u, lds, tid, wid, 0); }
    __device__ __forceinline__ void operator()(const f32x4 (&acc)[2][2][4][2], const Unit& u, int wr, int wc, int fr, int fq) const {
        const int row0 = u.pm * BM + wr * 64 + fr, col0 = u.pn * BM + wc * 32 + 8 * fq;
#pragma unroll
        for (int ai = 0; ai < 2; ++ai)
#pragma unroll
            for (int m = 0; m < 4; ++m) { const int row = row0 + ai * HALF + m * 16; const size_t off = (size_t)row * ldc + col0; float s = 0.f;
#pragma unroll
                for (int bj = 0; bj < 2; ++bj) {
                    const u32x4 bw = *(const u32x4*)(base + off + bj * HALF);
                    const f32x4 v0 = (f32x4){bf_lo(bw.x), bf_hi(bw.x), bf_lo(bw.y), bf_hi(bw.y)} + acc[ai][bj][m][0], v1 = (f32x4){bf_lo(bw.z), bf_hi(bw.z), bf_lo(bw.w), bf_hi(bw.w)} + acc[ai][bj][m][1];
                    *(u32x4*)(ob + off + bj * HALF) = pack8(v0, v1);
                    s += dot4(v0) + dot4(v1); }
                s += __shfl_xor(s, 16); s += __shfl_xor(s, 32);
                if (fq == 0) atomicAdd(ssq + row, s); }
    }
};
struct EpiSwiGLU {
    static constexpr bool PERM = true, AFTER_DRAIN = false;
    __device__ __forceinline__ void prefetch(const Unit&, PG8_LAS unsigned char*, int, int) const {}
    bf16_t* O; int ldc; const float* ssq; float inv_d, eps;
    __device__ __forceinline__ void operator()(const f32x4 (&acc)[2][2][4][2], const Unit& u, int wr, int wc, int fr, int fq) const {
        const int row0 = u.pm * BM + wr * 64 + fr, col0 = u.pn * HALF + wc * 32 + 8 * fq;
#pragma unroll
        for (int ai = 0; ai < 2; ++ai)
#pragma unroll
            for (int m = 0; m < 4; ++m) { const int row = row0 + ai * HALF + m * 16; const float r = __builtin_amdgcn_rsqf(ssq[row] * inv_d + eps);
                f32x4 o[2];
#pragma unroll
                for (int n = 0; n < 2; ++n)
#pragma unroll
                    for (int j = 0; j < 4; ++j) { const float g = acc[ai][0][m][n][j] * r, up = acc[ai][1][m][n][j] * r;
                        o[n][j] = g * up * __builtin_amdgcn_rcpf(1.0f + __builtin_amdgcn_exp2f(-1.4426950408889634f * g)); }
                *(u32x4*)(O + (size_t)row * ldc + col0) = pack8(o[0], o[1]); }
    }
};
struct EpiPle {
    static constexpr bool PERM = true, AFTER_DRAIN = false;
    const bf16_t* h; const bf16_t* pp; bf16_t* o; const float* ssq2; float* ssq3; int ldc; float inv_d, eps;
    __device__ __forceinline__ void prefetch(const Unit& u, PG8_LAS unsigned char* lds, int tid, int wid) const { prefetch_tile(h, ldc, u, lds, tid, wid, 0); prefetch_tile(pp, ldc, u, lds, tid, wid, 1); }
    __device__ __forceinline__ void operator()(const f32x4 (&acc)[2][2][4][2], const Unit& u, int wr, int wc, int fr, int fq) const {
        const int row0 = u.pm * BM + wr * 64 + fr, col0 = u.pn * BM + wc * 32 + 8 * fq;
#pragma unroll
        for (int ai = 0; ai < 2; ++ai)
#pragma unroll
            for (int m = 0; m < 4; ++m) { const int row = row0 + ai * HALF + m * 16; const size_t off = (size_t)row * ldc + col0; float s = 0.f;
                const float r = __builtin_amdgcn_rsqf(ssq2[row] * inv_d + eps);
#pragma unroll
                for (int bj = 0; bj < 2; ++bj) {
                    const u32x4 pw = *(const u32x4*)(pp + off + bj * HALF), hw = *(const u32x4*)(h + off + bj * HALF);
                    f32x4 v0 = {bf_lo(hw.x), bf_hi(hw.x), bf_lo(hw.y), bf_hi(hw.y)}, v1 = {bf_lo(hw.z), bf_hi(hw.z), bf_lo(hw.w), bf_hi(hw.w)};
                    const f32x4 p0 = {bf_lo(pw.x), bf_hi(pw.x), bf_lo(pw.y), bf_hi(pw.y)}, p1 = {bf_lo(pw.z), bf_hi(pw.z), bf_lo(pw.w), bf_hi(pw.w)};
#pragma unroll
                    for (int j = 0; j < 4; ++j) {
                        v0[j] += p0[j] * __builtin_amdgcn_rcpf(1.0f + __builtin_amdgcn_exp2f(-1.4426950408889634f * r * acc[ai][bj][m][0][j]));
                        v1[j] += p1[j] * __builtin_amdgcn_rcpf(1.0f + __builtin_amdgcn_exp2f(-1.4426950408889634f * r * acc[ai][bj][m][1][j])); }
                    *(u32x4*)(o + off + bj * HALF) = pack8(v0, v1);
                    s += dot4(v0) + dot4(v1); }
                s += __shfl_xor(s, 16); s += __shfl_xor(s, 32);
                if (fq == 0) atomicAdd(ssq3 + row, s); }
    }
};

template <class Epi, class Sched, bool ALIGN_EPI = false, bool SP2 = false>
__device__ __forceinline__ void gemm_phase(PG8_LAS unsigned char* lds, const Gemm g, const Sched& S, const Epi& E) {
    int tid_ = threadIdx.x; asm volatile("" : "+v"(tid_));
    const int tid = tid_, wid = __builtin_amdgcn_readfirstlane(tid >> 6), lane = tid & 63, wr = wid >> 2, wc = wid & 3, fr = lane & 15, fq = lane >> 4;
    const int K = g.K, nt = K / BK;
    unsigned voffA[2], voffB[2];
#pragma unroll
    for (int i = 0; i < 2; ++i) { int R, C; stage_rc(tid * 16 + i * 8192, R, C); const int Rb = Epi::PERM ? ((R & ~31) + perm32(R & 31)) : R;
        voffA[i] = (unsigned)(R * K + C) * 2u; voffB[i] = (unsigned)(Rb * K + C) * 2u; }
    const size_t kstep = (size_t)(BK * 2);
    const size_t hstep = (size_t)HALF * K * 2;
    const size_t tstep = 2 * hstep;
    const unsigned ldsw = (unsigned)wid * 1024u;
    const int aoff = lds_byte(wr * 64 + fr, fq * 8), boff = lds_byte(wc * 32 + fr, fq * 8);
#define PG8_SA(b, h) (((b) * 2 + (h)) * HTB)
#define PG8_SB(b, h) ((4 + (b) * 2 + (h)) * HTB)
#define PG8_STAGE(bufoff, gbase, voff) do { _Pragma("unroll") for (int _i = 0; _i < 2; ++_i) \
        __builtin_amdgcn_global_load_lds((const unsigned*)((const char*)(gbase) + (voff)[_i]), (PG8_LAS unsigned*)(lds + (bufoff) + ldsw + _i * 8192), 16, 0, 0); } while (0)
#define PG8_LDA(dst, b, h) do { _Pragma("unroll") for (int m = 0; m < 4; ++m) _Pragma("unroll") for (int k = 0; k < 2; ++k) dst[m][k] = *(const PG8_LAS bf16x8*)(lds + PG8_SA(b, h) + aoff + m * 2048 + k * 1024); } while (0)
#define PG8_LDB(dst, b, h) do { _Pragma("unroll") for (int n = 0; n < 2; ++n) _Pragma("unroll") for (int k = 0; k < 2; ++k) dst[n][k] = *(const PG8_LAS bf16x8*)(lds + PG8_SB(b, h) + boff + n * 2048 + k * 1024); } while (0)
#define PG8_MMA(ai, bj, At, Bt) do { __builtin_amdgcn_s_setprio(1); _Pragma("unroll") for (int m = 0; m < 4; ++m) _Pragma("unroll") for (int n = 0; n < 2; ++n) _Pragma("unroll") for (int k = 0; k < 2; ++k) \
        acc[ai][bj][m][n] = __builtin_amdgcn_mfma_f32_16x16x32_bf16(Bt[n][k], At[m][k], acc[ai][bj][m][n], 0, 0, 0); __builtin_amdgcn_s_setprio(0); } while (0)
#define PG8_WAIT_V(n) asm volatile("s_waitcnt vmcnt(" #n ")" ::: "memory")
#define PG8_WAIT_L(n) asm volatile("s_waitcnt lgkmcnt(" #n ")" ::: "memory")
#define PG8_BAR __builtin_amdgcn_s_barrier()
#define PG8_SCHED __builtin_amdgcn_sched_barrier(0)
    Unit cur, nxt; int ui = 0;
    if (!S.next(0, cur)) return;
    f32x4 acc[2][2][4][2];
#pragma unroll
    for (int a = 0; a < 2; ++a)
#pragma unroll
        for (int b = 0; b < 2; ++b)
#pragma unroll
            for (int m = 0; m < 4; ++m)
#pragma unroll
                for (int n = 0; n < 2; ++n) acc[a][b][m][n] = (f32x4){0.f, 0.f, 0.f, 0.f};
    bf16x8 At[4][2], B0[2][2], B1[2][2];
    const char* cA = (const char*)g.A + (size_t)cur.pm * tstep; const char* cB = (const char*)g.Bt + (size_t)cur.pn * tstep;
    S.a_ready(cur);
    if constexpr (SP2) {
        PG8_STAGE(PG8_SB(0, 0), cB, voffB); PG8_STAGE(PG8_SB(0, 1), cB + hstep, voffB); PG8_STAGE(PG8_SA(0, 0), cA, voffA); PG8_STAGE(PG8_SA(0, 1), cA + hstep, voffA);
        if (wr == 1) PG8_BAR;
        PG8_WAIT_V(2); PG8_BAR;
        PG8_STAGE(PG8_SB(1, 0), cB + kstep, voffB); PG8_STAGE(PG8_SA(1, 0), cA + kstep, voffA); PG8_STAGE(PG8_SB(1, 1), cB + hstep + kstep, voffB);
        PG8_WAIT_V(6); PG8_BAR;
    } else {
        PG8_STAGE(PG8_SB(0, 0), cB, voffB); PG8_STAGE(PG8_SA(0, 0), cA, voffA); PG8_STAGE(PG8_SB(0, 1), cB + hstep, voffB); PG8_STAGE(PG8_SA(0, 1), cA + hstep, voffA);
        if (wr == 1) PG8_BAR;
        PG8_WAIT_V(4); PG8_BAR;
        PG8_STAGE(PG8_SB(1, 0), cB + kstep, voffB); PG8_STAGE(PG8_SA(1, 0), cA + kstep, voffA); PG8_STAGE(PG8_SB(1, 1), cB + hstep + kstep, voffB);
        PG8_WAIT_V(6); PG8_BAR;
    }
    for (;;) {
        const bool has_next = S.next(ui + 1, nxt);
        const char* nA = has_next ? (const char*)g.A + (size_t)nxt.pm * tstep : cA; const char* nB = has_next ? (const char*)g.Bt + (size_t)nxt.pn * tstep : cB;
        for (int t = 0; t < nt; t += 2) {
            const bool last = (t == nt - 2);
            const char* a1 = cA + (size_t)(t + 1) * kstep;
            const char* a2 = last ? nA : cA + (size_t)(t + 2) * kstep; const char* b2 = last ? nB : cB + (size_t)(t + 2) * kstep;
            const char* a3 = a2 + kstep; const char* b3 = b2 + kstep;
            if (last && has_next) S.a_ready(nxt);
            if (t == nt - 4) E.prefetch(cur, lds, tid, wid);
            if constexpr (SP2) {
            PG8_LDB(B0, 0, 0); PG8_LDB(B1, 0, 1); PG8_SCHED; PG8_LDA(At, 0, 0); PG8_STAGE(PG8_SA(1, 1), a1 + hstep, voffA);
            PG8_WAIT_V(8); PG8_WAIT_L(0); PG8_BAR; PG8_MMA(0, 0, At, B0); PG8_MMA(0, 1, At, B1); PG8_BAR; PG8_SCHED;
            PG8_LDA(At, 0, 1); PG8_STAGE(PG8_SB(0, 0), b2, voffB); PG8_STAGE(PG8_SB(0, 1), b2 + hstep, voffB); PG8_STAGE(PG8_SA(0, 0), a2, voffA);
            PG8_WAIT_V(8); PG8_WAIT_L(0); PG8_BAR; PG8_MMA(1, 0, At, B0); PG8_MMA(1, 1, At, B1); PG8_BAR; PG8_SCHED;
            PG8_LDB(B0, 1, 0); PG8_LDB(B1, 1, 1); PG8_SCHED; PG8_LDA(At, 1, 0); PG8_STAGE(PG8_SA(0, 1), a2 + hstep, voffA);
            PG8_WAIT_V(8); PG8_WAIT_L(0); PG8_BAR; PG8_MMA(0, 0, At, B0); PG8_MMA(0, 1, At, B1); PG8_BAR; PG8_SCHED;
            PG8_LDA(At, 1, 1); PG8_STAGE(PG8_SB(1, 0), b3, voffB); PG8_STAGE(PG8_SB(1, 1), b3 + hstep, voffB); PG8_STAGE(PG8_SA(1, 0), a3, voffA);
            PG8_WAIT_V(8); PG8_WAIT_L(0); PG8_BAR; PG8_MMA(1, 0, At, B0); PG8_MMA(1, 1, At, B1); PG8_BAR; PG8_SCHED;
            } else {
            PG8_LDB(B0, 0, 0); PG8_SCHED; PG8_LDA(At, 0, 0); PG8_STAGE(PG8_SA(1, 1), a1 + hstep, voffA);
            PG8_WAIT_L(8); PG8_BAR; PG8_WAIT_L(0); PG8_MMA(0, 0, At, B0); PG8_BAR; PG8_SCHED;
            PG8_LDB(B1, 0, 1); PG8_STAGE(PG8_SB(0, 0), b2, voffB);
            PG8_BAR; PG8_WAIT_L(0); PG8_MMA(0, 1, At, B1); PG8_BAR;
            PG8_LDA(At, 0, 1); PG8_STAGE(PG8_SA(0, 0), a2, voffA);
            PG8_BAR; PG8_WAIT_L(0); PG8_MMA(1, 0, At, B0); PG8_BAR; PG8_SCHED;
            PG8_STAGE(PG8_SB(0, 1), b2 + hstep, voffB);
            PG8_WAIT_V(6); PG8_BAR; PG8_MMA(1, 1, At, B1); PG8_BAR;
            PG8_LDB(B0, 1, 0); PG8_SCHED; PG8_LDA(At, 1, 0); PG8_STAGE(PG8_SA(0, 1), a2 + hstep, voffA);
            PG8_WAIT_L(8); PG8_BAR; PG8_WAIT_L(0); PG8_MMA(0, 0, At, B0); PG8_BAR; PG8_SCHED;
            PG8_LDB(B1, 1, 1); PG8_STAGE(PG8_SB(1, 0), b3, voffB);
            PG8_BAR; PG8_WAIT_L(0); PG8_MMA(0, 1, At, B1); PG8_BAR;
            PG8_LDA(At, 1, 1); PG8_STAGE(PG8_SA(1, 0), a3, voffA);
            PG8_BAR; PG8_WAIT_L(0); PG8_MMA(1, 0, At, B0); PG8_BAR; PG8_SCHED;
            PG8_STAGE(PG8_SB(1, 1), b3 + hstep, voffB);
            PG8_WAIT_V(6); PG8_BAR; PG8_MMA(1, 1, At, B1); PG8_BAR;
            }
        }
        if constexpr (ALIGN_EPI) { if (wr == 0) PG8_BAR; }
        if constexpr (!Epi::AFTER_DRAIN) { E(acc, cur, wr, wc, fr, fq); S.done(cur); }
        if (!has_next) break;
#pragma unroll
        for (int a = 0; a < 2; ++a)
#pragma unroll
            for (int b = 0; b < 2; ++b)
#pragma unroll
                for (int m = 0; m < 4; ++m)
#pragma unroll
                    for (int n = 0; n < 2; ++n) acc[a][b][m][n] = (f32x4){0.f, 0.f, 0.f, 0.f};
        cur = nxt; cA = nA; cB = nB; ++ui;
        if constexpr (ALIGN_EPI) { if (wr == 1) PG8_BAR; }
    }
    PG8_WAIT_V(0);
    if constexpr (!ALIGN_EPI) { if (wr == 0) PG8_BAR; }
    PG8_BAR;
    if constexpr (Epi::AFTER_DRAIN) { E.fused(acc, cur, wr, wc, fr, fq, lds, wid, lane); S.done(cur); }
#undef PG8_SA
#undef PG8_SB
#undef PG8_STAGE
#undef PG8_LDA
#undef PG8_LDB
#undef PG8_MMA
#undef PG8_WAIT_V
#undef PG8_WAIT_L
#undef PG8_BAR
#undef PG8_SCHED
}
}

#define LAS __attribute__((address_space(3)))
typedef unsigned short bf16_t;
typedef short bf16x8 __attribute__((ext_vector_type(8)));
typedef short s16x4 __attribute__((ext_vector_type(4)));
typedef float f32x4 __attribute__((ext_vector_type(4)));
typedef unsigned u32x4 __attribute__((ext_vector_type(4)));
typedef unsigned u32x2 __attribute__((ext_vector_type(2)));

__device__ __forceinline__ float wave_sum(float v) {
#pragma unroll
    for (int o = 1; o < 64; o <<= 1) v += __shfl_xor(v, o);
    return v;
}
__device__ __forceinline__ unsigned pk2(float lo, float hi) { return pg8::cvt_pk_bf16(lo, hi); }
__device__ __forceinline__ float bflo(unsigned w) { return __uint_as_float(w << 16); }
__device__ __forceinline__ float bfhi(unsigned w) { return __uint_as_float(w & 0xffff0000u); }

constexpr size_t MiB = 1u << 20;
constexpr size_t WS_SSQ1 = 64 * 1024, WS_SSQ2 = 128 * 1024, WS_SSQ3 = 192 * 1024, WS_RSTDX = 256 * 1024;
constexpr size_t WS_LSE = 1 * MiB;
constexpr size_t WS_BT1 = 2 * MiB;
constexpr size_t WS_BT2 = 22 * MiB;
constexpr size_t WS_BT3 = 30 * MiB;
constexpr size_t WS_BT4 = 74 * MiB;
constexpr size_t WS_BT5 = 96 * MiB;
constexpr size_t WS_BT6 = 104 * MiB;
constexpr size_t WS_PB = 105 * MiB;
constexpr size_t WS_XB = 114 * MiB;
constexpr size_t WS_YMIX = 178 * MiB;
constexpr size_t WS_PROJ = 242 * MiB;
constexpr size_t WS_END = 418 * MiB;

constexpr int RING_BYTES = 131072;
constexpr int LUT_OFF = RING_BYTES;
constexpr int OSTG_OFF = RING_BYTES + 2048;
constexpr int LUTALL_OFF = OSTG_OFF + 8 * 2304;
constexpr int LDS_BYTES = 163840;

constexpr int MISC_OFF = RING_BYTES + 1024;
constexpr size_t WS_BAR = 0;

#define XB_TMO      128
#define XB_XCNT(j)  (256  + 64 * (j))
#define XB_XSUB(j)  (1280 + 64 * (j))
#define XB_XGEN(j)  (2304 + 64 * (j))
#define XB_TOP      3328
#define XB_TOPGEN   3392
#define XCD_BAR_WORDS 3456
#define XB_SPIN_CAP (1u << 18)

__device__ __forceinline__ unsigned xb_ld(unsigned* p)              { return __hip_atomic_load(p, __ATOMIC_RELAXED, __HIP_MEMORY_SCOPE_AGENT); }
__device__ __forceinline__ unsigned xb_add(unsigned* p, unsigned v) { return __hip_atomic_fetch_add(p, v, __ATOMIC_RELAXED, __HIP_MEMORY_SCOPE_AGENT); }
__device__ __forceinline__ unsigned xb_xcc_id() { return (unsigned)__builtin_amdgcn_s_getreg((3 << 11) | 20) & 0xFu; }
#define XB_SPIN(cond, bar) do { unsigned _sp = 0; while (cond) { __builtin_amdgcn_s_sleep(1); \
    if ((++_sp & 255u) == 0u) { if (xb_ld(&(bar)[XB_TMO])) break; if (_sp > XB_SPIN_CAP) { atomicAdd(&(bar)[XB_TMO], 1u); break; } } } } while (0)

struct XcdBarrier {
    unsigned* bar; unsigned x;
    volatile LAS unsigned* st;
};

__device__ __forceinline__ XcdBarrier xcd_barrier_post(unsigned* bar, volatile LAS unsigned* st) {
    XcdBarrier b; b.bar = bar; b.x = xb_xcc_id(); b.st = st;
    if (threadIdx.x == 0) (void)xb_add(&bar[XB_XCNT(b.x)], 1u);
    return b;
}
__device__ __forceinline__ void xcd_barrier_complete(unsigned* bar, unsigned x, unsigned& nloc, unsigned& nx) {
    const unsigned G = gridDim.x * gridDim.y * gridDim.z;
    unsigned sum, cnt, mine, sp = 0u;
    for (;;) {
        sum = 0u; cnt = 0u; mine = 0u;
#pragma unroll
        for (unsigned j = 0; j < 16; ++j) { const unsigned c = xb_ld(&bar[XB_XCNT(j)]); sum += c; cnt += (c > 0u) ? 1u : 0u; mine = (j == x) ? c : mine; }
        if (sum == G) break;
        __builtin_amdgcn_s_sleep(1);
        if ((++sp & 255u) == 0u) { if (xb_ld(&bar[XB_TMO])) break; if (sp > XB_SPIN_CAP) { atomicAdd(&bar[XB_TMO], 1u); break; } }
    }
    nloc = mine > 0u ? mine : 1u; nx = cnt > 0u ? cnt : 1u;
}

__device__ __forceinline__ void xcd_barrier(const XcdBarrier& b) {
    asm volatile("s_waitcnt vmcnt(0)" ::: "memory");
    __syncthreads();
    if (threadIdx.x == 0) {
        unsigned* bar = b.bar;
        __builtin_amdgcn_s_waitcnt(0);
        unsigned nloc = b.st[0], nx = b.st[1];
        if (nloc == 0u) { xcd_barrier_complete(bar, b.x, nloc, nx); b.st[0] = nloc; b.st[1] = nx; }
        const unsigned old = xb_add(&bar[XB_XSUB(b.x)], 1u);
        const unsigned gen = old / nloc;
        if (old + 1u == (gen + 1u) * nloc) {
            __builtin_amdgcn_fence(__ATOMIC_RELEASE, "agent");
            asm volatile("s_waitcnt vmcnt(0)" ::: "memory");
            const unsigned og = xb_add(&bar[XB_TOP], 1u);
            const unsigned tg = og / nx;
            if (og + 1u == (tg + 1u) * nx) xb_add(&bar[XB_TOPGEN], 1u);
            else XB_SPIN(xb_ld(&bar[XB_TOPGEN]) == tg, bar);
            __builtin_amdgcn_fence(__ATOMIC_ACQUIRE, "agent");
            xb_add(&bar[XB_XGEN(b.x)], 1u);
            asm volatile("s_waitcnt vmcnt(0)" ::: "memory");
        } else {
            XB_SPIN(xb_ld(&bar[XB_XGEN(b.x)]) == gen, bar);
            __builtin_amdgcn_fence(__ATOMIC_ACQUIRE, "agent");
            asm volatile("s_waitcnt vmcnt(0)" ::: "memory");
        }
    }
    __syncthreads();
}

__device__ __forceinline__ void transpose_item(const float* W, int N, const float* gain, bf16_t* WT, int ldk, int drow0, int k0, int n0, int lane) {
    const int nq = lane & 15, kg = lane >> 4;
    const float* src = W + (size_t)(k0 + 8 * kg) * N + n0 + 4 * nq;
    f32x4 v[2][8];
#pragma unroll
    for (int h = 0; h < 2; ++h)
#pragma unroll
        for (int j = 0; j < 8; ++j) v[h][j] = __builtin_nontemporal_load((const f32x4*)(src + (size_t)(32 * h + j) * N));
    if (gain) {
#pragma unroll
        for (int h = 0; h < 2; ++h) { const f32x4 g0 = *(const f32x4*)(gain + k0 + 32 * h + 8 * kg), g1 = *(const f32x4*)(gain + k0 + 32 * h + 8 * kg + 4);
#pragma unroll
            for (int j = 0; j < 4; ++j) { v[h][j] *= g0[j]; v[h][4 + j] *= g1[j]; } }
    }
#pragma unroll
    for (int h = 0; h < 2; ++h)
#pragma unroll
        for (int i = 0; i < 4; ++i) { u32x4 o; o.x = pk2(v[h][0][i], v[h][1][i]); o.y = pk2(v[h][2][i], v[h][3][i]); o.z = pk2(v[h][4][i], v[h][5][i]); o.w = pk2(v[h][6][i], v[h][7][i]);
            *(u32x4*)(WT + (size_t)(drow0 + 4 * nq + i) * ldk + k0 + 32 * h + 8 * kg) = o; }
}

struct Ptrs {
    const float *x, *p, *rel_bias, *g_mix, *w_in, *pool_w, *pool_scale, *w_out, *g_ffn, *w_gate, *w_up, *w_down, *g_ple, *w_pg, *w_pp, *g_final;
    float* out; unsigned char* ws;
};

__device__ __forceinline__ void prologue(const Ptrs& P, LAS unsigned char* lds, int gw, int NGW, int wid, int lane) {
    unsigned char* ws = P.ws;
    bf16_t* BT1 = (bf16_t*)(ws + WS_BT1); bf16_t* BT2 = (bf16_t*)(ws + WS_BT2); bf16_t* BT3 = (bf16_t*)(ws + WS_BT3);
    bf16_t* BT4 = (bf16_t*)(ws + WS_BT4); bf16_t* BT5 = (bf16_t*)(ws + WS_BT5); bf16_t* BT6 = (bf16_t*)(ws + WS_BT6);
    constexpr int I_IN = (DM / 64) * (NIN / 64);
    constexpr int I_OUT = ((DM - 512) / 64) * (DM / 64);
    constexpr int I_G = (DM / 64) * (DFF / 64);
    constexpr int I_DN = (DFF / 64) * (DM / 64);
    constexpr int I_PG = (DM / 64) * (DM / 64);
    constexpr int I_PP = (DPLE / 64) * (DM / 64);
    constexpr int NITEMS = I_IN + I_OUT + 2 * I_G + I_DN + I_PG + I_PP;
#define DEC(NB) const int nbh_ = (NB) / 8, blk_ = r >> 6, loc_ = r & 63, kb = (blk_ / nbh_) * 8 + (loc_ >> 3), n0 = 64 * ((blk_ % nbh_) * 8 + (loc_ & 7));
    for (int it = gw; it < NITEMS; it += NGW) {
        int r = it;
        if (r < I_IN) { DEC(NIN / 64) transpose_item(P.w_in, NIN, P.g_mix, BT1, DM, n0, 64 * kb, n0, lane); continue; } r -= I_IN;
        if (r < I_OUT) { DEC(DM / 64) transpose_item(P.w_out, DM, nullptr, BT2, DM, n0, 512 + 64 * kb, n0, lane); continue; } r -= I_OUT;
        if (r < I_G) { DEC(DFF / 64) transpose_item(P.w_gate, DFF, P.g_ffn, BT3, DM, (n0 >> 7) * 256 + (n0 & 127), 64 * kb, n0, lane); continue; } r -= I_G;
        if (r < I_G) { DEC(DFF / 64) transpose_item(P.w_up, DFF, P.g_ffn, BT3, DM, (n0 >> 7) * 256 + 128 + (n0 & 127), 64 * kb, n0, lane); continue; } r -= I_G;
        if (r < I_DN) { DEC(DM / 64) transpose_item(P.w_down, DM, nullptr, BT4, DFF, n0, 64 * kb, n0, lane); continue; } r -= I_DN;
        if (r < I_PG) { DEC(DM / 64) transpose_item(P.w_pg, DM, P.g_ple, BT5, DM, n0, 64 * kb, n0, lane); continue; } r -= I_PG;
        { const int nb = DM / 64, kb = r / nb, n0 = 64 * (r % nb); transpose_item(P.w_pp, DM, nullptr, BT6, DPLE, n0, 64 * kb, n0, lane); }
    }
    for (int it = gw; it < 1024; it += NGW) {
        const int kq = it >> 3, nc = it & 7, k4 = kq * 4, g = k4 >> 7, n = nc * 256 + lane * 4;
        f32x4 acc[4] = {{0.f, 0.f, 0.f, 0.f}, {0.f, 0.f, 0.f, 0.f}, {0.f, 0.f, 0.f, 0.f}, {0.f, 0.f, 0.f, 0.f}};
        const float* pw = P.pool_w + (size_t)k4 * 128;
        const float* ps = P.pool_scale + g * 128;
        const float* wo = P.w_out + (size_t)(g * 128) * DM + n;
#pragma unroll 4
        for (int d = 0; d < 128; ++d) {
            const f32x4 wv = *(const f32x4*)(wo + (size_t)d * DM); const float sc = ps[d];
#pragma unroll
            for (int cc = 0; cc < 4; ++cc) acc[cc] += (pw[cc * 128 + d] * sc) * wv;
        }
#pragma unroll
        for (int j = 0; j < 4; ++j) { u32x2 o; o.x = pk2(acc[0][j], acc[1][j]); o.y = pk2(acc[2][j], acc[3][j]); *(u32x2*)(BT2 + (size_t)(n + j) * DM + k4) = o; }
    }
    bf16_t* XB = (bf16_t*)(ws + WS_XB); float* rstdx = (float*)(ws + WS_RSTDX);
    for (int row = gw; row < MROWS; row += NGW) {
        const float* xr = P.x + (size_t)row * DM + lane * 8; f32x4 v[4][2]; float s = 0.f;
#pragma unroll
        for (int j = 0; j < 4; ++j) { v[j][0] = __builtin_nontemporal_load((const f32x4*)(xr + 512 * j)); v[j][1] = __builtin_nontemporal_load((const f32x4*)(xr + 512 * j + 4)); s += pg8::dot4(v[j][0]) + pg8::dot4(v[j][1]); }
        s = wave_sum(s);
        if (lane == 0) rstdx[row] = 1.0f / sqrtf(s * (1.0f / DM) + RMS_EPS);
        bf16_t* o = XB + (size_t)row * DM + lane * 8;
#pragma unroll
        for (int j = 0; j < 4; ++j) *(u32x4*)(o + 512 * j) = pg8::pack8(v[j][0], v[j][1]);
    }
    bf16_t* PB = (bf16_t*)(ws + WS_PB);
    for (int c = gw * 64 + lane; c < MROWS * DPLE / 8; c += NGW * 64) {
        const f32x4 a = __builtin_nontemporal_load((const f32x4*)(P.p + (size_t)c * 8)), b = __builtin_nontemporal_load((const f32x4*)(P.p + (size_t)c * 8 + 4));
        *(u32x4*)(PB + (size_t)c * 8) = pg8::pack8(a, b);
    }
    float* z = (float*)(ws + WS_SSQ1);
    for (int c = gw * 64 + lane; c < 3 * MROWS; c += NGW * 64) z[c] = 0.f;
}

__device__ __forceinline__ void up8(const u32x4 w, float (&f)[8]) { f[0] = bflo(w.x); f[1] = bfhi(w.x); f[2] = bflo(w.y); f[3] = bfhi(w.y); f[4] = bflo(w.z); f[5] = bfhi(w.z); f[6] = bflo(w.w); f[7] = bfhi(w.w); }
template <int W> __device__ __forceinline__ void pool_item_w(const bf16_t* upool, bf16_t* ymix, int tg, int gi, int lane) {
    const int rq = lane >> 4, oct = lane & 15;
    const int t0 = tg * 16 + rq * 4, pos0 = t0 & (SEQ - 1), col = gi * 128 + oct * 8;
    const bf16_t* u = upool + (size_t)t0 * 512 + col;
    u32x4 prev[W - 1], cur[4];
#pragma unroll
    for (int k = 1; k < W; ++k) { const bool ok = pos0 - k >= 0; prev[k - 1] = *(const u32x4*)(u - (size_t)(ok ? k : 0) * 512); }
#pragma unroll
    for (int i = 0; i < 4; ++i) cur[i] = *(const u32x4*)(u + (size_t)i * 512);
    float acc[8] = {0.f, 0.f, 0.f, 0.f, 0.f, 0.f, 0.f, 0.f}, f[8];
#pragma unroll
    for (int k = 1; k < W; ++k) { if (pos0 - k < 0) prev[k - 1] = (u32x4){0u, 0u, 0u, 0u}; up8(prev[k - 1], f);
#pragma unroll
        for (int e = 0; e < 8; ++e) acc[e] += f[e]; }
#pragma unroll
    for (int i = 0; i < 4; ++i) {
        float c[8]; up8(cur[i], c);
#pragma unroll
        for (int e = 0; e < 8; ++e) acc[e] += c[e];
        if (i > 0) { if (i >= W) up8(cur[i >= W ? i - W : 0], f); else up8(prev[(W - i - 1) >= 0 && (W - i - 1) < W - 1 ? W - i - 1 : 0], f);
#pragma unroll
            for (int e = 0; e < 8; ++e) acc[e] -= f[e]; }
        const int cnt = (pos0 + i + 1 < W) ? (pos0 + i + 1) : W; const float ic = 1.0f / (float)cnt;
        u32x4 o; o.x = pk2(acc[0] * ic - c[0], acc[1] * ic - c[1]); o.y = pk2(acc[2] * ic - c[2], acc[3] * ic - c[3]);
        o.z = pk2(acc[4] * ic - c[4], acc[5] * ic - c[5]); o.w = pk2(acc[6] * ic - c[6], acc[7] * ic - c[7]);
        *(u32x4*)(ymix + (size_t)(t0 + i) * DM + col) = o;
    }
}
__device__ __forceinline__ void pool_item(const bf16_t* upool, bf16_t* ymix, int item, int lane) {
    const int gi = item & 3, tg = item >> 2;
    if (gi == 0) pool_item_w<2>(upool, ymix, tg, gi, lane); else if (gi == 1) pool_item_w<4>(upool, ymix, tg, gi, lane);
    else if (gi == 2) pool_item_w<8>(upool, ymix, tg, gi, lane); else pool_item_w<16>(upool, ymix, tg, gi, lane);
}

__device__ const unsigned char T5_BUCKET[3][129] = {
{0,1,2,3,4,5,6,7,8,9,10,11,12,13,14,15,16,16,16,16,16,16,17,17,17,17,17,17,17,17,18,18,18,18,18,18,18,18,18,18,19,19,19,19,19,19,19,19,19,19,19,19,19,19,20,20,20,20,20,20,20,20,20,20,20,20,20,20,20,20,20,20,20,21,21,21,21,21,21,21,21,21,21,21,21,21,21,21,21,21,21,21,21,21,21,21,21,21,21,22,22,22,22,22,22,22,22,22,22,22,22,22,22,22,22,22,22,22,22,22,22,22,22,22,22,22,22,22,22},
{0,4,8,12,16,16,17,17,18,18,19,19,19,19,20,20,20,20,20,21,21,21,21,21,21,22,22,22,22,22,22,22,22,22,23,23,23,23,23,23,23,23,23,23,23,23,24,24,24,24,24,24,24,24,24,24,24,24,24,24,24,24,25,25,25,25,25,25,25,25,25,25,25,25,25,25,25,25,25,25,25,25,25,26,26,26,26,26,26,26,26,26,26,26,26,26,26,26,26,26,26,26,26,26,26,26,26,26,26,26,26,26,26,27,27,27,27,27,27,27,27,27,27,27,27,27,27,27,27},
{0,16,18,19,20,21,21,22,22,23,23,23,24,24,24,24,25,25,25,25,25,26,26,26,26,26,26,26,26,27,27,27,27,27,27,27,27,27,27,28,28,28,28,28,28,28,28,28,28,28,28,28,29,29,29,29,29,29,29,29,29,29,29,29,29,29,29,29,29,29,30,30,30,30,30,30,30,30,30,30,30,30,30,30,30,30,30,30,30,30,30,30,30,30,30,31,31,31,31,31,31,31,31,31,31,31,31,31,31,31,31,31,31,31,31,31,31,31,31,31,31,31,31,31,31,31,31,31,31}};

__device__ __forceinline__ s16x4 vtr(LAS const unsigned char* p) { typedef short v4i16_t __attribute__((ext_vector_type(4))); return __builtin_bit_cast(s16x4, __builtin_amdgcn_ds_read_tr16_b64_v4i16((LAS v4i16_t*)p)); }

struct AttnItem { int g, dsh, n, r, b, head; size_t subbase, rowbase; };
__device__ __forceinline__ AttnItem attn_decode(int item) {
    AttnItem a; a.g = item >> 9; const int idx = item & 511; a.dsh = 2 * a.g; const int nbsh = 6 - a.dsh, seq = idx >> nbsh;
    a.n = idx & ((1 << nbsh) - 1); a.r = seq & ((1 << a.dsh) - 1); const int bh = seq >> a.dsh; a.head = a.g * 4 + (bh & 3); a.b = bh >> 2;
    a.rowbase = (size_t)a.b * SEQ; a.subbase = a.rowbase + ((size_t)a.r << (13 - a.dsh)); return a;
}
__device__ __forceinline__ void glds16_asm(const void* gsrc, unsigned lds_dst) { unsigned keep;
    asm volatile("s_mov_b32 %0, m0\n\ts_mov_b32 m0, %2\n\ts_nop 0\n\tglobal_load_lds_dwordx4 %1, off\n\ts_mov_b32 m0, %0" : "=&s"(keep) : "v"(gsrc), "s"(lds_dst) : "memory"); }
template <bool ISV> __device__ __forceinline__ void attn_stage_half(LAS unsigned char* dst, const bf16_t* th, size_t gidx0, int wid, int lane) {
#pragma unroll
    for (int j = 0; j < 4; ++j) {
        const int piece = wid * 4 + j, key = piece * 4 + (lane >> 4), cp = lane & 15;
        const int ch = ISV ? ((((cp >> 1) ^ (key & 7)) << 1) | (cp & 1)) : (cp ^ (key & 15));
        glds16_asm(th + (gidx0 + key) * HD + ch * 8, (unsigned)__builtin_amdgcn_readfirstlane((int)(unsigned)(size_t)(dst + piece * 1024)));
    }
}
__device__ __forceinline__ void attn_phase(LAS unsigned char* lds, const bf16_t* qkv, bf16_t* ymix, float* lse, const float* rel_bias, int item0, int nitems) {
    const int tid = threadIdx.x, lane = tid & 63, wid = __builtin_amdgcn_readfirstlane(tid >> 6), fr = lane & 15, fq = lane >> 4;
    const int q0 = wid * 16;
    LAS unsigned char* KB = lds; LAS unsigned char* VB = lds + 65536;
    LAS float* lutall = (LAS float*)(lds + LUTALL_OFF);
    if (nitems <= 0) return;
    if (tid < 129) {
#pragma unroll
        for (int h = 0; h < NHEADS; ++h) lutall[h * 132 + tid] = rel_bias[(int)T5_BUCKET[h >> 2][tid] * NHEADS + h] * LOG2E;
    }
    bf16x8 qf[4];
    {
        const AttnItem a = attn_decode(item0);
        const bf16_t* kh = qkv + (size_t)(12 + a.head) * MROWS * HD; const bf16_t* vh = qkv + (size_t)(24 + a.head) * MROWS * HD; const bf16_t* qh = qkv + (size_t)a.head * MROWS * HD;
        const size_t cur = a.subbase + 128 * a.n, prv = a.n > 0 ? cur - 128 : cur;
        attn_stage_half<false>(KB, kh, cur, wid, lane); attn_stage_half<false>(KB + 32768, kh, prv, wid, lane);
        attn_stage_half<true>(VB, vh, cur, wid, lane); attn_stage_half<true>(VB + 32768, vh, prv, wid, lane);
        const bf16_t* qp = qh + (cur + q0 + fr) * HD + 8 * fq;
#pragma unroll
        for (int s = 0; s < 4; ++s) qf[s] = *(const bf16x8*)(qp + 32 * s);
    }
    for (int i = 0; i < nitems; ++i) {
        const AttnItem a = attn_decode(item0 + i);
        const int cs = i & 1;
        const bool has_next = i + 1 < nitems;
        AttnItem an = a; if (has_next) an = attn_decode(item0 + i + 1);
        asm volatile("s_waitcnt vmcnt(0) lgkmcnt(0)" ::: "memory");
        __builtin_amdgcn_s_barrier();
        asm volatile("" ::: "memory");
        f32x4 sc[9];
#pragma unroll
        for (int jt = 0; jt < 9; ++jt) {
            const int kt = q0 + 16 * jt, prow = ((((kt >> 7) ^ 1 ^ cs) & 1) << 7) | (kt & 127);
            f32x4 acc = {0.f, 0.f, 0.f, 0.f};
            LAS const unsigned char* kp = KB + (prow + fr) * 256;
#pragma unroll
            for (int s = 0; s < 4; ++s) { const bf16x8 kf = *(LAS const bf16x8*)(kp + (((4 * s + fq) ^ fr) << 4)); acc = __builtin_amdgcn_mfma_f32_16x16x32_bf16(kf, qf[s], acc, 0, 0, 0); }
            sc[jt] = acc;
        }
        asm volatile("s_waitcnt lgkmcnt(0)" ::: "memory");
        __builtin_amdgcn_s_barrier();
        asm volatile("" ::: "memory");
        if (has_next) {
            const bf16_t* qh = qkv + (size_t)an.head * MROWS * HD; const bf16_t* kh = qkv + (size_t)(12 + an.head) * MROWS * HD;
            const size_t cur = an.subbase + 128 * an.n;
            const bf16_t* qp = qh + (cur + q0 + fr) * HD + 8 * fq;
#pragma unroll
            for (int s = 0; s < 4; ++s) qf[s] = *(const bf16x8*)(qp + 32 * s);
            attn_stage_half<false>(KB + (cs ^ 1) * 32768, kh, cur, wid, lane);
        }
        LAS const float* lut = lutall + a.head * 132;
        float mx = -3.0e38f;
#pragma unroll
        for (int jt = 0; jt < 9; ++jt)
#pragma unroll
            for (int e = 0; e < 4; ++e) {
                const int off = 128 + fr - 16 * jt - 4 * fq - e, ki = q0 + 16 * jt + 4 * fq + e;
                const bool ok = (off >= 0) && (off <= 128) && (a.n > 0 || ki >= 128);
                const int oc = off < 0 ? 0 : (off > 128 ? 128 : off);
                const float v = ok ? sc[jt][e] + lut[oc] : -1.0e30f;
                sc[jt][e] = v; mx = fmaxf(mx, v);
            }
        mx = fmaxf(mx, __shfl_xor(mx, 16)); mx = fmaxf(mx, __shfl_xor(mx, 32));
        float den = 0.f;
#pragma unroll
        for (int jt = 0; jt < 9; ++jt)
#pragma unroll
            for (int e = 0; e < 4; ++e) { const float pv = __builtin_amdgcn_exp2f(sc[jt][e] - mx); sc[jt][e] = pv; den += pv; }
        den += __shfl_xor(den, 16); den += __shfl_xor(den, 32);
        bf16x8 pb[5];
#pragma unroll
        for (int ks = 0; ks < 5; ++ks) {
            u32x4 w; w.x = pk2(sc[2 * ks][0], sc[2 * ks][1]); w.y = pk2(sc[2 * ks][2], sc[2 * ks][3]);
            if (ks < 4) { w.z = pk2(sc[2 * ks + 1][0], sc[2 * ks + 1][1]); w.w = pk2(sc[2 * ks + 1][2], sc[2 * ks + 1][3]); } else { w.z = 0u; w.w = 0u; }
            pb[ks] = __builtin_bit_cast(bf16x8, w);
        }
        f32x4 o[8];
#pragma unroll
        for (int db = 0; db < 8; ++db) o[db] = (f32x4){0.f, 0.f, 0.f, 0.f};
#pragma unroll
        for (int ks = 0; ks < 5; ++ks) {
            const int ktA = q0 + 32 * ks, ktB = (ks < 4) ? ktA + 16 : ktA;
            const int prA = ((((ktA >> 7) ^ 1 ^ cs) & 1) << 7) | (ktA & 127), prB = ((((ktB >> 7) ^ 1 ^ cs) & 1) << 7) | (ktB & 127);
            const int rl = 4 * fq + (fr >> 2);
            LAS const unsigned char* va = VB + (prA + rl) * 256 + 8 * (fr & 3);
            LAS const unsigned char* vb = VB + (prB + rl) * 256 + 8 * (fr & 3);
#pragma unroll
            for (int db = 0; db < 8; ++db) {
                const s16x4 lo = vtr(va + ((db ^ (rl & 7)) << 5)), hi = vtr(vb + ((db ^ (rl & 7)) << 5));
                const bf16x8 vf = {lo[0], lo[1], lo[2], lo[3], hi[0], hi[1], hi[2], hi[3]};
                o[db] = __builtin_amdgcn_mfma_f32_16x16x32_bf16(vf, pb[ks], o[db], 0, 0, 0);
            }
        }
        asm volatile("s_waitcnt lgkmcnt(0)" ::: "memory");
        __builtin_amdgcn_s_barrier();
        asm volatile("" ::: "memory");
        if (has_next) {
            const bf16_t* vh = qkv + (size_t)(24 + an.head) * MROWS * HD;
            attn_stage_half<true>(VB + (cs ^ 1) * 32768, vh, an.subbase + 128 * an.n, wid, lane);
        }
        const float inv = 1.0f / den;
        LAS unsigned char* stg = lds + OSTG_OFF + wid * 2304;
        const size_t qrow_w = a.rowbase + ((size_t)(128 * a.n + q0) << a.dsh) + a.r;
#pragma unroll
        for (int hh = 0; hh < 2; ++hh) {
#pragma unroll
            for (int d4 = 0; d4 < 4; ++d4) { const int db = 4 * hh + d4; u32x2 w; w.x = pk2(o[db][0] * inv, o[db][1] * inv); w.y = pk2(o[db][2] * inv, o[db][3] * inv);
                *(LAS u32x2*)(stg + fr * 144 + d4 * 32 + 8 * fq) = w; }
            asm volatile("s_waitcnt lgkmcnt(0)" ::: "memory");
#pragma unroll
            for (int p = 0; p < 2; ++p) { const int rw = (lane >> 3) + 8 * p, ch = lane & 7;
                const u32x4 v = *(LAS const u32x4*)(stg + rw * 144 + ch * 16);
                *(u32x4*)(ymix + (qrow_w + ((size_t)rw << a.dsh)) * DM + 512 + a.head * HD + 64 * hh + 8 * ch) = v; }
            asm volatile("s_waitcnt lgkmcnt(0)" ::: "memory");
        }
        if (fq == 0) lse[(qrow_w + ((size_t)fr << a.dsh)) * NHEADS + a.head] = (mx + __builtin_amdgcn_logf(den)) * LN2;
    }
    asm volatile("s_waitcnt vmcnt(0) lgkmcnt(0)" ::: "memory");
    __builtin_amdgcn_s_barrier();
    asm volatile("" ::: "memory");
}

__device__ __forceinline__ void mix_row(bf16_t* ymix, const float* lse, int row, int lane) {
    const int hs = lane >> 4; const float* l = lse + (size_t)row * NHEADS + hs;
    const float l0 = l[0], l1 = l[4], l2 = l[8], m = fmaxf(l0, fmaxf(l1, l2));
    const float e0 = __expf(l0 - m), e1 = __expf(l1 - m), e2 = __expf(l2 - m), inv = 1.0f / (e0 + e1 + e2);
    const float al[3] = {e0 * inv, e1 * inv, e2 * inv};
    bf16_t* y = ymix + (size_t)row * DM + 512 + lane * 8;
#pragma unroll
    for (int j = 0; j < 3; ++j) { const u32x4 w = *(const u32x4*)(y + 512 * j); const float a = al[j]; u32x4 o;
        o.x = pk2(bflo(w.x) * a, bfhi(w.x) * a); o.y = pk2(bflo(w.y) * a, bfhi(w.y) * a); o.z = pk2(bflo(w.z) * a, bfhi(w.z) * a); o.w = pk2(bflo(w.w) * a, bfhi(w.w) * a);
        *(u32x4*)(y + 512 * j) = o; }
}
__device__ __forceinline__ void final_row(float* out, const bf16_t* h3, const float* ssq, const float* gfin, int row, int lane) {
    const float r = 1.0f / sqrtf(ssq[row] * (1.0f / DM) + RMS_EPS);
    float* o = out + (size_t)row * DM + lane * 8; const bf16_t* hh = h3 + (size_t)row * DM + lane * 8;
#pragma unroll
    for (int j = 0; j < 4; ++j) { const u32x4 w = __builtin_nontemporal_load((const u32x4*)(hh + 512 * j)); const f32x4 g0 = *(const f32x4*)(gfin + lane * 8 + 512 * j), g1 = *(const f32x4*)(gfin + lane * 8 + 512 * j + 4);
        const f32x4 v0 = {bflo(w.x), bfhi(w.x), bflo(w.y), bfhi(w.y)}, v1 = {bflo(w.z), bfhi(w.z), bflo(w.w), bfhi(w.w)};
        __builtin_nontemporal_store(v0 * r * g0, (f32x4*)(o + 512 * j)); __builtin_nontemporal_store(v1 * r * g1, (f32x4*)(o + 512 * j + 4)); }
}


struct Args { const float* in[16]; float* out; unsigned char* ws; };

#define PG8_ALIGN true
#define PG8_SP2 true

__global__ void __launch_bounds__(512, 2) hymba_fwd(Args args) {
    extern __shared__ __attribute__((aligned(16))) unsigned char lds_raw[];
    LAS unsigned char* lds = (LAS unsigned char*)lds_raw;
    cg::grid_group grid = cg::this_grid();
    const int tid = threadIdx.x, lane = tid & 63, wid = __builtin_amdgcn_readfirstlane(tid >> 6);
    const int G = gridDim.x, bx = blockIdx.x;
    const int vcu = (G % 8 == 0) ? (bx % 8) * (G / 8) + bx / 8 : bx;
    const int gw = vcu * 8 + wid, NGW = G * 8;
    Ptrs P;
    P.x = args.in[0]; P.p = args.in[1]; P.rel_bias = args.in[2]; P.g_mix = args.in[3]; P.w_in = args.in[4]; P.pool_w = args.in[5]; P.pool_scale = args.in[6]; P.w_out = args.in[7];
    P.g_ffn = args.in[8]; P.w_gate = args.in[9]; P.w_up = args.in[10]; P.w_down = args.in[11]; P.g_ple = args.in[12]; P.w_pg = args.in[13]; P.w_pp = args.in[14]; P.g_final = args.in[15];
    P.out = args.out; P.ws = args.ws;
    unsigned char* ws = args.ws;
    bf16_t* BT1 = (bf16_t*)(ws + WS_BT1); bf16_t* BT2 = (bf16_t*)(ws + WS_BT2); bf16_t* BT3 = (bf16_t*)(ws + WS_BT3);
    bf16_t* BT4 = (bf16_t*)(ws + WS_BT4); bf16_t* BT5 = (bf16_t*)(ws + WS_BT5); bf16_t* BT6 = (bf16_t*)(ws + WS_BT6);
    bf16_t* PB = (bf16_t*)(ws + WS_PB); bf16_t* XB = (bf16_t*)(ws + WS_XB); bf16_t* YMIX = (bf16_t*)(ws + WS_YMIX); bf16_t* PROJ = (bf16_t*)(ws + WS_PROJ);
    float* SSQ1 = (float*)(ws + WS_SSQ1); float* SSQ2 = (float*)(ws + WS_SSQ2); float* SSQ3 = (float*)(ws + WS_SSQ3); float* RSTDX = (float*)(ws + WS_RSTDX); float* LSE = (float*)(ws + WS_LSE);

    volatile LAS unsigned* MISC = (volatile LAS unsigned*)(lds + MISC_OFF);
    if (tid < 2) MISC[tid] = 0u;
    if (bx == 0) for (int u = tid; u < XCD_BAR_WORDS; u += 512) ((unsigned*)(ws + WS_BAR))[u] = 0u;
    prologue(P, lds, gw, NGW, wid, lane);
    grid.sync();
    const XcdBarrier bar = xcd_barrier_post((unsigned*)(ws + WS_BAR), MISC);

    { pg8::Gemm g{XB, BT1, MROWS, NIN, DM}; pg8::StaticOrder S; S.init(MROWS, NIN, G, bx);
      pg8::EpiProj E{PROJ, PROJ + (size_t)MROWS * 512, RSTDX, QSCALE, 13, MROWS};
      pg8::gemm_phase<pg8::EpiProj, pg8::StaticOrder, PG8_ALIGN, PG8_SP2>(lds, g, S, E); }
    xcd_barrier(bar);

    { const int per = (1536 + G - 1) / G;
      { const int i0 = vcu * per, cnt = (i0 + per <= 1536) ? per : (1536 - i0); attn_phase(lds, PROJ + (size_t)MROWS * 512, YMIX, LSE, P.rel_bias, i0, cnt); }
      for (int it = gw; it < 4096; it += NGW) pool_item(PROJ, YMIX, it, lane); }
    xcd_barrier(bar);

    for (int row = gw; row < MROWS; row += NGW) mix_row(YMIX, LSE, row, lane);
    xcd_barrier(bar);

    { pg8::Gemm g{YMIX, BT2, MROWS, DM, DM}; pg8::StaticOrder S; S.init(MROWS, DM, G, bx);
      pg8::EpiRes E{XB, XB, SSQ1, DM};
      pg8::gemm_phase<pg8::EpiRes, pg8::StaticOrder, PG8_ALIGN, PG8_SP2>(lds, g, S, E); }
    xcd_barrier(bar);

    { pg8::Gemm g{XB, BT3, MROWS, 2 * DFF, DM}; pg8::StaticOrder S; S.init(MROWS, 2 * DFF, G, bx);
      pg8::EpiSwiGLU E{PROJ, DFF, SSQ1, 1.0f / DM, RMS_EPS};
      pg8::gemm_phase<pg8::EpiSwiGLU, pg8::StaticOrder, PG8_ALIGN, PG8_SP2>(lds, g, S, E); }
    { int kpp = DPLE; asm volatile("" : "+s"(kpp));
      pg8::Gemm g{PB, BT6, MROWS, DM, kpp}; pg8::StaticOrder S; S.init(MROWS, DM, G, bx);
      pg8::EpiPlain E{YMIX, DM};
      pg8::gemm_phase<pg8::EpiPlain, pg8::StaticOrder, PG8_ALIGN, PG8_SP2>(lds, g, S, E); }
    xcd_barrier(bar);

    { pg8::Gemm g{PROJ, BT4, MROWS, DM, DFF}; pg8::StaticOrder S; S.init(MROWS, DM, G, bx);
      pg8::EpiRes E{XB, XB, SSQ2, DM};
      pg8::gemm_phase<pg8::EpiRes, pg8::StaticOrder, PG8_ALIGN, PG8_SP2>(lds, g, S, E); }
    xcd_barrier(bar);

    { pg8::Gemm g{XB, BT5, MROWS, DM, DM}; pg8::StaticOrder S; S.init(MROWS, DM, G, bx);
      pg8::EpiPle E{XB, YMIX, PROJ, SSQ2, SSQ3, DM, 1.0f / DM, RMS_EPS};
      pg8::gemm_phase<pg8::EpiPle, pg8::StaticOrder, PG8_ALIGN, PG8_SP2>(lds, g, S, E); }
    xcd_barrier(bar);

    for (int row = gw; row < MROWS; row += NGW) final_row(P.out, PROJ, SSQ3, P.g_final, row, lane);
}

extern "C" void kernel_launch(void* const* d_in, const int* in_sizes, int n_in, void* d_out, int out_size, void* d_ws, size_t ws_size, hipStream_t stream) {
    static int grid = 0;
    if (grid == 0) {
        if (n_in != 16 || in_sizes[0] != MROWS * DM || out_size != MROWS * DM || ws_size < WS_END) {
            fprintf(stderr, "kernel_launch: unexpected shapes (n_in %d, in0 %d, out %d, ws %zu); nothing launched\n", n_in, n_in > 0 ? in_sizes[0] : -1, out_size, ws_size); grid = -1; return; }
        int dev = 0, cus = 0, per_cu = 0;
        if (hipGetDevice(&dev) != hipSuccess || hipDeviceGetAttribute(&cus, hipDeviceAttributeMultiprocessorCount, dev) != hipSuccess) { fprintf(stderr, "kernel_launch: device query failed\n"); grid = -1; return; }
        if (hipFuncSetAttribute((const void*)hymba_fwd, hipFuncAttributeMaxDynamicSharedMemorySize, LDS_BYTES) != hipSuccess) { fprintf(stderr, "kernel_launch: hipFuncSetAttribute failed\n"); grid = -1; return; }
        if (hipOccupancyMaxActiveBlocksPerMultiprocessor(&per_cu, (const void*)hymba_fwd, 512, LDS_BYTES) != hipSuccess || per_cu < 1) { fprintf(stderr, "kernel_launch: occupancy query says %d blocks per CU\n", per_cu); (void)hipGetLastError(); per_cu = 1; }
        if (per_cu > 1) per_cu = 1;
        grid = cus * per_cu;
    }
    if (grid < 0) return;
    Args a{};
    for (int i = 0; i < 16; ++i) a.in[i] = (const float*)d_in[i];
    a.out = (float*)d_out; a.ws = (unsigned char*)d_ws;
    void* kargs[] = {&a};
    hipError_t e = hipLaunchCooperativeKernel((const void*)hymba_fwd, dim3(grid), dim3(512), kargs, LDS_BYTES, stream);
    if (e != hipSuccess) fprintf(stderr, "kernel_launch: cooperative launch failed: %s (grid %d)\n", hipGetErrorString(e), grid);
}
```

```cpp
#include <hip/hip_runtime.h>
#include <hip/hip_cooperative_groups.h>
#include <cstdio>
#include <cstdint>
namespace cg = cooperative_groups;

constexpr int BATCH = 2, SEQ = 8192, DM = 2048, MROWS = BATCH * SEQ, NIN = 5120, DFF = 5632, DPLE = 256, NHEADS = 12, HD = 128;
constexpr float RMS_EPS = 1e-6f;
constexpr float QSCALE = 0.08838834764831845f * 1.4426950408889634f;
constexpr float LOG2E = 1.4426950408889634f, LN2 = 0.6931471805599453f;
namespace pg8 {
#define PG8_LAS __attribute__((address_space(3)))
typedef unsigned short bf16_t;
typedef short bf16x8 __attribute__((ext_vector_type(8)));
typedef float f32x4 __attribute__((ext_vector_type(4)));
typedef unsigned u32x4 __attribute__((ext_vector_type(4)));
constexpr int BM = 256, BK = 64, HALF = 128, HTB = HALF * BK * 2  , STAGE_BYTES = 8 * HTB, NXCD = 8, WGM = 8;

__host__ __device__ __forceinline__ int lds_byte(int r, int c) { const int st = (r >> 4) * 2 + (c >> 5), rr = r & 15, cc = c & 31, ob = rr * 64 + cc * 2; return st * 1024 + (ob ^ (((ob >> 9) & 1) << 5)); }
__host__ __device__ __forceinline__ void stage_rc(int b, int& R, int& C) { const int st = b / 1024, sb = b % 1024, swz = sb ^ (((sb >> 9) & 1) << 5); R = (st >> 1) * 16 + swz / 64; C = (st & 1) * 32 + (swz % 64) / 2; }
__host__ __device__ __forceinline__ int perm32(int rho) { const int n = rho >> 4, i = rho & 15; return 8 * (i >> 2) + 4 * n + (i & 3); }

struct Unit { int pm, pn; };
struct Gemm { const bf16_t* A; const bf16_t* Bt; int M, N, K; };

struct StaticOrder {
    int nM, nN, nwg, G, c;
    __host__ __device__ void init(int M, int N, int G_, int c_) { nM = M / BM; nN = N / BM; nwg = nM * nN; G = G_; c = c_; }
    __host__ __device__ bool next(int i, Unit& u) const {
        const long L = (long)i * G + c; if (L >= nwg) return false;
        int wgid = (int)L; { const int q = nwg / NXCD, r = nwg % NXCD, xcd = wgid % NXCD, off = wgid / NXCD; wgid = (xcd < r ? xcd * (q + 1) : r * (q + 1) + (xcd - r) * q) + off; }
        const int nig = WGM * nN, gid = wgid / nig, fm = gid * WGM, gsz = (nM - fm) < WGM ? (nM - fm) : WGM;
        u.pm = fm + ((wgid % nig) % gsz); u.pn = (wgid % nig) / gsz; return true;
    }
    __device__ __forceinline__ void a_ready(const Unit&) const {}
    __device__ __forceinline__ void done(const Unit&) const {}
};

__device__ __forceinline__ unsigned cvt_pk_bf16(float lo, float hi) { unsigned r; asm volatile("v_cvt_pk_bf16_f32 %0, %1, %2" : "=v"(r) : "v"(lo), "v"(hi)); return r; }
__device__ __forceinline__ u32x4 pack8(const f32x4 v0, const f32x4 v1) { u32x4 w; w.x = cvt_pk_bf16(v0[0], v0[1]); w.y = cvt_pk_bf16(v0[2], v0[3]); w.z = cvt_pk_bf16(v1[0], v1[1]); w.w = cvt_pk_bf16(v1[2], v1[3]); return w; }
__device__ __forceinline__ float bf_lo(unsigned w) { return __uint_as_float(w << 16); }
__device__ __forceinline__ float bf_hi(unsigned w) { return __uint_as_float(w & 0xffff0000u); }
__device__ __forceinline__ float dot4(const f32x4 v) { return (v[0] * v[0] + v[1] * v[1]) + (v[2] * v[2] + v[3] * v[3]); }

constexpr int PF_SCRATCH = 131072 + 2048;
__device__ __forceinline__ void prefetch_tile(const bf16_t* base, int ldc, const Unit& u, PG8_LAS unsigned char* lds, int tid, int wid, int slot) {
#pragma unroll
    for (int j = 0; j < 2; ++j) { const int line = tid + 512 * j, row = line >> 2, seg = line & 3;
        __builtin_amdgcn_global_load_lds((const unsigned*)(base + (size_t)(u.pm * BM + row) * ldc + u.pn * BM + seg * 64), (PG8_LAS unsigned*)(lds + PF_SCRATCH + (slot * 16 + wid * 2 + j) * 256), 4, 0, 0); }
}
struct EpiProj {
    static constexpr bool PERM = true, AFTER_DRAIN = false;
    __device__ __forceinline__ void prefetch(const Unit&, PG8_LAS unsigned char*, int, int) const {}
    bf16_t* POOL; bf16_t* QKV; const float* rstd; float qscale; int seq_sh, mrows;
    __device__ __forceinline__ void operator()(const f32x4 (&acc)[2][2][4][2], const Unit& u, int wr, int wc, int fr, int fq) const {
        const int row0 = u.pm * BM + wr * 64 + fr, cin = wc * 32 + 8 * fq;
        if (u.pn < 2) {
#pragma unroll
            for (int ai = 0; ai < 2; ++ai)
#pragma unroll
                for (int m = 0; m < 4; ++m) { const int row = row0 + ai * HALF + m * 16; const float s = rstd[row]; bf16_t* rowp = POOL + (size_t)row * 512 + u.pn * BM + cin;
#pragma unroll
                    for (int bj = 0; bj < 2; ++bj) *(u32x4*)(rowp + bj * HALF) = pack8(acc[ai][bj][m][0] * s, acc[ai][bj][m][1] * s); }
        } else {
            const int tq = (u.pn - 2) / 6, hp = (u.pn - 2) - 6 * tq;
            const float qs = tq == 0 ? qscale : 1.0f;
#pragma unroll
            for (int ai = 0; ai < 2; ++ai)
#pragma unroll
                for (int m = 0; m < 4; ++m) { const int row = row0 + ai * HALF + m * 16; const float s = rstd[row] * qs;
                    const int b = row >> seq_sh, t = row & ((1 << seq_sh) - 1);
#pragma unroll
                    for (int bj = 0; bj < 2; ++bj) { const int head = 2 * hp + bj, dsh = 2 * (head >> 2);
                        const int idx = (b << seq_sh) + ((t & ((1 << dsh) - 1)) << (seq_sh - dsh)) + (t >> dsh);
                        *(u32x4*)(QKV + ((size_t)(tq * 12 + head) * mrows + idx) * 128 + cin) = pack8(acc[ai][bj][m][0] * s, acc[ai][bj][m][1] * s); } }
        }
    }
};
struct EpiPlain {
    static constexpr bool PERM = true, AFTER_DRAIN = false;
    __device__ __forceinline__ void prefetch(const Unit&, PG8_LAS unsigned char*, int, int) const {}
    bf16_t* O; int ldc;
    __device__ __forceinline__ void operator()(const f32x4 (&acc)[2][2][4][2], const Unit& u, int wr, int wc, int fr, int fq) const {
        const int row0 = u.pm * BM + wr * 64 + fr, col0 = u.pn * BM + wc * 32 + 8 * fq;
#pragma unroll
        for (int ai = 0; ai < 2; ++ai)
#pragma unroll
            for (int m = 0; m < 4; ++m) { bf16_t* rowp = O + (size_t)(row0 + ai * HALF + m * 16) * ldc + col0;
#pragma unroll
                for (int bj = 0; bj < 2; ++bj) *(u32x4*)(rowp + bj * HALF) = pack8(acc[ai][bj][m][0], acc[ai][bj][m][1]); }
    }
};
struct EpiRes {
    static constexpr bool PERM = true, AFTER_DRAIN = false;
    const bf16_t* base; bf16_t* ob; float* ssq; int ldc;
    __device__ __forceinline__ void prefetch(const Unit& u, PG8_LAS unsigned char* lds, int tid, int wid) const { prefetch_tile(base, ldc, u, lds, tid, wid, 0); }
    __device__ __forceinline__ void operator()(const f32x4 (&acc)[2][2][4][2], const Unit& u, int wr, int wc, int fr, int fq) const {
        const int row0 = u.pm * BM + wr * 64 + fr, col0 = u.pn * BM + wc * 32 + 8 * fq;
#pragma unroll
        for (int ai = 0; ai < 2; ++ai)
#pragma unroll
            for (int m = 0; m < 4; ++m) { const int row = row0 + ai * HALF + m * 16; const size_t off = (size_t)row * ldc + col0; float s = 0.f;
#pragma unroll
                for (int bj = 0; bj < 2; ++bj) {
                    const u32x4 bw = *(const u32x4*)(base + off + bj * HALF);
                    const f32x4 v0 = (f32x4){bf_lo(bw.x), bf_hi(bw.x), bf_lo(bw.y), bf_hi(bw.y)} + acc[ai][bj][m][0], v1 = (f32x4){bf_lo(bw.z), bf_hi(bw.z), bf_lo(bw.w), bf_hi(bw.w)} + acc[ai][bj][m][1];
                    *(u32x4*)(ob + off + bj * HALF) = pack8(v0, v1);
                    s += dot4(v0) + dot4(v1); }
                s += __shfl_xor(s, 16); s += __shfl_xor(s, 32);
                if (fq == 0) atomicAdd(ssq + row, s); }
    }
};
struct EpiSwiGLU {
    static constexpr bool PERM = true, AFTER_DRAIN = false;
    __device__ __forceinline__ void prefetch(const Unit&, PG8_LAS unsigned char*, int, int) const {}
    bf16_t* O; int ldc; const float* ssq; float inv_d, eps;
    __device__ __forceinline__ void operator()(const f32x4 (&acc)[2][2][4][2], const Unit& u, int wr, int wc, int fr, int fq) const {
        const int row0 = u.pm * BM + wr * 64 + fr, col0 = u.pn * HALF + wc * 32 + 8 * fq;
#pragma unroll
        for (int ai = 0; ai < 2; ++ai)
#pragma unroll
            for (int m = 0; m < 4; ++m) { const int row = row0 + ai * HALF + m * 16; const float r = __builtin_amdgcn_rsqf(ssq[row] * inv_d + eps);
                f32x4 o[2];
#pragma unroll
                for (int n = 0; n < 2; ++n)
#pragma unroll
                    for (int j = 0; j < 4; ++j) { const float g = acc[ai][0][m][n][j] * r, up = acc[ai][1][m][n][j] * r;
                        o[n][j] = g * up * __builtin_amdgcn_rcpf(1.0f + __builtin_amdgcn_exp2f(-1.4426950408889634f * g)); }
                __builtin_nontemporal_store(pack8(o[0], o[1]), (u32x4*)(O + (size_t)row * ldc + col0)); }
    }
};
struct EpiPle {
    static constexpr bool PERM = true, AFTER_DRAIN = false;
    const bf16_t* h; const bf16_t* pp; bf16_t* o; const float* ssq2; float* ssq3; int ldc; float inv_d, eps;
    __device__ __forceinline__ void prefetch(const Unit& u, PG8_LAS unsigned char* lds, int tid, int wid) const {}
    __device__ __forceinline__ void operator()(const f32x4 (&acc)[2][2][4][2], const Unit& u, int wr, int wc, int fr, int fq) const {
        const int row0 = u.pm * BM + wr * 64 + fr, col0 = u.pn * BM + wc * 32 + 8 * fq;
#pragma unroll
        for (int ai = 0; ai < 2; ++ai)
#pragma unroll
            for (int m = 0; m < 4; ++m) { const int row = row0 + ai * HALF + m * 16; const size_t off = (size_t)row * ldc + col0; float s = 0.f;
                const float r = __builtin_amdgcn_rsqf(ssq2[row] * inv_d + eps);
#pragma unroll
                for (int bj = 0; bj < 2; ++bj) {
                    const u32x4 pw = *(const u32x4*)(pp + off + bj * HALF), hw = *(const u32x4*)(h + off + bj * HALF);
                    f32x4 v0 = {bf_lo(hw.x), bf_hi(hw.x), bf_lo(hw.y), bf_hi(hw.y)}, v1 = {bf_lo(hw.z), bf_hi(hw.z), bf_lo(hw.w), bf_hi(hw.w)};
                    const f32x4 p0 = {bf_lo(pw.x), bf_hi(pw.x), bf_lo(pw.y), bf_hi(pw.y)}, p1 = {bf_lo(pw.z), bf_hi(pw.z), bf_lo(pw.w), bf_hi(pw.w)};
#pragma unroll
                    for (int j = 0; j < 4; ++j) {
                        v0[j] += p0[j] * __builtin_amdgcn_rcpf(1.0f + __builtin_amdgcn_exp2f(-1.4426950408889634f * r * acc[ai][bj][m][0][j]));
                        v1[j] += p1[j] * __builtin_amdgcn_rcpf(1.0f + __builtin_amdgcn_exp2f(-1.4426950408889634f * r * acc[ai][bj][m][1][j])); }
                    *(u32x4*)(o + off + bj * HALF) = pack8(v0, v1);
                    s += dot4(v0) + dot4(v1); }
                s += __shfl_xor(s, 16); s += __shfl_xor(s, 32);
                if (fq == 0) atomicAdd(ssq3 + row, s); }
    }
};

template <class Epi, class Sched, bool ALIGN_EPI = false, bool SP2 = false>
__device__ __forceinline__ void gemm_phase(PG8_LAS unsigned char* lds, const Gemm g, const Sched& S, const Epi& E) {
    int tid_ = threadIdx.x; asm volatile("" : "+v"(tid_));
    const int tid = tid_, wid = __builtin_amdgcn_readfirstlane(tid >> 6), lane = tid & 63, wr = wid >> 2, wc = wid & 3, fr = lane & 15, fq = lane >> 4;
    const int K = g.K, nt = K / BK;
    unsigned voffA[2], voffB[2];
#pragma unroll
    for (int i = 0; i < 2; ++i) { int R, C; stage_rc(tid * 16 + i * 8192, R, C); const int Rb = Epi::PERM ? ((R & ~31) + perm32(R & 31)) : R;
        voffA[i] = (unsigned)(R * K + C) * 2u; voffB[i] = (unsigned)(Rb * K + C) * 2u; }
    const size_t kstep = (size_t)(BK * 2);
    const size_t hstep = (size_t)HALF * K * 2;
    const size_t tstep = 2 * hstep;
    const unsigned ldsw = (unsigned)wid * 1024u;
    const int aoff = lds_byte(wr * 64 + fr, fq * 8), boff = lds_byte(wc * 32 + fr, fq * 8);
#define PG8_SA(b, h) (((b) * 2 + (h)) * HTB)
#define PG8_SB(b, h) ((4 + (b) * 2 + (h)) * HTB)
#define PG8_STAGE(bufoff, gbase, voff) do { _Pragma("unroll") for (int _i = 0; _i < 2; ++_i) \
        __builtin_amdgcn_global_load_lds((const unsigned*)((const char*)(gbase) + (voff)[_i]), (PG8_LAS unsigned*)(lds + (bufoff) + ldsw + _i * 8192), 16, 0, 0); } while (0)
#define PG8_LDA(dst, b, h) do { _Pragma("unroll") for (int m = 0; m < 4; ++m) _Pragma("unroll") for (int k = 0; k < 2; ++k) dst[m][k] = *(const PG8_LAS bf16x8*)(lds + PG8_SA(b, h) + aoff + m * 2048 + k * 1024); } while (0)
#define PG8_LDB(dst, b, h) do { _Pragma("unroll") for (int n = 0; n < 2; ++n) _Pragma("unroll") for (int k = 0; k < 2; ++k) dst[n][k] = *(const PG8_LAS bf16x8*)(lds + PG8_SB(b, h) + boff + n * 2048 + k * 1024); } while (0)
#define PG8_MMA(ai, bj, At, Bt) do { __builtin_amdgcn_s_setprio(1); _Pragma("unroll") for (int m = 0; m < 4; ++m) _Pragma("unroll") for (int n = 0; n < 2; ++n) _Pragma("unroll") for (int k = 0; k < 2; ++k) \
        acc[ai][bj][m][n] = __builtin_amdgcn_mfma_f32_16x16x32_bf16(Bt[n][k], At[m][k], acc[ai][bj][m][n], 0, 0, 0); __builtin_amdgcn_s_setprio(0); } while (0)
#define PG8_WAIT_V(n) asm volatile("s_waitcnt vmcnt(" #n ")" ::: "memory")
#define PG8_WAIT_L(n) asm volatile("s_waitcnt lgkmcnt(" #n ")" ::: "memory")
#define PG8_BAR __builtin_amdgcn_s_barrier()
#define PG8_SCHED __builtin_amdgcn_sched_barrier(0)
    Unit cur, nxt; int ui = 0;
    if (!S.next(0, cur)) return;
    f32x4 acc[2][2][4][2];
#pragma unroll
    for (int a = 0; a < 2; ++a)
#pragma unroll
        for (int b = 0; b < 2; ++b)
#pragma unroll
            for (int m = 0; m < 4; ++m)
#pragma unroll
                for (int n = 0; n < 2; ++n) acc[a][b][m][n] = (f32x4){0.f, 0.f, 0.f, 0.f};
    bf16x8 At[4][2], B0[2][2], B1[2][2];
    const char* cA = (const char*)g.A + (size_t)cur.pm * tstep; const char* cB = (const char*)g.Bt + (size_t)cur.pn * tstep;
    S.a_ready(cur);
    if constexpr (SP2) {
        PG8_STAGE(PG8_SB(0, 0), cB, voffB); PG8_STAGE(PG8_SB(0, 1), cB + hstep, voffB); PG8_STAGE(PG8_SA(0, 0), cA, voffA); PG8_STAGE(PG8_SA(0, 1), cA + hstep, voffA);
        if (wr == 1) PG8_BAR;
        PG8_WAIT_V(2); PG8_BAR;
        PG8_STAGE(PG8_SB(1, 0), cB + kstep, voffB); PG8_STAGE(PG8_SA(1, 0), cA + kstep, voffA); PG8_STAGE(PG8_SB(1, 1), cB + hstep + kstep, voffB);
        PG8_WAIT_V(6); PG8_BAR;
    } else {
        PG8_STAGE(PG8_SB(0, 0), cB, voffB); PG8_STAGE(PG8_SA(0, 0), cA, voffA); PG8_STAGE(PG8_SB(0, 1), cB + hstep, voffB); PG8_STAGE(PG8_SA(0, 1), cA + hstep, voffA);
        if (wr == 1) PG8_BAR;
        PG8_WAIT_V(4); PG8_BAR;
        PG8_STAGE(PG8_SB(1, 0), cB + kstep, voffB); PG8_STAGE(PG8_SA(1, 0), cA + kstep, voffA); PG8_STAGE(PG8_SB(1, 1), cB + hstep + kstep, voffB);
        PG8_WAIT_V(6); PG8_BAR;
    }
    for (;;) {
        const bool has_next = S.next(ui + 1, nxt);
        const char* nA = has_next ? (const char*)g.A + (size_t)nxt.pm * tstep : cA; const char* nB = has_next ? (const char*)g.Bt + (size_t)nxt.pn * tstep : cB;
        for (int t = 0; t < nt; t += 2) {
            const bool last = (t == nt - 2);
            const char* a1 = cA + (size_t)(t + 1) * kstep;
            const char* a2 = last ? nA : cA + (size_t)(t + 2) * kstep; const char* b2 = last ? nB : cB + (size_t)(t + 2) * kstep;
            const char* a3 = a2 + kstep; const char* b3 = b2 + kstep;
            if (last && has_next) S.a_ready(nxt);
            if (t == nt - 4) E.prefetch(cur, lds, tid, wid);
            if constexpr (SP2) {
            PG8_LDB(B0, 0, 0); PG8_LDB(B1, 0, 1); PG8_SCHED; PG8_LDA(At, 0, 0); PG8_STAGE(PG8_SA(1, 1), a1 + hstep, voffA);
            PG8_WAIT_V(8); PG8_WAIT_L(0); PG8_BAR; PG8_MMA(0, 0, At, B0); PG8_MMA(0, 1, At, B1); PG8_BAR; PG8_SCHED;
            PG8_LDA(At, 0, 1); PG8_STAGE(PG8_SB(0, 0), b2, voffB); PG8_STAGE(PG8_SB(0, 1), b2 + hstep, voffB); PG8_STAGE(PG8_SA(0, 0), a2, voffA);
            PG8_WAIT_V(8); PG8_WAIT_L(0); PG8_BAR; PG8_MMA(1, 0, At, B0); PG8_MMA(1, 1, At, B1); PG8_BAR; PG8_SCHED;
            PG8_LDB(B0, 1, 0); PG8_LDB(B1, 1, 1); PG8_SCHED; PG8_LDA(At, 1, 0); PG8_STAGE(PG8_SA(0, 1), a2 + hstep, voffA);
            PG8_WAIT_V(8); PG8_WAIT_L(0); PG8_BAR; PG8_MMA(0, 0, At, B0); PG8_MMA(0, 1, At, B1); PG8_BAR; PG8_SCHED;
            PG8_LDA(At, 1, 1); PG8_STAGE(PG8_SB(1, 0), b3, voffB); PG8_STAGE(PG8_SB(1, 1), b3 + hstep, voffB); PG8_STAGE(PG8_SA(1, 0), a3, voffA);
            PG8_WAIT_V(8); PG8_WAIT_L(0); PG8_BAR; PG8_MMA(1, 0, At, B0); PG8_MMA(1, 1, At, B1); PG8_BAR; PG8_SCHED;
            } else {
            PG8_LDB(B0, 0, 0); PG8_SCHED; PG8_LDA(At, 0, 0); PG8_STAGE(PG8_SA(1, 1), a1 + hstep, voffA);
            PG8_WAIT_L(8); PG8_BAR; PG8_WAIT_L(0); PG8_MMA(0, 0, At, B0); PG8_BAR; PG8_SCHED;
            PG8_LDB(B1, 0, 1); PG8_STAGE(PG8_SB(0, 0), b2, voffB);
            PG8_BAR; PG8_WAIT_L(0); PG8_MMA(0, 1, At, B1); PG8_BAR;
            PG8_LDA(At, 0, 1); PG8_STAGE(PG8_SA(0, 0), a2, voffA);
            PG8_BAR; PG8_WAIT_L(0); PG8_MMA(1, 0, At, B0); PG8_BAR; PG8_SCHED;
            PG8_STAGE(PG8_SB(0, 1), b2 + hstep, voffB);
            PG8_WAIT_V(6); PG8_BAR; PG8_MMA(1, 1, At, B1); PG8_BAR;
            PG8_LDB(B0, 1, 0); PG8_SCHED; PG8_LDA(At, 1, 0); PG8_STAGE(PG8_SA(0, 1), a2 + hstep, voffA);
            PG8_WAIT_L(8); PG8_BAR; PG8_WAIT_L(0); PG8_MMA(0, 0, At, B0); PG8_BAR; PG8_SCHED;
            PG8_LDB(B1, 1, 1); PG8_STAGE(PG8_SB(1, 0), b3, voffB);
            PG8_BAR; PG8_WAIT_L(0); PG8_MMA(0, 1, At, B1); PG8_BAR;
            PG8_LDA(At, 1, 1); PG8_STAGE(PG8_SA(1, 0), a3, voffA);
            PG8_BAR; PG8_WAIT_L(0); PG8_MMA(1, 0, At, B0); PG8_BAR; PG8_SCHED;
            PG8_STAGE(PG8_SB(1, 1), b3 + hstep, voffB);
            PG8_WAIT_V(6); PG8_BAR; PG8_MMA(1, 1, At, B1); PG8_BAR;
            }
        }
        if constexpr (ALIGN_EPI) { if (wr == 0) PG8_BAR; }
        if constexpr (!Epi::AFTER_DRAIN) { E(acc, cur, wr, wc, fr, fq); S.done(cur); }
        if (!has_next) break;
#pragma unroll
        for (int a = 0; a < 2; ++a)
#pragma unroll
            for (int b = 0; b < 2; ++b)
#pragma unroll
                for (int m = 0; m < 4; ++m)
#pragma unroll
                    for (int n = 0; n < 2; ++n) acc[a][b][m][n] = (f32x4){0.f, 0.f, 0.f, 0.f};
        cur = nxt; cA = nA; cB = nB; ++ui;
        if constexpr (ALIGN_EPI) { if (wr == 1) PG8_BAR; }
    }
    PG8_WAIT_V(0);
    if constexpr (!ALIGN_EPI) { if (wr == 0) PG8_BAR; }
    PG8_BAR;
    if constexpr (Epi::AFTER_DRAIN) { E.fused(acc, cur, wr, wc, fr, fq, lds, wid, lane); S.done(cur); }
#undef PG8_SA
#undef PG8_SB
#undef PG8_STAGE
#undef PG8_LDA
#undef PG8_LDB
#undef PG8_MMA
#undef PG8_WAIT_V
#undef PG8_WAIT_L
#undef PG8_BAR
#undef PG8_SCHED
}
}

#define LAS __attribute__((address_space(3)))
typedef unsigned short bf16_t;
typedef short bf16x8 __attribute__((ext_vector_type(8)));
typedef short s16x4 __attribute__((ext_vector_type(4)));
typedef float f32x4 __attribute__((ext_vector_type(4)));
typedef unsigned u32x4 __attribute__((ext_vector_type(4)));
typedef unsigned u32x2 __attribute__((ext_vector_type(2)));

__device__ __forceinline__ float wave_sum(float v) {
#pragma unroll
    for (int o = 1; o < 64; o <<= 1) v += __shfl_xor(v, o);
    return v;
}
__device__ __forceinline__ unsigned pk2(float lo, float hi) { return pg8::cvt_pk_bf16(lo, hi); }
__device__ __forceinline__ float bflo(unsigned w) { return __uint_as_float(w << 16); }
__device__ __forceinline__ float bfhi(unsigned w) { return __uint_as_float(w & 0xffff0000u); }

constexpr size_t MiB = 1u << 20;
constexpr size_t WS_SSQ1 = 64 * 1024, WS_SSQ2 = 128 * 1024, WS_SSQ3 = 192 * 1024, WS_RSTDX = 256 * 1024;
constexpr size_t WS_LSE = 1 * MiB;
constexpr size_t WS_BT1 = 2 * MiB;
constexpr size_t WS_BT2 = 22 * MiB;
constexpr size_t WS_BT3 = 30 * MiB;
constexpr size_t WS_BT4 = 74 * MiB;
constexpr size_t WS_BT5 = 96 * MiB;
constexpr size_t WS_BT6 = 104 * MiB;
constexpr size_t WS_PB = 105 * MiB;
constexpr size_t WS_XB = 114 * MiB;
constexpr size_t WS_YMIX = 178 * MiB;
constexpr size_t WS_PROJ = 242 * MiB;
constexpr size_t WS_END = 418 * MiB;

constexpr int RING_BYTES = 131072;
constexpr int LUT_OFF = RING_BYTES;
constexpr int OSTG_OFF = RING_BYTES + 2048;
constexpr int LUTALL_OFF = OSTG_OFF + 8 * 2304;
constexpr int LDS_BYTES = 163840;

constexpr int MISC_OFF = RING_BYTES + 1024;
constexpr size_t WS_BAR = 0;

#define XB_TMO      128
#define XB_XCNT(j)  (256  + 64 * (j))
#define XB_XSUB(j)  (1280 + 64 * (j))
#define XB_XGEN(j)  (2304 + 64 * (j))
#define XB_TOP      3328
#define XB_TOPGEN   3392
#define XCD_BAR_WORDS 3456
#define XB_SPIN_CAP (1u << 18)

__device__ __forceinline__ unsigned xb_ld(unsigned* p)              { return __hip_atomic_load(p, __ATOMIC_RELAXED, __HIP_MEMORY_SCOPE_AGENT); }
__device__ __forceinline__ unsigned xb_add(unsigned* p, unsigned v) { return __hip_atomic_fetch_add(p, v, __ATOMIC_RELAXED, __HIP_MEMORY_SCOPE_AGENT); }
__device__ __forceinline__ unsigned xb_xcc_id() { return (unsigned)__builtin_amdgcn_s_getreg((3 << 11) | 20) & 0xFu; }
#define XB_SPIN(cond, bar) do { unsigned _sp = 0; while (cond) { __builtin_amdgcn_s_sleep(1); \
    if ((++_sp & 255u) == 0u) { if (xb_ld(&(bar)[XB_TMO])) break; if (_sp > XB_SPIN_CAP) { atomicAdd(&(bar)[XB_TMO], 1u); break; } } } } while (0)

struct XcdBarrier {
    unsigned* bar; unsigned x;
    volatile LAS unsigned* st;
};

__device__ __forceinline__ XcdBarrier xcd_barrier_post(unsigned* bar, volatile LAS unsigned* st) {
    XcdBarrier b; b.bar = bar; b.x = xb_xcc_id(); b.st = st;
    if (threadIdx.x == 0) (void)xb_add(&bar[XB_XCNT(b.x)], 1u);
    return b;
}
__device__ __forceinline__ void xcd_barrier_complete(unsigned* bar, unsigned x, unsigned& nloc, unsigned& nx) {
    const unsigned G = gridDim.x * gridDim.y * gridDim.z;
    unsigned sum, cnt, mine, sp = 0u;
    for (;;) {
        sum = 0u; cnt = 0u; mine = 0u;
#pragma unroll
        for (unsigned j = 0; j < 16; ++j) { const unsigned c = xb_ld(&bar[XB_XCNT(j)]); sum += c; cnt += (c > 0u) ? 1u : 0u; mine = (j == x) ? c : mine; }
        if (sum == G) break;
        __builtin_amdgcn_s_sleep(1);
        if ((++sp & 255u) == 0u) { if (xb_ld(&bar[XB_TMO])) break; if (sp > XB_SPIN_CAP) { atomicAdd(&bar[XB_TMO], 1u); break; } }
    }
    nloc = mine > 0u ? mine : 1u; nx = cnt > 0u ? cnt : 1u;
}

__device__ __forceinline__ void xcd_barrier(const XcdBarrier& b) {
    asm volatile("s_waitcnt vmcnt(0)" ::: "memory");
    __syncthreads();
    if (threadIdx.x == 0) {
        unsigned* bar = b.bar;
        __builtin_amdgcn_s_waitcnt(0);
        unsigned nloc = b.st[0], nx = b.st[1];
        if (nloc == 0u) { xcd_barrier_complete(bar, b.x, nloc, nx); b.st[0] = nloc; b.st[1] = nx; }
        const unsigned old = xb_add(&bar[XB_XSUB(b.x)], 1u);
        const unsigned gen = old / nloc;
        if (old + 1u == (gen + 1u) * nloc) {
            __builtin_amdgcn_fence(__ATOMIC_RELEASE, "agent");
            asm volatile("s_waitcnt vmcnt(0)" ::: "memory");
            const unsigned og = xb_add(&bar[XB_TOP], 1u);
            const unsigned tg = og / nx;
            if (og + 1u == (tg + 1u) * nx) xb_add(&bar[XB_TOPGEN], 1u);
            else XB_SPIN(xb_ld(&bar[XB_TOPGEN]) == tg, bar);
            __builtin_amdgcn_fence(__ATOMIC_ACQUIRE, "agent");
            xb_add(&bar[XB_XGEN(b.x)], 1u);
            asm volatile("s_waitcnt vmcnt(0)" ::: "memory");
        } else {
            XB_SPIN(xb_ld(&bar[XB_XGEN(b.x)]) == gen, bar);
            __builtin_amdgcn_fence(__ATOMIC_ACQUIRE, "agent");
            asm volatile("s_waitcnt vmcnt(0)" ::: "memory");
        }
    }
    __syncthreads();
}

__device__ __forceinline__ void transpose_item(const float* W, int N, const float* gain, bf16_t* WT, int ldk, int drow0, int k0, int n0, int lane) {
    const int nq = lane & 15, kg = lane >> 4;
    const float* src = W + (size_t)(k0 + 8 * kg) * N + n0 + 4 * nq;
    f32x4 v[2][8];
#pragma unroll
    for (int h = 0; h < 2; ++h)
#pragma unroll
        for (int j = 0; j < 8; ++j) v[h][j] = __builtin_nontemporal_load((const f32x4*)(src + (size_t)(32 * h + j) * N));
    if (gain) {
#pragma unroll
        for (int h = 0; h < 2; ++h) { const f32x4 g0 = *(const f32x4*)(gain + k0 + 32 * h + 8 * kg), g1 = *(const f32x4*)(gain + k0 + 32 * h + 8 * kg + 4);
#pragma unroll
            for (int j = 0; j < 4; ++j) { v[h][j] *= g0[j]; v[h][4 + j] *= g1[j]; } }
    }
#pragma unroll
    for (int h = 0; h < 2; ++h)
#pragma unroll
        for (int i = 0; i < 4; ++i) { u32x4 o; o.x = pk2(v[h][0][i], v[h][1][i]); o.y = pk2(v[h][2][i], v[h][3][i]); o.z = pk2(v[h][4][i], v[h][5][i]); o.w = pk2(v[h][6][i], v[h][7][i]);
            *(u32x4*)(WT + (size_t)(drow0 + 4 * nq + i) * ldk + k0 + 32 * h + 8 * kg) = o; }
}

struct Ptrs {
    const float *x, *p, *rel_bias, *g_mix, *w_in, *pool_w, *pool_scale, *w_out, *g_ffn, *w_gate, *w_up, *w_down, *g_ple, *w_pg, *w_pp, *g_final;
    float* out; unsigned char* ws;
};

__device__ __forceinline__ void prologue(const Ptrs& P, LAS unsigned char* lds, int gw, int NGW, int wid, int lane) {
    unsigned char* ws = P.ws;
    bf16_t* BT1 = (bf16_t*)(ws + WS_BT1); bf16_t* BT2 = (bf16_t*)(ws + WS_BT2); bf16_t* BT3 = (bf16_t*)(ws + WS_BT3);
    bf16_t* BT4 = (bf16_t*)(ws + WS_BT4); bf16_t* BT5 = (bf16_t*)(ws + WS_BT5); bf16_t* BT6 = (bf16_t*)(ws + WS_BT6);
    constexpr int I_IN = (DM / 64) * (NIN / 64);
    constexpr int I_OUT = ((DM - 512) / 64) * (DM / 64);
    constexpr int I_G = (DM / 64) * (DFF / 64);
    constexpr int I_DN = (DFF / 64) * (DM / 64);
    constexpr int I_PG = (DM / 64) * (DM / 64);
    constexpr int I_PP = (DPLE / 64) * (DM / 64);
    constexpr int NITEMS = I_IN + I_OUT + 2 * I_G + I_DN + I_PG + I_PP;
#define DEC(NB) const int nbh_ = (NB) / 8, blk_ = r >> 6, loc_ = r & 63, kb = (blk_ / nbh_) * 8 + (loc_ >> 3), n0 = 64 * ((blk_ % nbh_) * 8 + (loc_ & 7));
    for (int it = gw; it < NITEMS; it += NGW) {
        int r = it;
        if (r < I_IN) { DEC(NIN / 64) transpose_item(P.w_in, NIN, P.g_mix, BT1, DM, n0, 64 * kb, n0, lane); continue; } r -= I_IN;
        if (r < I_OUT) { DEC(DM / 64) transpose_item(P.w_out, DM, nullptr, BT2, DM, n0, 512 + 64 * kb, n0, lane); continue; } r -= I_OUT;
        if (r < I_G) { DEC(DFF / 64) transpose_item(P.w_gate, DFF, P.g_ffn, BT3, DM, (n0 >> 7) * 256 + (n0 & 127), 64 * kb, n0, lane); continue; } r -= I_G;
        if (r < I_G) { DEC(DFF / 64) transpose_item(P.w_up, DFF, P.g_ffn, BT3, DM, (n0 >> 7) * 256 + 128 + (n0 & 127), 64 * kb, n0, lane); continue; } r -= I_G;
        if (r < I_DN) { DEC(DM / 64) transpose_item(P.w_down, DM, nullptr, BT4, DFF, n0, 64 * kb, n0, lane); continue; } r -= I_DN;
        if (r < I_PG) { DEC(DM / 64) transpose_item(P.w_pg, DM, P.g_ple, BT5, DM, n0, 64 * kb, n0, lane); continue; } r -= I_PG;
        { const int nb = DM / 64, kb = r / nb, n0 = 64 * (r % nb); transpose_item(P.w_pp, DM, nullptr, BT6, DPLE, n0, 64 * kb, n0, lane); }
    }
    for (int it = gw; it < 1024; it += NGW) {
        const int kq = it >> 3, nc = it & 7, k4 = kq * 4, g = k4 >> 7, n = nc * 256 + lane * 4;
        f32x4 acc[4] = {{0.f, 0.f, 0.f, 0.f}, {0.f, 0.f, 0.f, 0.f}, {0.f, 0.f, 0.f, 0.f}, {0.f, 0.f, 0.f, 0.f}};
        const float* pw = P.pool_w + (size_t)k4 * 128;
        const float* ps = P.pool_scale + g * 128;
        const float* wo = P.w_out + (size_t)(g * 128) * DM + n;
#pragma unroll 4
        for (int d = 0; d < 128; ++d) {
            const f32x4 wv = *(const f32x4*)(wo + (size_t)d * DM); const float sc = ps[d];
#pragma unroll
            for (int cc = 0; cc < 4; ++cc) acc[cc] += (pw[cc * 128 + d] * sc) * wv;
        }
#pragma unroll
        for (int j = 0; j < 4; ++j) { u32x2 o; o.x = pk2(acc[0][j], acc[1][j]); o.y = pk2(acc[2][j], acc[3][j]); *(u32x2*)(BT2 + (size_t)(n + j) * DM + k4) = o; }
    }
    bf16_t* XB = (bf16_t*)(ws + WS_XB); float* rstdx = (float*)(ws + WS_RSTDX);
    for (int row = gw; row < MROWS; row += NGW) {
        const float* xr = P.x + (size_t)row * DM + lane * 8; f32x4 v[4][2]; float s = 0.f;
#pragma unroll
        for (int j = 0; j < 4; ++j) { v[j][0] = __builtin_nontemporal_load((const f32x4*)(xr + 512 * j)); v[j][1] = __builtin_nontemporal_load((const f32x4*)(xr + 512 * j + 4)); s += pg8::dot4(v[j][0]) + pg8::dot4(v[j][1]); }
        s = wave_sum(s);
        if (lane == 0) rstdx[row] = 1.0f / sqrtf(s * (1.0f / DM) + RMS_EPS);
        bf16_t* o = XB + (size_t)row * DM + lane * 8;
#pragma unroll
        for (int j = 0; j < 4; ++j) *(u32x4*)(o + 512 * j) = pg8::pack8(v[j][0], v[j][1]);
    }
    bf16_t* PB = (bf16_t*)(ws + WS_PB);
    for (int c = gw * 64 + lane; c < MROWS * DPLE / 8; c += NGW * 64) {
        const f32x4 a = __builtin_nontemporal_load((const f32x4*)(P.p + (size_t)c * 8)), b = __builtin_nontemporal_load((const f32x4*)(P.p + (size_t)c * 8 + 4));
        *(u32x4*)(PB + (size_t)c * 8) = pg8::pack8(a, b);
    }
    float* z = (float*)(ws + WS_SSQ1);
    for (int c = gw * 64 + lane; c < 3 * MROWS; c += NGW * 64) z[c] = 0.f;
}

__device__ __forceinline__ void up8(const u32x4 w, float (&f)[8]) { f[0] = bflo(w.x); f[1] = bfhi(w.x); f[2] = bflo(w.y); f[3] = bfhi(w.y); f[4] = bflo(w.z); f[5] = bfhi(w.z); f[6] = bflo(w.w); f[7] = bfhi(w.w); }
template <int W> __device__ __forceinline__ void pool_item_w(const bf16_t* upool, bf16_t* ymix, int tg, int gi, int lane) {
    const int rq = lane >> 4, oct = lane & 15;
    const int t0 = tg * 16 + rq * 4, pos0 = t0 & (SEQ - 1), col = gi * 128 + oct * 8;
    const bf16_t* u = upool + (size_t)t0 * 512 + col;
    u32x4 prev[W - 1], cur[4];
#pragma unroll
    for (int k = 1; k < W; ++k) { const bool ok = pos0 - k >= 0; prev[k - 1] = *(const u32x4*)(u - (size_t)(ok ? k : 0) * 512); }
#pragma unroll
    for (int i = 0; i < 4; ++i) cur[i] = *(const u32x4*)(u + (size_t)i * 512);
    float acc[8] = {0.f, 0.f, 0.f, 0.f, 0.f, 0.f, 0.f, 0.f}, f[8];
#pragma unroll
    for (int k = 1; k < W; ++k) { if (pos0 - k < 0) prev[k - 1] = (u32x4){0u, 0u, 0u, 0u}; up8(prev[k - 1], f);
#pragma unroll
        for (int e = 0; e < 8; ++e) acc[e] += f[e]; }
#pragma unroll
    for (int i = 0; i < 4; ++i) {
        float c[8]; up8(cur[i], c);
#pragma unroll
        for (int e = 0; e < 8; ++e) acc[e] += c[e];
        if (i > 0) { if (i >= W) up8(cur[i >= W ? i - W : 0], f); else up8(prev[(W - i - 1) >= 0 && (W - i - 1) < W - 1 ? W - i - 1 : 0], f);
#pragma unroll
            for (int e = 0; e < 8; ++e) acc[e] -= f[e]; }
        const int cnt = (pos0 + i + 1 < W) ? (pos0 + i + 1) : W; const float ic = 1.0f / (float)cnt;
        u32x4 o; o.x = pk2(acc[0] * ic - c[0], acc[1] * ic - c[1]); o.y = pk2(acc[2] * ic - c[2], acc[3] * ic - c[3]);
        o.z = pk2(acc[4] * ic - c[4], acc[5] * ic - c[5]); o.w = pk2(acc[6] * ic - c[6], acc[7] * ic - c[7]);
        *(u32x4*)(ymix + (size_t)(t0 + i) * DM + col) = o;
    }
}
__device__ __forceinline__ void pool_item(const bf16_t* upool, bf16_t* ymix, int item, int lane) {
    const int gi = item & 3, tg = item >> 2;
    if (gi == 0) pool_item_w<2>(upool, ymix, tg, gi, lane); else if (gi == 1) pool_item_w<4>(upool, ymix, tg, gi, lane);
    else if (gi == 2) pool_item_w<8>(upool, ymix, tg, gi, lane); else pool_item_w<16>(upool, ymix, tg, gi, lane);
}

__device__ const unsigned char T5_BUCKET[3][129] = {
{0,1,2,3,4,5,6,7,8,9,10,11,12,13,14,15,16,16,16,16,16,16,17,17,17,17,17,17,17,17,18,18,18,18,18,18,18,18,18,18,19,19,19,19,19,19,19,19,19,19,19,19,19,19,20,20,20,20,20,20,20,20,20,20,20,20,20,20,20,20,20,20,20,21,21,21,21,21,21,21,21,21,21,21,21,21,21,21,21,21,21,21,21,21,21,21,21,21,21,22,22,22,22,22,22,22,22,22,22,22,22,22,22,22,22,22,22,22,22,22,22,22,22,22,22,22,22,22,22},
{0,4,8,12,16,16,17,17,18,18,19,19,19,19,20,20,20,20,20,21,21,21,21,21,21,22,22,22,22,22,22,22,22,22,23,23,23,23,23,23,23,23,23,23,23,23,24,24,24,24,24,24,24,24,24,24,24,24,24,24,24,24,25,25,25,25,25,25,25,25,25,25,25,25,25,25,25,25,25,25,25,25,25,26,26,26,26,26,26,26,26,26,26,26,26,26,26,26,26,26,26,26,26,26,26,26,26,26,26,26,26,26,26,27,27,27,27,27,27,27,27,27,27,27,27,27,27,27,27},
{0,16,18,19,20,21,21,22,22,23,23,23,24,24,24,24,25,25,25,25,25,26,26,26,26,26,26,26,26,27,27,27,27,27,27,27,27,27,27,28,28,28,28,28,28,28,28,28,28,28,28,28,29,29,29,29,29,29,29,29,29,29,29,29,29,29,29,29,29,29,30,30,30,30,30,30,30,30,30,30,30,30,30,30,30,30,30,30,30,30,30,30,30,30,30,31,31,31,31,31,31,31,31,31,31,31,31,31,31,31,31,31,31,31,31,31,31,31,31,31,31,31,31,31,31,31,31,31,31}};

__device__ __forceinline__ s16x4 vtr(LAS const unsigned char* p) { typedef short v4i16_t __attribute__((ext_vector_type(4))); return __builtin_bit_cast(s16x4, __builtin_amdgcn_ds_read_tr16_b64_v4i16((LAS v4i16_t*)p)); }

struct AttnItem { int g, dsh, n, r, b, head; size_t subbase, rowbase; };
__device__ __forceinline__ AttnItem attn_decode(int item) {
    AttnItem a; a.g = item >> 9; const int idx = item & 511; a.dsh = 2 * a.g; const int nbsh = 6 - a.dsh, seq = idx >> nbsh;
    a.n = idx & ((1 << nbsh) - 1); a.r = seq & ((1 << a.dsh) - 1); const int bh = seq >> a.dsh; a.head = a.g * 4 + (bh & 3); a.b = bh >> 2;
    a.rowbase = (size_t)a.b * SEQ; a.subbase = a.rowbase + ((size_t)a.r << (13 - a.dsh)); return a;
}
__device__ __forceinline__ void glds16_asm(const void* gsrc, unsigned lds_dst) { unsigned keep;
    asm volatile("s_mov_b32 %0, m0\n\ts_mov_b32 m0, %2\n\ts_nop 0\n\tglobal_load_lds_dwordx4 %1, off\n\ts_mov_b32 m0, %0" : "=&s"(keep) : "v"(gsrc), "s"(lds_dst) : "memory"); }
template <bool ISV> __device__ __forceinline__ void attn_stage_half(LAS unsigned char* dst, const bf16_t* th, size_t gidx0, int wid, int lane) {
#pragma unroll
    for (int j = 0; j < 4; ++j) {
        const int piece = wid * 4 + j, key = piece * 4 + (lane >> 4), cp = lane & 15;
        const int ch = ISV ? ((((cp >> 1) ^ (key & 7)) << 1) | (cp & 1)) : (cp ^ (key & 15));
        glds16_asm(th + (gidx0 + key) * HD + ch * 8, (unsigned)__builtin_amdgcn_readfirstlane((int)(unsigned)(size_t)(dst + piece * 1024)));
    }
}
__device__ __forceinline__ void attn_phase(LAS unsigned char* lds, const bf16_t* qkv, bf16_t* ymix, float* lse, const float* rel_bias, int item0, int nitems) {
    const int tid = threadIdx.x, lane = tid & 63, wid = __builtin_amdgcn_readfirstlane(tid >> 6), fr = lane & 15, fq = lane >> 4;
    const int q0 = wid * 16;
    LAS unsigned char* KB = lds; LAS unsigned char* VB = lds + 65536;
    LAS float* lutall = (LAS float*)(lds + LUTALL_OFF);
    if (nitems <= 0) return;
    if (tid < 129) {
#pragma unroll
        for (int h = 0; h < NHEADS; ++h) lutall[h * 132 + tid] = rel_bias[(int)T5_BUCKET[h >> 2][tid] * NHEADS + h] * LOG2E;
    }
    bf16x8 qf[4];
    {
        const AttnItem a = attn_decode(item0);
        const bf16_t* kh = qkv + (size_t)(12 + a.head) * MROWS * HD; const bf16_t* vh = qkv + (size_t)(24 + a.head) * MROWS * HD; const bf16_t* qh = qkv + (size_t)a.head * MROWS * HD;
        const size_t cur = a.subbase + 128 * a.n, prv = a.n > 0 ? cur - 128 : cur;
        attn_stage_half<false>(KB, kh, cur, wid, lane); attn_stage_half<false>(KB + 32768, kh, prv, wid, lane);
        attn_stage_half<true>(VB, vh, cur, wid, lane); attn_stage_half<true>(VB + 32768, vh, prv, wid, lane);
        const bf16_t* qp = qh + (cur + q0 + fr) * HD + 8 * fq;
#pragma unroll
        for (int s = 0; s < 4; ++s) qf[s] = *(const bf16x8*)(qp + 32 * s);
    }
    for (int i = 0; i < nitems; ++i) {
        const AttnItem a = attn_decode(item0 + i);
        const int cs = i & 1;
        const bool has_next = i + 1 < nitems;
        AttnItem an = a; if (has_next) an = attn_decode(item0 + i + 1);
        asm volatile("s_waitcnt vmcnt(0) lgkmcnt(0)" ::: "memory");
        __builtin_amdgcn_s_barrier();
        asm volatile("" ::: "memory");
        f32x4 sc[9];
#pragma unroll
        for (int jt = 0; jt < 9; ++jt) {
            const int kt = q0 + 16 * jt, prow = ((((kt >> 7) ^ 1 ^ cs) & 1) << 7) | (kt & 127);
            f32x4 acc = {0.f, 0.f, 0.f, 0.f};
            LAS const unsigned char* kp = KB + (prow + fr) * 256;
#pragma unroll
            for (int s = 0; s < 4; ++s) { const bf16x8 kf = *(LAS const bf16x8*)(kp + (((4 * s + fq) ^ fr) << 4)); acc = __builtin_amdgcn_mfma_f32_16x16x32_bf16(kf, qf[s], acc, 0, 0, 0); }
            sc[jt] = acc;
        }
        asm volatile("s_waitcnt lgkmcnt(0)" ::: "memory");
        __builtin_amdgcn_s_barrier();
        asm volatile("" ::: "memory");
        if (has_next) {
            const bf16_t* qh = qkv + (size_t)an.head * MROWS * HD; const bf16_t* kh = qkv + (size_t)(12 + an.head) * MROWS * HD;
            const size_t cur = an.subbase + 128 * an.n;
            const bf16_t* qp = qh + (cur + q0 + fr) * HD + 8 * fq;
#pragma unroll
            for (int s = 0; s < 4; ++s) qf[s] = *(const bf16x8*)(qp + 32 * s);
            attn_stage_half<false>(KB + (cs ^ 1) * 32768, kh, cur, wid, lane);
        }
        LAS const float* lut = lutall + a.head * 132;
        float mx = -3.0e38f;
#pragma unroll
        for (int jt = 0; jt < 9; ++jt)
#pragma unroll
            for (int e = 0; e < 4; ++e) {
                const int off = 128 + fr - 16 * jt - 4 * fq - e, ki = q0 + 16 * jt + 4 * fq + e;
                const bool ok = (off >= 0) && (off <= 128) && (a.n > 0 || ki >= 128);
                const int oc = off < 0 ? 0 : (off > 128 ? 128 : off);
                const float v = ok ? sc[jt][e] + lut[oc] : -1.0e30f;
                sc[jt][e] = v; mx = fmaxf(mx, v);
            }
        mx = fmaxf(mx, __shfl_xor(mx, 16)); mx = fmaxf(mx, __shfl_xor(mx, 32));
        float den = 0.f;
#pragma unroll
        for (int jt = 0; jt < 9; ++jt)
#pragma unroll
            for (int e = 0; e < 4; ++e) { const float pv = __builtin_amdgcn_exp2f(sc[jt][e] - mx); sc[jt][e] = pv; den += pv; }
        den += __shfl_xor(den, 16); den += __shfl_xor(den, 32);
        bf16x8 pb[5];
#pragma unroll
        for (int ks = 0; ks < 5; ++ks) {
            u32x4 w; w.x = pk2(sc[2 * ks][0], sc[2 * ks][1]); w.y = pk2(sc[2 * ks][2], sc[2 * ks][3]);
            if (ks < 4) { w.z = pk2(sc[2 * ks + 1][0], sc[2 * ks + 1][1]); w.w = pk2(sc[2 * ks + 1][2], sc[2 * ks + 1][3]); } else { w.z = 0u; w.w = 0u; }
            pb[ks] = __builtin_bit_cast(bf16x8, w);
        }
        f32x4 o[8];
#pragma unroll
        for (int db = 0; db < 8; ++db) o[db] = (f32x4){0.f, 0.f, 0.f, 0.f};
#pragma unroll
        for (int ks = 0; ks < 5; ++ks) {
            const int ktA = q0 + 32 * ks, ktB = (ks < 4) ? ktA + 16 : ktA;
            const int prA = ((((ktA >> 7) ^ 1 ^ cs) & 1) << 7) | (ktA & 127), prB = ((((ktB >> 7) ^ 1 ^ cs) & 1) << 7) | (ktB & 127);
            const int rl = 4 * fq + (fr >> 2);
            LAS const unsigned char* va = VB + (prA + rl) * 256 + 8 * (fr & 3);
            LAS const unsigned char* vb = VB + (prB + rl) * 256 + 8 * (fr & 3);
#pragma unroll
            for (int db = 0; db < 8; ++db) {
                const s16x4 lo = vtr(va + ((db ^ (rl & 7)) << 5)), hi = vtr(vb + ((db ^ (rl & 7)) << 5));
                const bf16x8 vf = {lo[0], lo[1], lo[2], lo[3], hi[0], hi[1], hi[2], hi[3]};
                o[db] = __builtin_amdgcn_mfma_f32_16x16x32_bf16(vf, pb[ks], o[db], 0, 0, 0);
            }
        }
        asm volatile("s_waitcnt lgkmcnt(0)" ::: "memory");
        __builtin_amdgcn_s_barrier();
        asm volatile("" ::: "memory");
        if (has_next) {
            const bf16_t* vh = qkv + (size_t)(24 + an.head) * MROWS * HD;
            attn_stage_half<true>(VB + (cs ^ 1) * 32768, vh, an.subbase + 128 * an.n, wid, lane);
        }
        const float inv = 1.0f / den;
        LAS unsigned char* stg = lds + OSTG_OFF + wid * 2304;
        const size_t qrow_w = a.rowbase + ((size_t)(128 * a.n + q0) << a.dsh) + a.r;
#pragma unroll
        for (int hh = 0; hh < 2; ++hh) {
#pragma unroll
            for (int d4 = 0; d4 < 4; ++d4) { const int db = 4 * hh + d4; u32x2 w; w.x = pk2(o[db][0] * inv, o[db][1] * inv); w.y = pk2(o[db][2] * inv, o[db][3] * inv);
                *(LAS u32x2*)(stg + fr * 144 + d4 * 32 + 8 * fq) = w; }
            asm volatile("s_waitcnt lgkmcnt(0)" ::: "memory");
#pragma unroll
            for (int p = 0; p < 2; ++p) { const int rw = (lane >> 3) + 8 * p, ch = lane & 7;
                const u32x4 v = *(LAS const u32x4*)(stg + rw * 144 + ch * 16);
                *(u32x4*)(ymix + (qrow_w + ((size_t)rw << a.dsh)) * DM + 512 + a.head * HD + 64 * hh + 8 * ch) = v; }
            asm volatile("s_waitcnt lgkmcnt(0)" ::: "memory");
        }
        if (fq == 0) lse[(qrow_w + ((size_t)fr << a.dsh)) * NHEADS + a.head] = (mx + __builtin_amdgcn_logf(den)) * LN2;
    }
    asm volatile("s_waitcnt vmcnt(0) lgkmcnt(0)" ::: "memory");
    __builtin_amdgcn_s_barrier();
    asm volatile("" ::: "memory");
}

__device__ __forceinline__ void mix_row(bf16_t* ymix, const float* lse, int row, int lane) {
    const int hs = lane >> 4; const float* l = lse + (size_t)row * NHEADS + hs;
    const float l0 = l[0], l1 = l[4], l2 = l[8], m = fmaxf(l0, fmaxf(l1, l2));
    const float e0 = __expf(l0 - m), e1 = __expf(l1 - m), e2 = __expf(l2 - m), inv = 1.0f / (e0 + e1 + e2);
    const float al[3] = {e0 * inv, e1 * inv, e2 * inv};
    bf16_t* y = ymix + (size_t)row * DM + 512 + lane * 8;
#pragma unroll
    for (int j = 0; j < 3; ++j) { const u32x4 w = *(const u32x4*)(y + 512 * j); const float a = al[j]; u32x4 o;
        o.x = pk2(bflo(w.x) * a, bfhi(w.x) * a); o.y = pk2(bflo(w.y) * a, bfhi(w.y) * a); o.z = pk2(bflo(w.z) * a, bfhi(w.z) * a); o.w = pk2(bflo(w.w) * a, bfhi(w.w) * a);
        *(u32x4*)(y + 512 * j) = o; }
}
__device__ __forceinline__ void final_row(float* out, const bf16_t* h3, const float* ssq, const float* gfin, int row, int lane) {
    const float r = 1.0f / sqrtf(ssq[row] * (1.0f / DM) + RMS_EPS);
    float* o = out + (size_t)row * DM + lane * 8; const bf16_t* hh = h3 + (size_t)row * DM + lane * 8;
#pragma unroll
    for (int j = 0; j < 4; ++j) { const u32x4 w = __builtin_nontemporal_load((const u32x4*)(hh + 512 * j)); const f32x4 g0 = *(const f32x4*)(gfin + lane * 8 + 512 * j), g1 = *(const f32x4*)(gfin + lane * 8 + 512 * j + 4);
        const f32x4 v0 = {bflo(w.x), bfhi(w.x), bflo(w.y), bfhi(w.y)}, v1 = {bflo(w.z), bfhi(w.z), bflo(w.w), bfhi(w.w)};
        __builtin_nontemporal_store(v0 * r * g0, (f32x4*)(o + 512 * j)); __builtin_nontemporal_store(v1 * r * g1, (f32x4*)(o + 512 * j + 4)); }
}


struct Args { const float* in[16]; float* out; unsigned char* ws; };

#define PG8_ALIGN true
#define PG8_SP2 true

__global__ void __launch_bounds__(512, 2) hymba_fwd(Args args) {
    extern __shared__ __attribute__((aligned(16))) unsigned char lds_raw[];
    LAS unsigned char* lds = (LAS unsigned char*)lds_raw;
    cg::grid_group grid = cg::this_grid();
    const int tid = threadIdx.x, lane = tid & 63, wid = __builtin_amdgcn_readfirstlane(tid >> 6);
    const int G = gridDim.x, bx = blockIdx.x;
    const int vcu = (G % 8 == 0) ? (bx % 8) * (G / 8) + bx / 8 : bx;
    const int gw = vcu * 8 + wid, NGW = G * 8;
    Ptrs P;
    P.x = args.in[0]; P.p = args.in[1]; P.rel_bias = args.in[2]; P.g_mix = args.in[3]; P.w_in = args.in[4]; P.pool_w = args.in[5]; P.pool_scale = args.in[6]; P.w_out = args.in[7];
    P.g_ffn = args.in[8]; P.w_gate = args.in[9]; P.w_up = args.in[10]; P.w_down = args.in[11]; P.g_ple = args.in[12]; P.w_pg = args.in[13]; P.w_pp = args.in[14]; P.g_final = args.in[15];
    P.out = args.out; P.ws = args.ws;
    unsigned char* ws = args.ws;
    bf16_t* BT1 = (bf16_t*)(ws + WS_BT1); bf16_t* BT2 = (bf16_t*)(ws + WS_BT2); bf16_t* BT3 = (bf16_t*)(ws + WS_BT3);
    bf16_t* BT4 = (bf16_t*)(ws + WS_BT4); bf16_t* BT5 = (bf16_t*)(ws + WS_BT5); bf16_t* BT6 = (bf16_t*)(ws + WS_BT6);
    bf16_t* PB = (bf16_t*)(ws + WS_PB); bf16_t* XB = (bf16_t*)(ws + WS_XB); bf16_t* YMIX = (bf16_t*)(ws + WS_YMIX); bf16_t* PROJ = (bf16_t*)(ws + WS_PROJ);
    float* SSQ1 = (float*)(ws + WS_SSQ1); float* SSQ2 = (float*)(ws + WS_SSQ2); float* SSQ3 = (float*)(ws + WS_SSQ3); float* RSTDX = (float*)(ws + WS_RSTDX); float* LSE = (float*)(ws + WS_LSE);

    volatile LAS unsigned* MISC = (volatile LAS unsigned*)(lds + MISC_OFF);
    if (tid < 2) MISC[tid] = 0u;
    if (bx == 0) for (int u = tid; u < XCD_BAR_WORDS; u += 512) ((unsigned*)(ws + WS_BAR))[u] = 0u;
    prologue(P, lds, gw, NGW, wid, lane);
    grid.sync();
    const XcdBarrier bar = xcd_barrier_post((unsigned*)(ws + WS_BAR), MISC);

    { pg8::Gemm g{XB, BT1, MROWS, NIN, DM}; pg8::StaticOrder S; S.init(MROWS, NIN, G, bx);
      pg8::EpiProj E{PROJ, PROJ + (size_t)MROWS * 512, RSTDX, QSCALE, 13, MROWS};
      pg8::gemm_phase<pg8::EpiProj, pg8::StaticOrder, PG8_ALIGN, PG8_SP2>(lds, g, S, E); }
    xcd_barrier(bar);

    { const int per = (1536 + G - 1) / G;
      { const int i0 = vcu * per, cnt = (i0 + per <= 1536) ? per : (1536 - i0); attn_phase(lds, PROJ + (size_t)MROWS * 512, YMIX, LSE, P.rel_bias, i0, cnt); }
      for (int it = gw; it < 4096; it += NGW) pool_item(PROJ, YMIX, it, lane); }
    xcd_barrier(bar);

    for (int row = gw; row < MROWS; row += NGW) mix_row(YMIX, LSE, row, lane);
    xcd_barrier(bar);

    { pg8::Gemm g{YMIX, BT2, MROWS, DM, DM}; pg8::StaticOrder S; S.init(MROWS, DM, G, bx);
      pg8::EpiRes E{XB, XB, SSQ1, DM};
      pg8::gemm_phase<pg8::EpiRes, pg8::StaticOrder, PG8_ALIGN, PG8_SP2>(lds, g, S, E); }
    xcd_barrier(bar);

    { pg8::Gemm g{XB, BT3, MROWS, 2 * DFF, DM}; pg8::StaticOrder S; S.init(MROWS, 2 * DFF, G, bx);
      pg8::EpiSwiGLU E{PROJ, DFF, SSQ1, 1.0f / DM, RMS_EPS};
      pg8::gemm_phase<pg8::EpiSwiGLU, pg8::StaticOrder, PG8_ALIGN, PG8_SP2>(lds, g, S, E); }
    { int kpp = DPLE; asm volatile("" : "+s"(kpp));
      pg8::Gemm g{PB, BT6, MROWS, DM, kpp}; pg8::StaticOrder S; S.init(MROWS, DM, G, bx);
      pg8::EpiPlain E{YMIX, DM};
      pg8::gemm_phase<pg8::EpiPlain, pg8::StaticOrder, PG8_ALIGN, PG8_SP2>(lds, g, S, E); }
    xcd_barrier(bar);

    { pg8::Gemm g{PROJ, BT4, MROWS, DM, DFF}; pg8::StaticOrder S; S.init(MROWS, DM, G, bx);
      pg8::EpiRes E{XB, XB, SSQ2, DM};
      pg8::gemm_phase<pg8::EpiRes, pg8::StaticOrder, PG8_ALIGN, PG8_SP2>(lds, g, S, E); }
    xcd_barrier(bar);

    { pg8::Gemm g{XB, BT5, MROWS, DM, DM}; pg8::StaticOrder S; S.init(MROWS, DM, G, bx);
      pg8::EpiPle E{XB, YMIX, PROJ, SSQ2, SSQ3, DM, 1.0f / DM, RMS_EPS};
      pg8::gemm_phase<pg8::EpiPle, pg8::StaticOrder, PG8_ALIGN, PG8_SP2>(lds, g, S, E); }
    xcd_barrier(bar);

    for (int row = gw; row < MROWS; row += NGW) final_row(P.out, PROJ, SSQ3, P.g_final, row, lane);
}

extern "C" void kernel_launch(void* const* d_in, const int* in_sizes, int n_in, void* d_out, int out_size, void* d_ws, size_t ws_size, hipStream_t stream) {
    static int grid = 0;
    if (grid == 0) {
        if (n_in != 16 || in_sizes[0] != MROWS * DM || out_size != MROWS * DM || ws_size < WS_END) {
            fprintf(stderr, "kernel_launch: unexpected shapes (n_in %d, in0 %d, out %d, ws %zu); nothing launched\n", n_in, n_in > 0 ? in_sizes[0] : -1, out_size, ws_size); grid = -1; return; }
        int dev = 0, cus = 0, per_cu = 0;
        if (hipGetDevice(&dev) != hipSuccess || hipDeviceGetAttribute(&cus, hipDeviceAttributeMultiprocessorCount, dev) != hipSuccess) { fprintf(stderr, "kernel_launch: device query failed\n"); grid = -1; return; }
        if (hipFuncSetAttribute((const void*)hymba_fwd, hipFuncAttributeMaxDynamicSharedMemorySize, LDS_BYTES) != hipSuccess) { fprintf(stderr, "kernel_launch: hipFuncSetAttribute failed\n"); grid = -1; return; }
        if (hipOccupancyMaxActiveBlocksPerMultiprocessor(&per_cu, (const void*)hymba_fwd, 512, LDS_BYTES) != hipSuccess || per_cu < 1) { fprintf(stderr, "kernel_launch: occupancy query says %d blocks per CU\n", per_cu); (void)hipGetLastError(); per_cu = 1; }
        if (per_cu > 1) per_cu = 1;
        grid = cus * per_cu;
    }
    if (grid < 0) return;
    Args a{};
    for (int i = 0; i < 16; ++i) a.in[i] = (const float*)d_in[i];
    a.out = (float*)d_out; a.ws = (unsigned char*)d_ws;
    void* kargs[] = {&a};
    hipError_t e = hipLaunchCooperativeKernel((const void*)hymba_fwd, dim3(grid), dim3(512), kargs, LDS_BYTES, stream);
    if (e != hipSuccess) fprintf(stderr, "kernel_launch: cooperative launch failed: %s (grid %d)\n", hipGetErrorString(e), grid);
}
```
